# Optimizing an MI355X kernel written in HIP

```python
import math
import jax, jax.numpy as jnp
from jax import lax
import numpy as np

D_MODEL = 2048
BATCH = 2
SEQ = 4096
DEPTH = 2

N_A_LAYERS = DEPTH // 2
N_B_LAYERS = DEPTH - N_A_LAYERS
S5_WIDTH = D_MODEL
S5_GROUP = 16
S5_GROUPS = S5_WIDTH // S5_GROUP
S5_STATE = 64
DT_MIN = 1e-3
DT_MAX = 1e-1
FOX_HEAD_DIM = 128
FOX_HEADS = D_MODEL // FOX_HEAD_DIM
FOX_WIDTH = FOX_HEADS * FOX_HEAD_DIM
Q_BLOCK = 128
RMS_EPS = 1e-6
NEG_INF = -1e30

kernel_name = "yoco_s5_fox_hybrid"

F32 = jnp.float32


def rmsnorm(x, g):
    xf = x.astype(F32)
    y = xf * lax.rsqrt(jnp.mean(xf * xf, axis=-1, keepdims=True) + RMS_EPS)
    return (y * g.astype(F32)).astype(x.dtype)


def s5_ssm(u, a_re, a_im, log_dt, b_re, b_im, c_re, c_im, d_skip):
    bsz, seq, _ = u.shape
    uf = u.astype(F32).reshape(bsz, seq, S5_GROUPS, S5_GROUP)
    dt = jnp.exp(log_dt.astype(F32))[:, None]
    ar = a_re.astype(F32)
    ai = a_im.astype(F32)
    mag = jnp.exp(ar * dt)
    abar_re = mag * jnp.cos(ai * dt)
    abar_im = mag * jnp.sin(ai * dt)
    den = ar * ar + ai * ai
    nr = abar_re - 1.0
    coef_re = (nr * ar + abar_im * ai) / den
    coef_im = (abar_im * ar - nr * ai) / den
    bu_re = jnp.einsum('bsgc,gpc->bsgp', uf, b_re.astype(F32))
    bu_im = jnp.einsum('bsgc,gpc->bsgp', uf, b_im.astype(F32))
    x_re = coef_re * bu_re - coef_im * bu_im
    x_im = coef_re * bu_im + coef_im * bu_re
    shape_a = (1, seq, S5_GROUPS, S5_STATE)
    a_seq_re = jnp.broadcast_to(abar_re, shape_a)
    a_seq_im = jnp.broadcast_to(abar_im, shape_a)

    def combine(left, right):
        a1r, a1i, b1r, b1i = left
        a2r, a2i, b2r, b2i = right
        return (a2r * a1r - a2i * a1i,
                a2r * a1i + a2i * a1r,
                a2r * b1r - a2i * b1i + b2r,
                a2r * b1i + a2i * b1r + b2i)

    _, _, h_re, h_im = lax.associative_scan(combine, (a_seq_re, a_seq_im, x_re, x_im), axis=1)
    y = (jnp.einsum('bsgp,gcp->bsgc', h_re, c_re.astype(F32))
         - jnp.einsum('bsgp,gcp->bsgc', h_im, c_im.astype(F32)))
    y = y + d_skip.astype(F32).reshape(S5_GROUPS, S5_GROUP) * uf
    return y.reshape(bsz, seq, S5_WIDTH)


def s5_layer(h, g_pre, g_post, w_in, a_re, a_im, log_dt, b_re, b_im, c_re, c_im, d_skip, w_glu, b_glu, w_out):
    xn = rmsnorm(h, g_pre)
    uz = xn @ w_in
    u, z = jnp.split(uz, 2, axis=-1)
    y = s5_ssm(u, a_re, a_im, log_dt, b_re, b_im, c_re, c_im, d_skip)
    y = jax.nn.gelu(y)
    y = y * jax.nn.sigmoid(y @ w_glu.astype(F32) + b_glu.astype(F32))
    y = y.astype(h.dtype) * jax.nn.silu(z)
    return h + rmsnorm(y @ w_out, g_post)


def shared_kv(h, g_kv, w_kv, b_f):
    bsz, seq, _ = h.shape
    kvf = rmsnorm(h, g_kv) @ w_kv
    k = kvf[..., :FOX_WIDTH]
    v = kvf[..., FOX_WIDTH:2 * FOX_WIDTH]
    f_logit = kvf[..., 2 * FOX_WIDTH:]
    k = k.reshape(bsz, seq, FOX_HEADS, FOX_HEAD_DIM).transpose(0, 2, 1, 3)
    v = v.reshape(bsz, seq, FOX_HEADS, FOX_HEAD_DIM).transpose(0, 2, 1, 3)
    log_f = jax.nn.log_sigmoid(f_logit.astype(F32) + b_f.astype(F32))
    cum = jnp.cumsum(log_f, axis=1).transpose(0, 2, 1)
    return k, v, cum


def fox_attention(q, k, v, cum):
    bsz, nh, seq, dh = q.shape
    nblk = seq // Q_BLOCK
    qb = q.reshape(bsz, nh, nblk, Q_BLOCK, dh).transpose(2, 0, 1, 3, 4)
    cb = cum.reshape(bsz, nh, nblk, Q_BLOCK).transpose(2, 0, 1, 3)
    kpos = jnp.arange(seq)
    scale = dh ** -0.5

    def block(args):
        q_i, c_i, i = args
        s = jnp.einsum('bhqd,bhkd->bhqk', q_i, k, preferred_element_type=F32) * scale
        s = s + c_i[..., :, None] - cum[:, :, None, :]
        qpos = i * Q_BLOCK + jnp.arange(Q_BLOCK)
        s = jnp.where(kpos[None, :] <= qpos[:, None], s, NEG_INF)
        p = jax.nn.softmax(s, axis=-1)
        return jnp.einsum('bhqk,bhkd->bhqd', p.astype(v.dtype), v)

    o = lax.map(block, (qb, cb, jnp.arange(nblk)))
    return o.transpose(1, 2, 0, 3, 4).reshape(bsz, nh, seq, dh)


def fox_layer(h, g_pre, g_post, w_in, w_out, k, v, cum):
    bsz, seq, _ = h.shape
    qz = rmsnorm(h, g_pre) @ w_in
    q, z = jnp.split(qz, 2, axis=-1)
    q = q.reshape(bsz, seq, FOX_HEADS, FOX_HEAD_DIM).transpose(0, 2, 1, 3)
    o = fox_attention(q, k, v, cum)
    o = o.transpose(0, 2, 1, 3).reshape(bsz, seq, FOX_WIDTH)
    o = o.astype(h.dtype) * jax.nn.silu(z)
    return h + rmsnorm(o @ w_out, g_post)


def setup_inputs(seed: int = 0) -> dict:
    key = jax.random.key(seed)
    ks = jax.random.split(key, 24)
    nrm = lambda k, shp, s: jax.random.normal(k, shp, F32) * s
    n = jnp.arange(S5_STATE, dtype=F32)
    a_re = -0.5 + nrm(ks[4], (N_A_LAYERS, S5_GROUPS, S5_STATE), 0.01)
    a_im = math.pi * n + nrm(ks[5], (N_A_LAYERS, S5_GROUPS, S5_STATE), 0.01)
    log_dt = jax.random.uniform(ks[6], (N_A_LAYERS, S5_GROUPS), F32, math.log(DT_MIN), math.log(DT_MAX))
    return {
        "x": nrm(ks[0], (BATCH, SEQ, D_MODEL), 1.0),
        "norm_pre": 1.0 + nrm(ks[1], (DEPTH, D_MODEL), 0.02),
        "norm_post": 1.0 + nrm(ks[2], (DEPTH, D_MODEL), 0.02),
        "s5_w_in": nrm(ks[3], (N_A_LAYERS, D_MODEL, 2 * S5_WIDTH), D_MODEL ** -0.5),
        "s5_a_re": a_re,
        "s5_a_im": a_im,
        "s5_log_dt": log_dt,
        "s5_b_re": nrm(ks[7], (N_A_LAYERS, S5_GROUPS, S5_STATE, S5_GROUP), (2 * S5_GROUP) ** -0.5),
        "s5_b_im": nrm(ks[8], (N_A_LAYERS, S5_GROUPS, S5_STATE, S5_GROUP), (2 * S5_GROUP) ** -0.5),
        "s5_c_re": nrm(ks[9], (N_A_LAYERS, S5_GROUPS, S5_GROUP, S5_STATE), S5_STATE ** -0.5),
        "s5_c_im": nrm(ks[10], (N_A_LAYERS, S5_GROUPS, S5_GROUP, S5_STATE), S5_STATE ** -0.5),
        "s5_d": nrm(ks[11], (N_A_LAYERS, S5_WIDTH), 1.0),
        "s5_w_glu": nrm(ks[12], (N_A_LAYERS, S5_WIDTH, S5_WIDTH), S5_WIDTH ** -0.5),
        "s5_b_glu": nrm(ks[13], (N_A_LAYERS, S5_WIDTH), 0.01),
        "s5_w_out": nrm(ks[14], (N_A_LAYERS, S5_WIDTH, D_MODEL), S5_WIDTH ** -0.5),
        "kv_norm": 1.0 + nrm(ks[15], (D_MODEL,), 0.02),
        "kv_w": nrm(ks[16], (D_MODEL, 2 * FOX_WIDTH + FOX_HEADS), D_MODEL ** -0.5),
        "kv_b_f": jax.random.uniform(ks[17], (FOX_HEADS,), F32, 2.0, 7.0),
        "fox_w_in": nrm(ks[18], (N_B_LAYERS, D_MODEL, 2 * FOX_WIDTH), D_MODEL ** -0.5),
        "fox_w_out": nrm(ks[19], (N_B_LAYERS, FOX_WIDTH, D_MODEL), FOX_WIDTH ** -0.5),
    }


def reference(x, norm_pre, norm_post, s5_w_in, s5_a_re, s5_a_im, s5_log_dt, s5_b_re, s5_b_im,
              s5_c_re, s5_c_im, s5_d, s5_w_glu, s5_b_glu, s5_w_out, kv_norm, kv_w, kv_b_f,
              fox_w_in, fox_w_out):
    h = x
    k = v = cum = None
    for layer in range(DEPTH):
        if layer < N_A_LAYERS:
            i = layer
            h = s5_layer(h, norm_pre[layer], norm_post[layer], s5_w_in[i], s5_a_re[i], s5_a_im[i],
                         s5_log_dt[i], s5_b_re[i], s5_b_im[i], s5_c_re[i], s5_c_im[i], s5_d[i],
                         s5_w_glu[i], s5_b_glu[i], s5_w_out[i])
        else:
            if layer == N_A_LAYERS:
                k, v, cum = shared_kv(h, kv_norm, kv_w, kv_b_f)
            j = layer - N_A_LAYERS
            h = fox_layer(h, norm_pre[layer], norm_post[layer], fox_w_in[j], fox_w_out[j], k, v, cum)
    return h
```

```cpp
#include <hip/hip_runtime.h>
#include <hip/hip_bf16.h>
#include <hip/hip_cooperative_groups.h>
#include <cstdio>
#include <cstdint>
namespace cg = cooperative_groups;
namespace pg8 {
#define PG8_LAS __attribute__((address_space(3)))
typedef unsigned short bf16_t;
typedef short bf16x8 __attribute__((ext_vector_type(8)));
typedef float f32x4 __attribute__((ext_vector_type(4)));
typedef unsigned u32x4 __attribute__((ext_vector_type(4)));
constexpr int BM = 256, BK = 64, HALF = 128, HTB = HALF * BK * 2  , STAGE_BYTES = 8 * HTB, NXCD = 8, WGM = 8;

__host__ __device__ __forceinline__ int lds_byte(int r, int c) { const int st = (r >> 4) * 2 + (c >> 5), rr = r & 15, cc = c & 31, ob = rr * 64 + cc * 2; return st * 1024 + (ob ^ (((ob >> 9) & 1) << 5)); }
__host__ __device__ __forceinline__ void stage_rc(int b, int& R, int& C) { const int st = b / 1024, sb = b % 1024, swz = sb ^ (((sb >> 9) & 1) << 5); R = (st >> 1) * 16 + swz / 64; C = (st & 1) * 32 + (swz % 64) / 2; }
__host__ __device__ __forceinline__ int perm32(int rho) { const int n = rho >> 4, i = rho & 15; return 8 * (i >> 2) + 4 * n + (i & 3); }

struct Unit { int pm, pn; };
struct Gemm { const bf16_t* A; const bf16_t* Bt; int M, N, K; };

struct StaticOrder {
    int nM, nN, nwg, G, c;
    __host__ __device__ void init(int M, int N, int G_, int c_) { nM = M / BM; nN = N / BM; nwg = nM * nN; G = G_; c = c_; }
    __host__ __device__ bool next(int i, Unit& u) const {
        const long L = (long)i * G + c; if (L >= nwg) return false;
        int wgid = (int)L; { const int q = nwg / NXCD, r = nwg % NXCD, xcd = wgid % NXCD, off = wgid / NXCD; wgid = (xcd < r ? xcd * (q + 1) : r * (q + 1) + (xcd - r) * q) + off; }
        const int nig = WGM * nN, gid = wgid / nig, fm = gid * WGM, gsz = (nM - fm) < WGM ? (nM - fm) : WGM;
        u.pm = fm + ((wgid % nig) % gsz); u.pn = (wgid % nig) / gsz; return true;
    }
    __device__ __forceinline__ void a_ready(const Unit&) const {}
    __device__ __forceinline__ void done(const Unit&) const {}
};

__device__ __forceinline__ unsigned cvt_pk_bf16(float lo, float hi) { unsigned r; asm volatile("v_cvt_pk_bf16_f32 %0, %1, %2" : "=v"(r) : "v"(lo), "v"(hi)); return r; }
typedef float f32x2 __attribute__((ext_vector_type(2)));
template <class F> struct EpiRow8 {
    static constexpr bool PERM = true, AFTER_DRAIN = false;
    F f;
    __device__ __forceinline__ void operator()(const f32x4 (&acc)[2][2][4][2], const Unit& u, int wr, int wc, int fr, int fq) const {
        const int row0 = u.pm * BM + wr * 64 + fr, col0 = u.pn * BM + wc * 32 + 8 * fq;
#pragma unroll
        for (int ai = 0; ai < 2; ++ai)
#pragma unroll
            for (int m = 0; m < 4; ++m)
#pragma unroll
                for (int bj = 0; bj < 2; ++bj) f(row0 + ai * HALF + m * 16, col0 + bj * HALF, acc[ai][bj][m][0], acc[ai][bj][m][1]);
    }
    __device__ __forceinline__ void fused(f32x4 (&)[2][2][4][2], const Unit&, int, int, int, int, PG8_LAS unsigned char*, int, int) const {}
};
struct RowStat {
    float* slots;
    unsigned* cnt;
    float* rstd_out;
    __device__ __forceinline__ void run(const f32x4 (&v)[2][2][4][2], const Unit& u, int wr, int wc, int fr, int fq, PG8_LAS unsigned char* lds, int wid, int lane) const {
        PG8_LAS float* Pp = (PG8_LAS float*)lds;
        PG8_LAS float* S = (PG8_LAS float*)(lds + 4096);
#pragma unroll
        for (int ai = 0; ai < 2; ++ai)
#pragma unroll
            for (int m = 0; m < 4; ++m) {
                float s = 0.f;
#pragma unroll
                for (int bj = 0; bj < 2; ++bj)
#pragma unroll
                    for (int n = 0; n < 2; ++n) { const f32x4 x = v[ai][bj][m][n]; s += (x[0] * x[0] + x[1] * x[1]) + (x[2] * x[2] + x[3] * x[3]); }
                s += __shfl_xor(s, 16); s += __shfl_xor(s, 32);
                if (fq == 0) Pp[(ai * HALF + wr * 64 + m * 16 + fr) * 4 + wc] = s;
            }
        asm volatile("s_waitcnt lgkmcnt(0)" ::: "memory"); __builtin_amdgcn_s_barrier(); asm volatile("" ::: "memory");
        const int row = wid * 32 + (lane & 31);
        if (lane < 32) {
            const float t = (Pp[row * 4 + 0] + Pp[row * 4 + 1]) + (Pp[row * 4 + 2] + Pp[row * 4 + 3]);
            __hip_atomic_store(slots + (size_t)(u.pm * BM + row) * 8 + u.pn, t, __ATOMIC_RELAXED, __HIP_MEMORY_SCOPE_AGENT);
        }
        asm volatile("s_waitcnt vmcnt(0)" ::: "memory");
        if (lane == 0) __hip_atomic_fetch_add(cnt + 64 * u.pm, 1u, __ATOMIC_RELAXED, __HIP_MEMORY_SCOPE_AGENT);
        if (wid == 0) {
            unsigned spins = 0;
            while ((unsigned)__builtin_amdgcn_readfirstlane(__hip_atomic_load(cnt + 64 * u.pm, __ATOMIC_RELAXED, __HIP_MEMORY_SCOPE_AGENT)) < 64u) { __builtin_amdgcn_s_sleep(2); if (++spins > (1u << 22)) break; }
            __builtin_amdgcn_fence(__ATOMIC_ACQUIRE, "agent");
        }
        asm volatile("s_waitcnt vmcnt(0) lgkmcnt(0)" ::: "memory"); __builtin_amdgcn_s_barrier(); asm volatile("" ::: "memory");
        if (lane < 32) {
            const float* sl = slots + (size_t)(u.pm * BM + row) * 8; float t = 0.f;
#pragma unroll
            for (int k = 0; k < 8; ++k) t += __hip_atomic_load(sl + k, __ATOMIC_RELAXED, __HIP_MEMORY_SCOPE_AGENT);
            const float rs = rsqrtf(t * (1.f / 2048.f) + 1e-6f);
            S[row] = rs;
            if (rstd_out && u.pn == 0) rstd_out[u.pm * BM + row] = rs;
        }
        asm volatile("s_waitcnt lgkmcnt(0)" ::: "memory"); __builtin_amdgcn_s_barrier(); asm volatile("" ::: "memory");
    }
};
__device__ __forceinline__ void rowstat_partial(const f32x4 (&v)[2][2][4][2], const Unit& u, float* slots, int wr, int wc, int fr, int fq, PG8_LAS unsigned char* lds, int wid, int lane) {
    PG8_LAS float* Pp = (PG8_LAS float*)lds;
#pragma unroll
    for (int ai = 0; ai < 2; ++ai)
#pragma unroll
        for (int m = 0; m < 4; ++m) {
            float s = 0.f;
#pragma unroll
            for (int bj = 0; bj < 2; ++bj)
#pragma unroll
                for (int n = 0; n < 2; ++n) { const f32x4 x = v[ai][bj][m][n]; s += (x[0] * x[0] + x[1] * x[1]) + (x[2] * x[2] + x[3] * x[3]); }
            s += __shfl_xor(s, 16); s += __shfl_xor(s, 32);
            if (fq == 0) Pp[(ai * HALF + wr * 64 + m * 16 + fr) * 4 + wc] = s;
        }
    asm volatile("s_waitcnt lgkmcnt(0)" ::: "memory"); __builtin_amdgcn_s_barrier(); asm volatile("" ::: "memory");
    const int row = wid * 32 + (lane & 31);
    if (lane < 32) slots[(size_t)(u.pm * BM + row) * 8 + u.pn] = (Pp[row * 4 + 0] + Pp[row * 4 + 1]) + (Pp[row * 4 + 2] + Pp[row * 4 + 3]);
}
template <bool SECOND> struct EpiNormRes {
    static constexpr bool PERM = true, AFTER_DRAIN = true;
    const float* base; const bf16_t* base16; float* out; const float* gain; bf16_t* outb; RowStat st1, st2;
    __device__ __forceinline__ void operator()(const f32x4 (&)[2][2][4][2], const Unit&, int, int, int, int) const {}
    __device__ __forceinline__ void fused(f32x4 (&acc)[2][2][4][2], const Unit& u, int wr, int wc, int fr, int fq, PG8_LAS unsigned char* lds, int wid, int lane) const {
        const PG8_LAS float* S = (const PG8_LAS float*)(lds + 4096);
        st1.run(acc, u, wr, wc, fr, fq, lds, wid, lane);
        const int col0 = u.pn * BM + wc * 32 + 8 * fq;
        f32x4 g[2][2];
#pragma unroll
        for (int bj = 0; bj < 2; ++bj) { g[bj][0] = *(const f32x4*)(gain + col0 + bj * HALF); g[bj][1] = *(const f32x4*)(gain + col0 + bj * HALF + 4); }
#pragma unroll
        for (int ai = 0; ai < 2; ++ai)
#pragma unroll
            for (int m = 0; m < 4; ++m) { const int r = ai * HALF + wr * 64 + m * 16 + fr; const float rs = S[r]; const size_t off = (size_t)(u.pm * BM + r) * 2048 + col0;
#pragma unroll
                for (int bj = 0; bj < 2; ++bj) {
                    f32x4 b0, b1;
                    { const u32x4 w = *(const u32x4*)(base16 + off + bj * HALF);
                        b0 = (f32x4){__uint_as_float(w.x << 16), __uint_as_float(w.x & 0xffff0000u), __uint_as_float(w.y << 16), __uint_as_float(w.y & 0xffff0000u)};
                        b1 = (f32x4){__uint_as_float(w.z << 16), __uint_as_float(w.z & 0xffff0000u), __uint_as_float(w.w << 16), __uint_as_float(w.w & 0xffff0000u)}; }
                    const f32x4 h0 = b0 + acc[ai][bj][m][0] * rs * g[bj][0], h1 = b1 + acc[ai][bj][m][1] * rs * g[bj][1];
                    if (!SECOND) { *(f32x4*)(out + off + bj * HALF) = h0; *(f32x4*)(out + off + bj * HALF + 4) = h1; }
                    else { acc[ai][bj][m][0] = h0; acc[ai][bj][m][1] = h1;
                        u32x4 w; w.x = cvt_pk_bf16(h0[0], h0[1]); w.y = cvt_pk_bf16(h0[2], h0[3]); w.z = cvt_pk_bf16(h1[0], h1[1]); w.w = cvt_pk_bf16(h1[2], h1[3]);
                        *(u32x4*)(outb + off + bj * HALF) = w; }
                }
                if (m & 1) asm volatile("" ::: "memory"); }
        if (SECOND) rowstat_partial(acc, u, st2.slots, wr, wc, fr, fq, lds, wid, lane);
    }
};
template <class Epi, class Sched, bool ALIGN_EPI = false, bool SP2 = false>
__device__ __forceinline__ void gemm_phase(PG8_LAS unsigned char* lds, const Gemm g, const Sched& S, const Epi& E, const int tid_in) {
    const int tid = tid_in, wid = __builtin_amdgcn_readfirstlane(tid >> 6), lane = tid & 63, wr = wid >> 2, wc = wid & 3, fr = lane & 15, fq = lane >> 4;
    const int K = g.K, nt = K / BK;
    unsigned voffA[2], voffB[2];
#pragma unroll
    for (int i = 0; i < 2; ++i) { int R, C; stage_rc(tid * 16 + i * 8192, R, C); const int Rb = Epi::PERM ? ((R & ~31) + perm32(R & 31)) : R;
        voffA[i] = (unsigned)(R * K + C) * 2u; voffB[i] = (unsigned)(Rb * K + C) * 2u; }
    const size_t kstep = (size_t)(BK * 2);
    const size_t hstep = (size_t)HALF * K * 2;
    const size_t tstep = 2 * hstep;
    const unsigned ldsw = (unsigned)wid * 1024u;
    const int aoff = lds_byte(wr * 64 + fr, fq * 8), boff = lds_byte(wc * 32 + fr, fq * 8);
#define PG8_SA(b, h) (((b) * 2 + (h)) * HTB)
#define PG8_SB(b, h) ((4 + (b) * 2 + (h)) * HTB)
#define PG8_STAGE(bufoff, gbase, voff) do { _Pragma("unroll") for (int _i = 0; _i < 2; ++_i) \
        __builtin_amdgcn_global_load_lds((const unsigned*)((const char*)(gbase) + (voff)[_i]), (PG8_LAS unsigned*)(lds + (bufoff) + ldsw + _i * 8192), 16, 0, 0); } while (0)
#define PG8_LDA(dst, b, h) do { _Pragma("unroll") for (int m = 0; m < 4; ++m) _Pragma("unroll") for (int k = 0; k < 2; ++k) dst[m][k] = *(const PG8_LAS bf16x8*)(lds + PG8_SA(b, h) + aoff + m * 2048 + k * 1024); } while (0)
#define PG8_LDB(dst, b, h) do { _Pragma("unroll") for (int n = 0; n < 2; ++n) _Pragma("unroll") for (int k = 0; k < 2; ++k) dst[n][k] = *(const PG8_LAS bf16x8*)(lds + PG8_SB(b, h) + boff + n * 2048 + k * 1024); } while (0)
#define PG8_MMA(ai, bj, At, Bt) do { __builtin_amdgcn_s_setprio(1); _Pragma("unroll") for (int m = 0; m < 4; ++m) _Pragma("unroll") for (int n = 0; n < 2; ++n) _Pragma("unroll") for (int k = 0; k < 2; ++k) \
        acc[ai][bj][m][n] = __builtin_amdgcn_mfma_f32_16x16x32_bf16(Bt[n][k], At[m][k], acc[ai][bj][m][n], 0, 0, 0); __builtin_amdgcn_s_setprio(0); } while (0)
#define PG8_WAIT_V(n) asm volatile("s_waitcnt vmcnt(" #n ")" ::: "memory")
#define PG8_WAIT_L(n) asm volatile("s_waitcnt lgkmcnt(" #n ")" ::: "memory")
#define PG8_BAR __builtin_amdgcn_s_barrier()
#define PG8_SCHED __builtin_amdgcn_sched_barrier(0)
    Unit cur, nxt; int ui = 0;
    if (!S.next(0, cur)) return;
    f32x4 acc[2][2][4][2];
#pragma unroll
    for (int a = 0; a < 2; ++a)
#pragma unroll
        for (int b = 0; b < 2; ++b)
#pragma unroll
            for (int m = 0; m < 4; ++m)
#pragma unroll
                for (int n = 0; n < 2; ++n) acc[a][b][m][n] = (f32x4){0.f, 0.f, 0.f, 0.f};
    bf16x8 At[4][2], B0[2][2], B1[2][2];
    const char* cA = (const char*)g.A + (size_t)cur.pm * tstep; const char* cB = (const char*)g.Bt + (size_t)cur.pn * tstep;
    S.a_ready(cur);
    if constexpr (SP2) {
        PG8_STAGE(PG8_SB(0, 0), cB, voffB); PG8_STAGE(PG8_SB(0, 1), cB + hstep, voffB); PG8_STAGE(PG8_SA(0, 0), cA, voffA); PG8_STAGE(PG8_SA(0, 1), cA + hstep, voffA);
        if (wr == 1) PG8_BAR;
        PG8_WAIT_V(2); PG8_BAR;
        PG8_STAGE(PG8_SB(1, 0), cB + kstep, voffB); PG8_STAGE(PG8_SA(1, 0), cA + kstep, voffA); PG8_STAGE(PG8_SB(1, 1), cB + hstep + kstep, voffB);
        PG8_WAIT_V(6); PG8_BAR;
    } else {
        PG8_STAGE(PG8_SB(0, 0), cB, voffB); PG8_STAGE(PG8_SA(0, 0), cA, voffA); PG8_STAGE(PG8_SB(0, 1), cB + hstep, voffB); PG8_STAGE(PG8_SA(0, 1), cA + hstep, voffA);
        if (wr == 1) PG8_BAR;
        PG8_WAIT_V(4); PG8_BAR;
        PG8_STAGE(PG8_SB(1, 0), cB + kstep, voffB); PG8_STAGE(PG8_SA(1, 0), cA + kstep, voffA); PG8_STAGE(PG8_SB(1, 1), cB + hstep + kstep, voffB);
        PG8_WAIT_V(6); PG8_BAR;
    }
    for (;;) {
        const bool has_next = S.next(ui + 1, nxt);
        const char* nA = has_next ? (const char*)g.A + (size_t)nxt.pm * tstep : cA; const char* nB = has_next ? (const char*)g.Bt + (size_t)nxt.pn * tstep : cB;
        for (int t = 0; t < nt; t += 2) {
            const bool last = (t == nt - 2);
            const char* a1 = cA + (size_t)(t + 1) * kstep;
            const char* a2 = last ? nA : cA + (size_t)(t + 2) * kstep; const char* b2 = last ? nB : cB + (size_t)(t + 2) * kstep;
            const char* a3 = a2 + kstep; const char* b3 = b2 + kstep;
            if (last && has_next) S.a_ready(nxt);
            if constexpr (SP2) {
            PG8_LDB(B0, 0, 0); PG8_LDB(B1, 0, 1); PG8_SCHED; PG8_LDA(At, 0, 0); PG8_STAGE(PG8_SA(1, 1), a1 + hstep, voffA);
            PG8_WAIT_V(8); PG8_WAIT_L(0); PG8_BAR; PG8_MMA(0, 0, At, B0); PG8_MMA(0, 1, At, B1); PG8_BAR; PG8_SCHED;
            PG8_LDA(At, 0, 1); PG8_STAGE(PG8_SB(0, 0), b2, voffB); PG8_STAGE(PG8_SB(0, 1), b2 + hstep, voffB); PG8_STAGE(PG8_SA(0, 0), a2, voffA);
            PG8_WAIT_V(8); PG8_WAIT_L(0); PG8_BAR; PG8_MMA(1, 0, At, B0); PG8_MMA(1, 1, At, B1); PG8_BAR; PG8_SCHED;
            PG8_LDB(B0, 1, 0); PG8_LDB(B1, 1, 1); PG8_SCHED; PG8_LDA(At, 1, 0); PG8_STAGE(PG8_SA(0, 1), a2 + hstep, voffA);
            PG8_WAIT_V(8); PG8_WAIT_L(0); PG8_BAR; PG8_MMA(0, 0, At, B0); PG8_MMA(0, 1, At, B1); PG8_BAR; PG8_SCHED;
            PG8_LDA(At, 1, 1); PG8_STAGE(PG8_SB(1, 0), b3, voffB); PG8_STAGE(PG8_SB(1, 1), b3 + hstep, voffB); PG8_STAGE(PG8_SA(1, 0), a3, voffA);
            PG8_WAIT_V(8); PG8_WAIT_L(0); PG8_BAR; PG8_MMA(1, 0, At, B0); PG8_MMA(1, 1, At, B1); PG8_BAR; PG8_SCHED;
            } else {
            PG8_LDB(B0, 0, 0); PG8_SCHED; PG8_LDA(At, 0, 0); PG8_STAGE(PG8_SA(1, 1), a1 + hstep, voffA);
            PG8_WAIT_L(8); PG8_BAR; PG8_WAIT_L(0); PG8_MMA(0, 0, At, B0); PG8_BAR; PG8_SCHED;
            PG8_LDB(B1, 0, 1); PG8_STAGE(PG8_SB(0, 0), b2, voffB);
            PG8_BAR; PG8_WAIT_L(0); PG8_MMA(0, 1, At, B1); PG8_BAR;
            PG8_LDA(At, 0, 1); PG8_STAGE(PG8_SA(0, 0), a2, voffA);
            PG8_BAR; PG8_WAIT_L(0); PG8_MMA(1, 0, At, B0); PG8_BAR; PG8_SCHED;
            PG8_STAGE(PG8_SB(0, 1), b2 + hstep, voffB);
            PG8_WAIT_V(6); PG8_BAR; PG8_MMA(1, 1, At, B1); PG8_BAR;
            PG8_LDB(B0, 1, 0); PG8_SCHED; PG8_LDA(At, 1, 0); PG8_STAGE(PG8_SA(0, 1), a2 + hstep, voffA);
            PG8_WAIT_L(8); PG8_BAR; PG8_WAIT_L(0); PG8_MMA(0, 0, At, B0); PG8_BAR; PG8_SCHED;
            PG8_LDB(B1, 1, 1); PG8_STAGE(PG8_SB(1, 0), b3, voffB);
            PG8_BAR; PG8_WAIT_L(0); PG8_MMA(0, 1, At, B1); PG8_BAR;
            PG8_LDA(At, 1, 1); PG8_STAGE(PG8_SA(1, 0), a3, voffA);
            PG8_BAR; PG8_WAIT_L(0); PG8_MMA(1, 0, At, B0); PG8_BAR; PG8_SCHED;
            PG8_STAGE(PG8_SB(1, 1), b3 + hstep, voffB);
            PG8_WAIT_V(6); PG8_BAR; PG8_MMA(1, 1, At, B1); PG8_BAR;
            }
        }
        if constexpr (ALIGN_EPI) { if (wr == 0) PG8_BAR; }
        if constexpr (!Epi::AFTER_DRAIN) { E(acc, cur, wr, wc, fr, fq); S.done(cur); }
        if (!has_next) break;
#pragma unroll
        for (int a = 0; a < 2; ++a)
#pragma unroll
            for (int b = 0; b < 2; ++b)
#pragma unroll
                for (int m = 0; m < 4; ++m)
#pragma unroll
                    for (int n = 0; n < 2; ++n) acc[a][b][m][n] = (f32x4){0.f, 0.f, 0.f, 0.f};
        cur = nxt; cA = nA; cB = nB; ++ui;
        if constexpr (ALIGN_EPI) { if (wr == 1) PG8_BAR; }
    }
    PG8_WAIT_V(0);
    if constexpr (!ALIGN_EPI) { if (wr == 0) PG8_BAR; }
    PG8_BAR;
    if constexpr (Epi::AFTER_DRAIN) { E.fused(acc, cur, wr, wc, fr, fq, lds, wid, lane); S.done(cur); }
#undef PG8_SA
#undef PG8_SB
#undef PG8_STAGE
#undef PG8_LDA
#undef PG8_LDB
#undef PG8_MMA
#undef PG8_WAIT_V
#undef PG8_WAIT_L
#undef PG8_BAR
#undef PG8_SCHED
}
}
namespace attn {
constexpr int D = 128; constexpr float THR = 8.f; constexpr bool WSKIP = false; constexpr int OSTR = 2048, BIAS_OFF = 69632, OST_OFF = 90112;
constexpr float SCALE = 0.08838834764831845f;
constexpr int NW = 8, QBLK = 32, KVBLK = 64, QB = NW * QBLK;
constexpr int SHM_V = KVBLK * D * 2, SHM_K = KVBLK * D * 2;
constexpr int LDS_BYTES = 2 * SHM_V + 2 * SHM_K + NW * 64 * 4;
using bf16 = __hip_bfloat16;
typedef short bf16x8 __attribute__((ext_vector_type(8)));
typedef short s16x4 __attribute__((ext_vector_type(4)));
typedef float f32x16 __attribute__((ext_vector_type(16)));
typedef float f32x4 __attribute__((ext_vector_type(4)));
typedef unsigned u32x4 __attribute__((ext_vector_type(4)));
template <class A, class Bt> struct same_t { static constexpr bool v = false; };
template <class A> struct same_t<A, A> { static constexpr bool v = true; };

#define KSWZ(row, colB) ((row) * 256 + ((colB) ^ (((row) & 7) << 4)))
#define SBAR() __builtin_amdgcn_sched_barrier(0)
__device__ __forceinline__ int v_st(int k, int c) { const int kk = (k & ~0xC) | ((k & 4) << 1) | ((k & 8) >> 1); return ((kk >> 3) * 4 + (c >> 5)) * 512 + ((kk & 7) * 32 + (c & 31)) * 2; }
__device__ __forceinline__ int v_rd_base(int lane) { return ((lane & 3) << 3) | (((lane >> 2) & 3) << 6) | (((lane >> 4) & 1) << 5) | (((lane >> 5) & 1) << 8); }
constexpr int v_rd_off(int d0, int ks, int half) { return d0 * 512 + ks * 4096 + half * 2048; }
__device__ __forceinline__ int crow(int r, int hi) { return (r & 3) + 8 * (r >> 2) + 4 * hi; }
__device__ __forceinline__ unsigned cvtpk(float lo, float hi) {
    unsigned r; asm volatile("v_cvt_pk_bf16_f32 %0, %1, %2" : "=v"(r) : "v"(lo), "v"(hi)); return r;
}
__device__ __forceinline__ bf16x8 pack8(f32x4 a, f32x4 b) {
    u32x4 w = {cvtpk(a[0], a[1]), cvtpk(a[2], a[3]), cvtpk(b[0], b[1]), cvtpk(b[2], b[3])};
    return *reinterpret_cast<bf16x8*>(&w);
}
template <class T> __device__ __forceinline__ bf16x8 load8(const T* p) {
    if constexpr (same_t<T, float>::v) { return pack8(*(const f32x4*)p, *(const f32x4*)(p + 4)); }
    else { return *reinterpret_cast<const bf16x8*>(p); }
}
__device__ __forceinline__ void mask_tile(f32x16& p0, f32x16& p1, int dq, unsigned W) {
    const float NEG = -__builtin_inff();
#pragma unroll
    for (int r = 0; r < 16; ++r) {
        const int c = (r & 3) + 8 * (r >> 2);
        if ((unsigned)(dq - c) >= W) p0[r] = NEG;
        if ((unsigned)(dq - c - 32) >= W) p1[r] = NEG;
    }
}
__device__ __forceinline__ void partialSM(f32x16& p0, f32x16& p1, float& m_reg, float& mn, float& alpha) {
    float pmax = p0[0]; for (int r = 1; r < 16; ++r) pmax = fmaxf(pmax, p0[r]); for (int r = 0; r < 16; ++r) pmax = fmaxf(pmax, p1[r]);
    { auto rr = __builtin_amdgcn_permlane32_swap(__float_as_uint(pmax), __float_as_uint(pmax), false, false);
      pmax = fmaxf(__uint_as_float(rr[0]), __uint_as_float(rr[1])); }
    constexpr float C2 = 1.4426950408889634f * SCALE;
    if (__builtin_expect(__all((pmax - m_reg) * SCALE <= THR), 1)) { mn = m_reg; alpha = 1.f; }
    else { mn = fmaxf(m_reg, pmax); alpha = __builtin_amdgcn_exp2f((m_reg - mn) * C2); m_reg = mn; }
    const float mnL = -mn * C2;
    for (int r = 0; r < 16; ++r) p0[r] = fmaf(p0[r], C2, mnL); for (int r = 0; r < 16; ++r) p1[r] = fmaf(p1[r], C2, mnL);
    for (int r = 0; r < 16; ++r) p0[r] = __builtin_amdgcn_exp2f(p0[r]);
}
__device__ __forceinline__ void finishSM(f32x16& p0, f32x16& p1, float alpha, float& l_reg, bf16x8& pa0, bf16x8& pa1, bf16x8& pa2, bf16x8& pa3) {
    for (int r = 0; r < 16; ++r) p1[r] = __builtin_amdgcn_exp2f(p1[r]);
    float ps = 0; for (int r = 0; r < 16; ++r) ps += p0[r]; for (int r = 0; r < 16; ++r) ps += p1[r];
    { auto rr = __builtin_amdgcn_permlane32_swap(__float_as_uint(ps), __float_as_uint(ps), false, false);
      ps = __uint_as_float(rr[0]) + __uint_as_float(rr[1]); }
    l_reg = l_reg * alpha + ps;
#define PK4(P, B_, OUT) do { unsigned a0 = cvtpk(P[B_+0], P[B_+1]), a1 = cvtpk(P[B_+2], P[B_+3]);                          \
        unsigned b0 = cvtpk(P[B_+4], P[B_+5]), b1 = cvtpk(P[B_+6], P[B_+7]);                                             \
        auto r0 = __builtin_amdgcn_permlane32_swap(a0, b0, false, false); auto r1 = __builtin_amdgcn_permlane32_swap(a1, b1, false, false); \
        u32x4 w = {r0[0], r1[0], r0[1], r1[1]}; OUT = *reinterpret_cast<bf16x8*>(&w); } while (0)
    PK4(p0, 0, pa0); PK4(p0, 8, pa1); PK4(p1, 0, pa2); PK4(p1, 8, pa3);
#undef PK4
}
__device__ __forceinline__ const float* bl_addr(const char* lds, int hi, int kbase) { int h = hi; asm volatile("" : "+v"(h)); return (const float*)(lds + BIAS_OFF) + 4 * h + kbase; }
template <int KB, bool SK>
__device__ __forceinline__ void qkt(f32x16& p0, f32x16& p1, const char* K_lds, int r32, int hi, const bf16x8* qr, bool act, const float* bl) {
    if (SK && !act) { const float NEG = -__builtin_inff();
#pragma unroll
        for (int r = 0; r < 16; ++r) { p0[r] = NEG; p1[r] = NEG; } return; }
    { const f32x4 c0 = *(const f32x4*)(bl), c1 = *(const f32x4*)(bl + 8), c2 = *(const f32x4*)(bl + 16), c3 = *(const f32x4*)(bl + 24);
      const f32x4 e0 = *(const f32x4*)(bl + 32), e1 = *(const f32x4*)(bl + 40), e2 = *(const f32x4*)(bl + 48), e3 = *(const f32x4*)(bl + 56);
      p0 = (f32x16){c0[0], c0[1], c0[2], c0[3], c1[0], c1[1], c1[2], c1[3], c2[0], c2[1], c2[2], c2[3], c3[0], c3[1], c3[2], c3[3]};
      p1 = (f32x16){e0[0], e0[1], e0[2], e0[3], e1[0], e1[1], e1[2], e1[3], e2[0], e2[1], e2[2], e2[3], e3[0], e3[1], e3[2], e3[3]}; }
    const char* kb[4];
#pragma unroll
    for (int dd = 0; dd < 4; ++dd) kb[dd] = K_lds + KB * SHM_K + KSWZ(r32, (dd * 16 + hi * 8) * 2);
#pragma unroll
    for (int d0 = 0; d0 < 8; ++d0) { const char* a = kb[d0 & 3] + (d0 >> 2) * 128;
        bf16x8 b0 = *reinterpret_cast<const bf16x8*>(a);
        bf16x8 b1 = *reinterpret_cast<const bf16x8*>(a + 32 * 256);
        p0 = __builtin_amdgcn_mfma_f32_32x32x16_bf16(b0, qr[d0], p0, 0, 0, 0);
        p1 = __builtin_amdgcn_mfma_f32_32x32x16_bf16(b1, qr[d0], p1, 0, 0, 0); }
}
template <int VB, bool SK>
__device__ __forceinline__ void pv_tile(f32x16* o, int vb0, bf16x8 pa0, bf16x8 pa1, bf16x8 pa2, bf16x8 pa3, bool act) {
    if (SK && !act) return;
#define TRRD(dst, off) asm volatile("ds_read_b64_tr_b16 %0, %1 offset:%2" : "=&v"(dst) : "v"(vb0), "i"(off) : "memory")
#define PV_D0(d0) do { s16x4 l0, l1, l2, l3, h0, h1, h2, h3; constexpr int b_ = VB * SHM_V + v_rd_off(d0, 0, 0);     \
        TRRD(l0, b_); TRRD(h0, b_ + 2048); TRRD(l1, b_ + 4096); TRRD(h1, b_ + 6144); TRRD(l2, b_ + 8192); TRRD(h2, b_ + 10240); TRRD(l3, b_ + 12288); TRRD(h3, b_ + 14336); \
        asm volatile("s_waitcnt lgkmcnt(0)" ::: "memory"); SBAR();                 \
        o[d0] = __builtin_amdgcn_mfma_f32_32x32x16_bf16(pa0, (bf16x8){l0[0], l0[1], l0[2], l0[3], h0[0], h0[1], h0[2], h0[3]}, o[d0], 0, 0, 0);   \
        o[d0] = __builtin_amdgcn_mfma_f32_32x32x16_bf16(pa1, (bf16x8){l1[0], l1[1], l1[2], l1[3], h1[0], h1[1], h1[2], h1[3]}, o[d0], 0, 0, 0);   \
        o[d0] = __builtin_amdgcn_mfma_f32_32x32x16_bf16(pa2, (bf16x8){l2[0], l2[1], l2[2], l2[3], h2[0], h2[1], h2[2], h2[3]}, o[d0], 0, 0, 0);   \
        o[d0] = __builtin_amdgcn_mfma_f32_32x32x16_bf16(pa3, (bf16x8){l3[0], l3[1], l3[2], l3[3], h3[0], h3[1], h3[2], h3[3]}, o[d0], 0, 0, 0); } while (0)
    PV_D0(0); PV_D0(1); PV_D0(2); PV_D0(3);
#undef PV_D0
#undef TRRD
}

template <class TIn, class TOut> struct BlockRef { const TIn* Q; const TIn* K; const TIn* V; TOut* O; const unsigned short* Z; int P0; };
template <class TIn> struct Seam {
    bf16x8 qr[8];
    bf16x8 st_v0, st_v1, st_k0, st_k1; f32x4 sf0, sf1, sf2, sf3;
    f32x4 tq[16];
};
__device__ __forceinline__ int swa_jlo(int P0, int W) { const int lowk = P0 - W + 1; return lowk > 0 ? lowk / KVBLK : 0; }
__device__ __forceinline__ int hm16(int r, int d) { return (r & ~15) * 128 + ((((d >> 5) * 16 + (r & 15)) * 4 + ((d >> 3) & 3)) << 3); }
#define ROW(p, k0, rr) ((p) + (size_t)(k0) * D + hm16((rr), sc))
#define VMW() asm volatile("s_waitcnt vmcnt(0)" ::: "memory")
#define VMWN(n) asm volatile("s_waitcnt vmcnt(%0)" :: "i"(n) : "memory")
#define SLOAD_H(Kp, Vp, k0) do { S.st_v0 = load8<TIn>(ROW(Vp, k0, sr)); S.st_v1 = load8<TIn>(ROW(Vp, k0, 32 + sr));              \
                         S.st_k0 = load8<TIn>(ROW(Kp, k0, sr)); S.st_k1 = load8<TIn>(ROW(Kp, k0, 32 + sr)); } while (0)
#define SWRITE_HK(bf) do { *(bf16x8*)(K_lds + (bf) * SHM_K + kws) = S.st_k0; *(bf16x8*)(K_lds + (bf) * SHM_K + kws + 32 * 256) = S.st_k1; } while (0)
#define SWRITE_HV(bf) do { *(bf16x8*)(V_lds + (bf) * SHM_V + vst0) = S.st_v0; *(bf16x8*)(V_lds + (bf) * SHM_V + vst1) = S.st_v1; } while (0)
#define SWRITE_H(bf) do { SWRITE_HV(bf); SWRITE_HK(bf); } while (0)
#define SLOAD_F(p, k0) do { S.sf0 = *(const f32x4*)ROW(p, k0, sr); S.sf1 = *(const f32x4*)(ROW(p, k0, sr) + 4);                \
                            S.sf2 = *(const f32x4*)ROW(p, k0, 32 + sr); S.sf3 = *(const f32x4*)(ROW(p, k0, 32 + sr) + 4); } while (0)
#define SWRITE_KF(bf) do { *(bf16x8*)(K_lds + (bf) * SHM_K + kws) = pack8(S.sf0, S.sf1); *(bf16x8*)(K_lds + (bf) * SHM_K + kws + 32 * 256) = pack8(S.sf2, S.sf3); } while (0)
#define SWRITE_VF(bf) do { *(bf16x8*)(V_lds + (bf) * SHM_V + vst0) = pack8(S.sf0, S.sf1); *(bf16x8*)(V_lds + (bf) * SHM_V + vst1) = pack8(S.sf2, S.sf3); } while (0)
template <class TIn, class TOut>
__device__ __forceinline__ void causal_swa_prime(const BlockRef<TIn, TOut>& cur, int W, char* lds, Seam<TIn>& S, const int tid_in) {
    constexpr bool F32 = same_t<TIn, float>::v;
    const int tid = tid_in, wid = __builtin_amdgcn_readfirstlane(tid >> 6), lane = tid & 63, r32 = lane & 31, hi = lane >> 5;
    const int sr = tid >> 4, sc = (tid & 15) * 8, kws = KSWZ(sr, sc * 2); char* K_lds = lds + 2 * SHM_V;
    const int kb0 = swa_jlo(cur.P0, W) * KVBLK;
    for (int d0 = 0; d0 < 8; ++d0) S.qr[d0] = load8<TIn>(cur.Q + hm16(wid * QBLK + r32, d0 * 16 + hi * 8));
    if constexpr (F32) { SLOAD_F((const float*)cur.K, kb0); VMW(); SWRITE_KF(0); SBAR(); SLOAD_F((const float*)cur.V, kb0); }
    else { SLOAD_H(cur.K, cur.V, kb0); VMW(); SWRITE_HK(0); }
    __syncthreads();
}
template <class TIn, class TOut>
__device__ __forceinline__ void causal_swa_block(const BlockRef<TIn, TOut>& cur, const BlockRef<TIn, TOut>& nxt, int skv, int W, char* lds, Seam<TIn>& S, const int tid_in) {
    constexpr bool F32 = same_t<TIn, float>::v;
    const int tid = tid_in, wid = __builtin_amdgcn_readfirstlane(tid >> 6), lane = tid & 63, r32 = lane & 31, hi = lane >> 5;
    const int j_lo = swa_jlo(cur.P0, W);
    int j_hi = (cur.P0 + QB - 1) / KVBLK + 1; if (j_hi > skv / KVBLK) j_hi = skv / KVBLK;
    const int NT = j_hi - j_lo;
    const int kbn = swa_jlo(nxt.P0, W) * KVBLK;
    const int qlo = cur.P0 + wid * QBLK, qm = qlo + r32 - 4 * hi;
    char* V_lds = lds; char* K_lds = lds + 2 * SHM_V;
    float* ws = (float*)(lds + 2 * SHM_V + 2 * SHM_K) + wid * 64; float* li_l = ws, * al_l = ws + 32;
    float m_reg = ((const float*)(lds + BIAS_OFF))[cur.P0 + wid * QBLK + r32], l_reg = 0; f32x16 o[4] = {};
    const int sr = tid >> 4, sc = (tid & 15) * 8, vst0 = v_st(sr, sc), vst1 = v_st(32 + sr, sc), kws = KSWZ(sr, sc * 2);
    const int vb0 = (int)(uintptr_t)V_lds + v_rd_base(lane);
    const TIn* Kh = cur.K; const TIn* Vh = cur.V;
#define RESC(a) do { if (__any((a) < 1.f)) { if (hi == 0) al_l[r32] = (a); asm volatile("s_waitcnt lgkmcnt(0)" ::: "memory");              \
                     for (int d_ = 0; d_ < 4; ++d_) for (int r = 0; r < 16; ++r) o[d_][r] *= al_l[crow(r, hi)]; } } while (0)
#define KBASE(t) ((j_lo + (t)) * KVBLK)
#define BL(t) bl_addr(lds, hi, KBASE(t))
#define ACT(t) (KBASE(t) <= qlo + QBLK - 1 && KBASE(t) + KVBLK - 1 >= qlo - W + 1)
#define MASKT(P0_, P1_, t) do { const int kb_ = KBASE(t); if ((!SK || ACT(t)) && (kb_ + KVBLK - 1 > qlo || kb_ <= qlo + QBLK - 1 - W)) mask_tile(P0_, P1_, qm - kb_, (unsigned)W); } while (0)
    constexpr int NQL = F32 ? 16 : 8;
    constexpr bool SK = WSKIP && !F32;
#define SEAM_K0() do { VMWN(NQL); if constexpr (F32) { SWRITE_KF(0); SBAR(); SLOAD_F((const float*)nxt.V, kbn); } else { SWRITE_HK(0); } SBAR(); } while (0)
    f32x16 pA0, pA1, pB0, pB1; float mnA, mnB, alA, alB; bf16x8 pa0, pa1, pa2, pa3;
    if constexpr (F32) { VMW(); SWRITE_VF(0); SBAR(); } else { SWRITE_HV(0); SBAR(); }
    if (NT > 1) { if constexpr (F32) SLOAD_F((const float*)Kh, KBASE(1)); else SLOAD_H(Kh, Vh, KBASE(1)); }
    SBAR(); qkt<0, SK>(pA0, pA1, K_lds, r32, hi, S.qr, ACT(0), BL(0));
    if constexpr (F32) { if (NT > 1) { VMW(); SWRITE_KF(1); SBAR(); SLOAD_F((const float*)Vh, KBASE(1)); } }
    MASKT(pA0, pA1, 0); partialSM(pA0, pA1, m_reg, mnA, alA);
    if (NT > 1) { VMW(); if constexpr (F32) { SWRITE_VF(1); SBAR(); if (NT > 2) SLOAD_F((const float*)Kh, KBASE(2)); } else SWRITE_H(1); }
    __syncthreads();
#define HALF_STEP(PX0, PX1, mnX, alX, PY0, PY1, alY, t, KB, VB, SB) do {                                                      \
        SBAR(); qkt<KB, SK>(PX0, PX1, K_lds, r32, hi, S.qr, ACT(t), BL(t));                                             \
        finishSM(PY0, PY1, alY, l_reg, pa0, pa1, pa2, pa3); SBAR();                                                           \
        if ((t) + 1 < NT) { if constexpr (F32) { VMW(); SWRITE_KF(SB); SBAR(); SLOAD_F((const float*)Vh, KBASE((t) + 1)); }  \
                            else { SLOAD_H(Kh, Vh, KBASE((t) + 1)); } SBAR(); }                                               \
        pv_tile<VB, SK>(o, vb0, pa0, pa1, pa2, pa3, ACT((t) - 1)); MASKT(PX0, PX1, (t)); partialSM(PX0, PX1, m_reg, mnX, alX);                                        \
        __syncthreads();                                                                                                      \
        if ((t) + 1 < NT) { VMW(); if constexpr (F32) { SWRITE_VF(SB); SBAR(); if ((t) + 2 < NT) SLOAD_F((const float*)Kh, KBASE((t) + 2)); } \
                            else { SWRITE_H(SB); } }                                                                          \
        RESC(alX); __syncthreads(); } while (0)
    for (int t = 1; t + 1 < NT; t += 2) {
        HALF_STEP(pB0, pB1, mnB, alB, pA0, pA1, alA, t, 1, 0, 0);
        HALF_STEP(pA0, pA1, mnA, alA, pB0, pB1, alB, t + 1, 0, 1, 1);
    }
    const bool even = (NT & 1) == 0;
    if (even) { SBAR(); qkt<1, SK>(pB0, pB1, K_lds, r32, hi, S.qr, ACT(NT - 1), BL(NT - 1)); SBAR(); }
#define QROW(e) (nxt.Q + (size_t)(wid * QBLK + r32) * D + ((e) >> 1) * 16 + hi * 8 + ((e) & 1) * 4)
    if constexpr (F32) { SLOAD_F((const float*)nxt.K, kbn); SBAR();
#pragma unroll
        for (int e = 0; e < 8; ++e) S.tq[e] = *(const f32x4*)QROW(e); }
    else { SLOAD_H(nxt.K, nxt.V, kbn); SBAR();
#pragma unroll
        for (int d0 = 0; d0 < 8; ++d0) S.qr[d0] = load8<TIn>(nxt.Q + hm16(wid * QBLK + r32, d0 * 16 + hi * 8)); }
    SBAR();
    finishSM(pA0, pA1, alA, l_reg, pa0, pa1, pa2, pa3); SBAR();
    if constexpr (F32) {
#pragma unroll
        for (int e = 8; e < 16; ++e) S.tq[e] = *(const f32x4*)QROW(e); SBAR(); }
#undef QROW
    pv_tile<0, SK>(o, vb0, pa0, pa1, pa2, pa3, ACT(even ? NT - 2 : NT - 1));
    if (even) { MASKT(pB0, pB1, NT - 1); partialSM(pB0, pB1, m_reg, mnB, alB); __syncthreads(); RESC(alB);
        finishSM(pB0, pB1, alB, l_reg, pa0, pa1, pa2, pa3); SBAR(); pv_tile<1, SK>(o, vb0, pa0, pa1, pa2, pa3, ACT(NT - 1)); }
    SBAR(); SEAM_K0();
    if (hi == 0) li_l[r32] = l_reg; asm volatile("s_waitcnt lgkmcnt(0)" ::: "memory");
    float rli[16];
#pragma unroll
    for (int r = 0; r < 16; ++r) rli[r] = __builtin_amdgcn_rcpf(li_l[crow(r, hi)]);
    { unsigned short* stg = (unsigned short*)(lds + OST_OFF) + wid * 2048;
      size_t obase = (size_t)cur.O, zbase = (size_t)cur.Z; int ln = lane; asm volatile("" : "+s"(obase), "+s"(zbase), "+v"(ln));
#pragma unroll
      for (int half = 0; half < 2; ++half) {
#pragma unroll
        for (int r = 0; r < 16; ++r) { const int orow = crow(r, hi);
#pragma unroll
          for (int dl = 0; dl < 2; ++dl) { const float v = o[half * 2 + dl][r] * rli[r]; stg[orow * 64 + dl * 32 + r32] = (unsigned short)(cvtpk(v, v) & 0xffffu); } }
        asm volatile("s_waitcnt lgkmcnt(0)" ::: "memory");
#pragma unroll
        for (int i = 0; i < 4; ++i) { const int row = i * 8 + (ln >> 3), ch = ln & 7;
          const u32x4 v = *(const u32x4*)(stg + row * 64 + ch * 8);
          const size_t off = ((size_t)(wid * QBLK + row) * OSTR + half * 64 + ch * 8) * 2;
          const u32x4 z = *(const u32x4*)(zbase + (size_t)hm16(wid * QBLK + row, half * 64 + ch * 8) * 2); u32x4 w;
#define MUL2(a_, b_) cvtpk(__uint_as_float((a_) << 16) * __uint_as_float((b_) << 16), __uint_as_float((a_) & 0xffff0000u) * __uint_as_float((b_) & 0xffff0000u))
          w.x = MUL2(v.x, z.x); w.y = MUL2(v.y, z.y); w.z = MUL2(v.z, z.z); w.w = MUL2(v.w, z.w);
#undef MUL2
          *(u32x4*)(obase + off) = w; }
        asm volatile("s_waitcnt lgkmcnt(0)" ::: "memory");
      } }
    if constexpr (F32) {
#pragma unroll
        for (int d0 = 0; d0 < 8; ++d0) S.qr[d0] = pack8(S.tq[2 * d0], S.tq[2 * d0 + 1]); }
    __syncthreads();
#undef RESC
#undef KBASE
#undef BL
#undef ACT
#undef MASKT
#undef SEAM_K0
#undef HALF_STEP
}
#undef ROW
#undef VMW
#undef VMWN
#undef SLOAD_H
#undef SWRITE_HK
#undef SWRITE_HV
#undef SWRITE_H
#undef SLOAD_F
#undef SWRITE_KF
#undef SWRITE_VF

}
#define LAS __attribute__((address_space(3)))
typedef unsigned short bf16_t;
typedef short bf16x8 __attribute__((ext_vector_type(8)));
typedef float f32x4 __attribute__((ext_vector_type(4)));
typedef float f32x16 __attribute__((ext_vector_type(16)));
typedef unsigned u32x4 __attribute__((ext_vector_type(4)));
typedef unsigned u32x2 __attribute__((ext_vector_type(2)));

constexpr int DM = 2048, NB = 2, SEQ = 4096, T = NB * SEQ, NH = 16, HD = 128, NG = 128;
constexpr float EPS = 1e-6f;
constexpr size_t MiB = 1u << 20;
constexpr size_t WS_WIN = 0, WS_WGLU = 16 * MiB, WS_WOUT = 24 * MiB, WS_WCAT = 32 * MiB, WS_WFO = 64 * MiB;
constexpr size_t WS_S0 = 72 * MiB;
constexpr size_t WS_S1 = 104 * MiB;
constexpr size_t WS_S2 = 136 * MiB;
constexpr size_t WS_S3 = 168 * MiB;
constexpr size_t WS_S4 = 200 * MiB;
constexpr size_t WS_MISC = 232 * MiB;
constexpr size_t MISC_RSTD0 = 0, MISC_RSTD1 = 32768, MISC_LOGF = 65536, MISC_WFT = 65536 + 524288, MISC_CTL = 65536 + 524288 + 65536  , MISC_SLOTS = MISC_CTL + 65536  ;
constexpr int LDS_TOTAL = 147456;
constexpr int ATT_BIAS_OFF = 69632;
constexpr int ATT_WTOT_OFF = ATT_BIAS_OFF + 16384;

struct Params { const float* in[20]; float* out; unsigned char* ws; int ph_lo, ph_hi; };

__device__ __forceinline__ int mk_tid(int wv_s) { int t = wv_s * 64 + (int)__lane_id(); asm volatile("" : "+v"(t)); return t; }
__device__ __forceinline__ unsigned cvtpk(float lo, float hi) { unsigned r; asm volatile("v_cvt_pk_bf16_f32 %0, %1, %2" : "=v"(r) : "v"(lo), "v"(hi)); return r; }
__device__ __forceinline__ float bflo(unsigned w) { return __uint_as_float(w << 16); }
__device__ __forceinline__ float bfhi(unsigned w) { return __uint_as_float(w & 0xffff0000u); }
__device__ __forceinline__ float sigmoidf_(float v) { return __builtin_amdgcn_rcpf(1.f + __expf(-v)); }
__device__ __forceinline__ float wave_sum(float v) {
#pragma unroll
    for (int o = 1; o < 64; o <<= 1) v += __shfl_xor(v, o);
    return v;
}
__device__ __forceinline__ void store8(bf16_t* dst, f32x4 a, f32x4 b) {
    u32x4 w; w.x = cvtpk(a[0], a[1]); w.y = cvtpk(a[2], a[3]); w.z = cvtpk(b[0], b[1]); w.w = cvtpk(b[2], b[3]);
    *(u32x4*)dst = w;
}

__device__ __forceinline__ void transpose_item(const float* W, int ldw, bf16_t* WT, int row_off, const float* gk, LAS float* scr, int nblk, int item, int lane) {
    const int kb = item / nblk, nb = item % nblk, k0 = 64 * kb, n0 = 32 * nb;
    float wv_[32], gv_[32];
    const float* wp = W + (size_t)(k0 + (lane >> 5)) * ldw + n0 + (lane & 31);
#pragma unroll
    for (int i = 0; i < 32; ++i) wv_[i] = __builtin_nontemporal_load(wp + (size_t)(2 * i) * ldw);
    if (gk) {
#pragma unroll
        for (int i = 0; i < 32; ++i) gv_[i] = gk[k0 + 2 * i + (lane >> 5)];
#pragma unroll
        for (int i = 0; i < 32; ++i) wv_[i] *= gv_[i];
    }
#pragma unroll
    for (int i = 0; i < 32; ++i) scr[(2 * i + (lane >> 5)) * 33 + (lane & 31)] = wv_[i];
    asm volatile("s_waitcnt lgkmcnt(0)" ::: "memory");
    const int c = lane & 7;
#pragma unroll
    for (int j = 0; j < 4; ++j) { const int n = (lane >> 3) + 8 * j; const LAS float* s = scr + (8 * c) * 33 + n;
        u32x4 o; o.x = cvtpk(s[0 * 33], s[1 * 33]); o.y = cvtpk(s[2 * 33], s[3 * 33]); o.z = cvtpk(s[4 * 33], s[5 * 33]); o.w = cvtpk(s[6 * 33], s[7 * 33]);
        *(u32x4*)(WT + (size_t)(row_off + n0 + n) * DM + k0 + 8 * c) = o; }
    asm volatile("s_waitcnt lgkmcnt(0)" ::: "memory");
}
__device__ __forceinline__ void titem_load(const float* W, int ldw, int nblk, int item, int lane, float (&cv)[32]) {
    const int kb = item / nblk, nb = item % nblk, k0 = 64 * kb, n0 = 32 * nb;
    const float* wp = W + (size_t)(k0 + (lane >> 5)) * ldw + n0 + (lane & 31);
#pragma unroll
    for (int i = 0; i < 32; ++i) cv[i] = __builtin_nontemporal_load(wp + (size_t)(2 * i) * ldw);
}
__device__ __forceinline__ void titem_store(bf16_t* WT, int row_off, const float* gk, int nblk, int item, int lane, LAS float* scr, const float (&cv)[32]) {
    const int kb = item / nblk, nb = item % nblk, k0 = 64 * kb, n0 = 32 * nb;
#pragma unroll
    for (int i = 0; i < 32; ++i) scr[(2 * i + (lane >> 5)) * 33 + (lane & 31)] = cv[i];
    asm volatile("s_waitcnt lgkmcnt(0)" ::: "memory");
    const int c = lane & 7;
    f32x4 g0 = {1.f, 1.f, 1.f, 1.f}, g1 = {1.f, 1.f, 1.f, 1.f};
    if (gk) { g0 = *(const f32x4*)(gk + k0 + 8 * c); g1 = *(const f32x4*)(gk + k0 + 8 * c + 4); }
#pragma unroll
    for (int j = 0; j < 4; ++j) { const int n = (lane >> 3) + 8 * j; const LAS float* s = scr + (8 * c) * 33 + n;
        u32x4 o; o.x = cvtpk(s[0 * 33] * g0[0], s[1 * 33] * g0[1]); o.y = cvtpk(s[2 * 33] * g0[2], s[3 * 33] * g0[3]); o.z = cvtpk(s[4 * 33] * g1[0], s[5 * 33] * g1[1]); o.w = cvtpk(s[6 * 33] * g1[2], s[7 * 33] * g1[3]);
        *(u32x4*)(WT + (size_t)(row_off + n0 + n) * DM + k0 + 8 * c) = o; }
    asm volatile("s_waitcnt lgkmcnt(0)" ::: "memory");
}
#define P0_DECODE(S, it_) int r##S = (it_); const float* W##S; int ldw##S, roff##S, nblk##S; bf16_t* WT##S; const float* gk##S; \
    if (r##S < I_IN) { W##S = w3; ldw##S = 4096; WT##S = (bf16_t*)(ws + WS_WIN); roff##S = 0; gk##S = g1p; nblk##S = 128; } \
    else if (r##S < I_IN + I_SQ) { r##S -= I_IN; W##S = w12; ldw##S = 2048; WT##S = (bf16_t*)(ws + WS_WGLU); roff##S = 0; gk##S = nullptr; nblk##S = 64; } \
    else if (r##S < I_IN + 2 * I_SQ) { r##S -= I_IN + I_SQ; W##S = w14; ldw##S = 2048; WT##S = (bf16_t*)(ws + WS_WOUT); roff##S = 0; gk##S = nullptr; nblk##S = 64; } \
    else if (r##S < 2 * I_IN + 2 * I_SQ) { r##S -= I_IN + 2 * I_SQ; W##S = w16; ldw##S = 4112; WT##S = (bf16_t*)(ws + WS_WCAT); roff##S = 0; gk##S = g15; nblk##S = 128; } \
    else if (r##S < 3 * I_IN + 2 * I_SQ) { r##S -= 2 * I_IN + 2 * I_SQ; W##S = w18; ldw##S = 4096; WT##S = (bf16_t*)(ws + WS_WCAT); roff##S = 4096; gk##S = g1p + DM; nblk##S = 128; } \
    else { r##S -= 3 * I_IN + 2 * I_SQ; W##S = w19; ldw##S = 2048; WT##S = (bf16_t*)(ws + WS_WFO); roff##S = 0; gk##S = nullptr; nblk##S = 64; }
__device__ __forceinline__ void p0_phase(const Params& P, LAS unsigned char* lds, const int tid) {
    const int lane = tid & 63, wave = tid >> 6;
    LAS float* scrA = (LAS float*)(lds + wave * 16896); LAS float* scrB = scrA + 64 * 33;
    const int gw = blockIdx.x * 8 + wave, NGW = gridDim.x * 8;
    constexpr int I_IN = 32 * 128, I_SQ = 32 * 64, NIT = 3 * I_IN + 3 * I_SQ;
    unsigned char* ws = P.ws;
    const float* w3 = P.in[3]; const float* w12 = P.in[12]; const float* w14 = P.in[14]; const float* w16 = P.in[16]; const float* w18 = P.in[18]; const float* w19 = P.in[19];
    const float* g1p = P.in[1]; const float* g15 = P.in[15];
    asm("" : "+s"(w3)); asm("" : "+s"(w12)); asm("" : "+s"(w14)); asm("" : "+s"(w16)); asm("" : "+s"(w18)); asm("" : "+s"(w19)); asm("" : "+s"(g1p)); asm("" : "+s"(g15));
    for (int it = gw; it < NIT; it += 2 * NGW) {
        const bool hasB = it + NGW < NIT;
        P0_DECODE(A, it); P0_DECODE(B, hasB ? it + NGW : it);
        float ca[32], cb[32];
        titem_load(WA, ldwA, nblkA, rA, lane, ca);
        titem_load(WB, ldwB, nblkB, rB, lane, cb);
        titem_store(WTA, roffA, gkA, nblkA, rA, lane, scrA, ca);
        if (hasB) titem_store(WTB, roffB, gkB, nblkB, rB, lane, scrB, cb);
    }
    { bf16_t* wfT = (bf16_t*)(ws + WS_MISC + MISC_WFT); const float* kvw = P.in[16]; const float* gkv = P.in[15];
      for (int i = blockIdx.x * 512 + tid; i < 16 * DM; i += gridDim.x * 512) { const int c = i >> 11, k = i & 2047;
          const float v = gkv[k] * kvw[(size_t)k * 4112 + 4096 + c]; wfT[i] = (bf16_t)(cvtpk(v, v) & 0xffffu); } }
    { const float* x = P.in[0]; bf16_t* xb = (bf16_t*)(ws + WS_S3); float* rstd0 = (float*)(ws + WS_MISC + MISC_RSTD0);
      for (int m = gw; m < T; m += 2 * NGW) {
          const int m1 = (m + NGW < T) ? m + NGW : m;
          const f32x4* xr0 = (const f32x4*)(x + (size_t)m * DM) + lane; const f32x4* xr1 = (const f32x4*)(x + (size_t)m1 * DM) + lane; f32x4 v0[8], v1[8]; float s0 = 0.f, s1 = 0.f;
#pragma unroll
          for (int j = 0; j < 8; ++j) v0[j] = __builtin_nontemporal_load(xr0 + 64 * j);
#pragma unroll
          for (int j = 0; j < 8; ++j) v1[j] = __builtin_nontemporal_load(xr1 + 64 * j);
#pragma unroll
          for (int j = 0; j < 8; ++j) { s0 += (v0[j][0] * v0[j][0] + v0[j][1] * v0[j][1]) + (v0[j][2] * v0[j][2] + v0[j][3] * v0[j][3]); s1 += (v1[j][0] * v1[j][0] + v1[j][1] * v1[j][1]) + (v1[j][2] * v1[j][2] + v1[j][3] * v1[j][3]); }
          const float rs0 = rsqrtf(wave_sum(s0) * (1.f / DM) + EPS), rs1 = rsqrtf(wave_sum(s1) * (1.f / DM) + EPS);
          if (lane == 0) { rstd0[m] = rs0; rstd0[m1] = rs1; }
          u32x2* o0 = (u32x2*)(xb + (size_t)m * DM) + lane; u32x2* o1 = (u32x2*)(xb + (size_t)m1 * DM) + lane;
#pragma unroll
          for (int j = 0; j < 8; ++j) { u32x2 w; w.x = cvtpk(v0[j][0], v0[j][1]); w.y = cvtpk(v0[j][2], v0[j][3]); o0[64 * j] = w; u32x2 w1; w1.x = cvtpk(v1[j][0], v1[j][1]); w1.y = cvtpk(v1[j][2], v1[j][3]); o1[64 * j] = w1; }
      } }
}

__device__ __forceinline__ size_t sz_off(int row, int c) { return ((size_t)((row >> 4) * 64 + (c >> 5)) << 9) + ((((row & 15) * 4 + ((c >> 3) & 3))) << 3); }
struct F1 {
    const float* rstd; bf16_t* ug; bf16_t* sz;
    __device__ __forceinline__ void operator()(int row, int col, f32x4 a, f32x4 b) const {
        const float r = rstd[row]; a = a * r; b = b * r;
        if (col < DM) { const int bb = row >> 12, t = row & 4095, g = col >> 4;
            store8(ug + ((size_t)(bb * NG + g) * SEQ + t) * 16 + (col & 15), a, b); }
        else {
#pragma unroll
            for (int i = 0; i < 4; ++i) { a[i] = a[i] * sigmoidf_(a[i]); b[i] = b[i] * sigmoidf_(b[i]); }
            store8(sz + sz_off(row, col - DM), a, b); }
    }
};
struct F2 {
    const float* bias; const bf16_t* y1; const bf16_t* sz; bf16_t* y2;
    __device__ __forceinline__ void operator()(int row, int col, f32x4 a, f32x4 b) const {
        const f32x4 b0 = *(const f32x4*)(bias + col), b1 = *(const f32x4*)(bias + col + 4);
        const u32x4 yv = *(const u32x4*)(y1 + (size_t)row * DM + col), zv = *(const u32x4*)(sz + sz_off(row, col));
        a = a + b0; b = b + b1;
        f32x4 oa, ob;
        oa[0] = bflo(yv.x) * sigmoidf_(a[0]) * bflo(zv.x); oa[1] = bfhi(yv.x) * sigmoidf_(a[1]) * bfhi(zv.x);
        oa[2] = bflo(yv.y) * sigmoidf_(a[2]) * bflo(zv.y); oa[3] = bfhi(yv.y) * sigmoidf_(a[3]) * bfhi(zv.y);
        ob[0] = bflo(yv.z) * sigmoidf_(b[0]) * bflo(zv.z); ob[1] = bfhi(yv.z) * sigmoidf_(b[1]) * bfhi(zv.z);
        ob[2] = bflo(yv.w) * sigmoidf_(b[2]) * bflo(zv.w); ob[3] = bfhi(yv.w) * sigmoidf_(b[3]) * bfhi(zv.w);
        store8(y2 + (size_t)row * DM + col, oa, ob);
    }
};
struct F3 {
    bf16_t* o;
    __device__ __forceinline__ void operator()(int row, int col, f32x4 a, f32x4 b) const { store8(o + (size_t)row * DM + col, a, b); }
};
struct F4 {
    const float* rstd; bf16_t* kb; bf16_t* vb; bf16_t* qb; bf16_t* sz2;
    __device__ __forceinline__ void operator()(int row, int col, f32x4 a, f32x4 b) const {
        const f32x4 p0 = *(const f32x4*)(rstd + (size_t)row * 8), p1 = *(const f32x4*)(rstd + (size_t)row * 8 + 4);
        const float r = rsqrtf(((p0[0] + p0[1]) + (p0[2] + p0[3]) + (p1[0] + p1[1]) + (p1[2] + p1[3])) * (1.f / DM) + EPS); a = a * r; b = b * r;
        const int sec = col >> 11, c = col & 2047;
        if (sec == 3) {
#pragma unroll
            for (int i = 0; i < 4; ++i) { a[i] = a[i] * sigmoidf_(a[i]); b[i] = b[i] * sigmoidf_(b[i]); } }
        const int bb = row >> 12, t = row & 4095, hh = c >> 7, d = c & 127;
        store8(kb + (size_t)sec * (16u << 20) + ((size_t)(bb * NH + hh) * SEQ) * HD + attn::hm16(t, d), a, b);
    }
};

#ifndef SSM_PF_U
#define SSM_PF_U 1
#endif
__device__ __forceinline__ void sincos_small(float x, float& s, float& c) {
    const float k = rintf(x * 0.63661977236758134f);
    float r = fmaf(-k, 1.57079625129699707031f, x); r = fmaf(-k, 7.54978941586159635335e-08f, r);
    const float r2 = r * r;
    const float sp = r + r * r2 * (-1.6666666666666666e-1f + r2 * (8.3333333333333332e-3f + r2 * (-1.9841269841269841e-4f + r2 * 2.7557319223985893e-6f)));
    const float cp = 1.f + r2 * (-0.5f + r2 * (4.1666666666666664e-2f + r2 * (-1.3888888888888889e-3f + r2 * (2.4801587301587302e-5f + r2 * -2.7557319223985888e-7f))));
    const int q = (int)k & 3;
    s = (q == 0) ? sp : (q == 1) ? cp : (q == 2) ? -sp : -cp;
    c = (q == 0) ? cp : (q == 1) ? -sp : (q == 2) ? -cp : sp;
}
__device__ __forceinline__ float gelu_tanh(float x) { const float u = 1.5957691216057308f * (x + 0.044715f * x * x * x); return x * sigmoidf_(u); }
__device__ __forceinline__ void ssm_phase(const Params& P, LAS unsigned char* lds, const int tid) {
    const int wv = __builtin_amdgcn_readfirstlane(tid >> 6);
    const float* a_re = P.in[4]; const float* a_im = P.in[5]; const float* log_dt = P.in[6]; const float* b_re = P.in[7]; const float* b_im = P.in[8];
    const float* c_re = P.in[9]; const float* c_im = P.in[10]; const float* dsk = P.in[11];
    const bf16_t* ug = (const bf16_t*)(P.ws + WS_S1); bf16_t* y1 = (bf16_t*)(P.ws + WS_S0);
    LAS float* Sst = (LAS float*)lds;
    LAS unsigned char* img = lds + 8192 + wv * 8704;
    for (int bg = blockIdx.x; bg < NB * NG; bg += gridDim.x) {
        int lane = tid & 63; asm volatile("" : "+v"(lane));
        const int n = lane & 31, hi = lane >> 5, l15 = lane & 15, kq = lane >> 4;
        const int b = bg >> 7, g = bg & 127;
        const float dt = expf(log_dt[g]);
        float abr[2], abi[2], qr_[2], qi_[2]; bf16x8 Bf[4];
#pragma unroll
        for (int ph = 0; ph < 2; ++ph) {
            const int p = ph * 32 + n; const float ar = a_re[g * 64 + p], ai = a_im[g * 64 + p];
            const float mag = expf(ar * dt); float cs, sn; sincos_small(ai * dt, sn, cs);
            abr[ph] = mag * cs; abi[ph] = mag * sn;
            const float den = ar * ar + ai * ai, nr = abr[ph] - 1.f;
            const float cr = (nr * ar + abi[ph] * ai) / den, ci = (abi[ph] * ar - nr * ai) / den;
            float pr = abr[ph], pi = abi[ph];
#pragma unroll
            for (int i = 0; i < 8; ++i) { const float t2 = pr * pr - pi * pi; pi = 2.f * pr * pi; pr = t2; }
            qr_[ph] = pr; qi_[ph] = pi;
            const float* brp = b_re + ((size_t)(g * 64 + p) * 16 + 8 * hi); const float* bip = b_im + ((size_t)(g * 64 + p) * 16 + 8 * hi);
            const f32x4 r0 = *(const f32x4*)brp, r1 = *(const f32x4*)(brp + 4), i0 = *(const f32x4*)bip, i1 = *(const f32x4*)(bip + 4);
            const f32x4 xr0 = r0 * cr - i0 * ci, xr1 = r1 * cr - i1 * ci, xi0 = i0 * cr + r0 * ci, xi1 = i1 * cr + r1 * ci;
            u32x4 wr_, wi_; wr_.x = cvtpk(xr0[0], xr0[1]); wr_.y = cvtpk(xr0[2], xr0[3]); wr_.z = cvtpk(xr1[0], xr1[1]); wr_.w = cvtpk(xr1[2], xr1[3]);
            wi_.x = cvtpk(xi0[0], xi0[1]); wi_.y = cvtpk(xi0[2], xi0[3]); wi_.z = cvtpk(xi1[0], xi1[1]); wi_.w = cvtpk(xi1[2], xi1[3]);
            Bf[ph * 2 + 0] = __builtin_bit_cast(bf16x8, wr_); Bf[ph * 2 + 1] = __builtin_bit_cast(bf16x8, wi_);
        }
        bf16x8 Cf[4], Df;
#pragma unroll
        for (int kk = 0; kk < 4; ++kk) {
            const f32x4 cr4 = *(const f32x4*)(c_re + (size_t)(g * 16 + l15) * 64 + kk * 16 + 4 * kq), ci4 = *(const f32x4*)(c_im + (size_t)(g * 16 + l15) * 64 + kk * 16 + 4 * kq);
            u32x4 w; w.x = cvtpk(cr4[0], -ci4[0]); w.y = cvtpk(cr4[1], -ci4[1]); w.z = cvtpk(cr4[2], -ci4[2]); w.w = cvtpk(cr4[3], -ci4[3]);
            Cf[kk] = __builtin_bit_cast(bf16x8, w);
        }
        { const float dv = dsk[g * 16 + l15]; float e[8];
#pragma unroll
          for (int j = 0; j < 8; ++j) e[j] = (kq < 2 && 8 * kq + j == l15) ? dv : 0.f;
          u32x4 w; w.x = cvtpk(e[0], e[1]); w.y = cvtpk(e[2], e[3]); w.z = cvtpk(e[4], e[5]); w.w = cvtpk(e[6], e[7]); Df = __builtin_bit_cast(bf16x8, w); }
        const bf16_t* ugb = ug + (size_t)bg * SEQ * 16;
        bf16_t* y1b = y1 + (size_t)b * SEQ * DM + g * 16;
        const int sm = (n >> 2) & 1, jm = (n & 3) + 4 * (n >> 3);
        float Hr[2] = {0.f, 0.f}, Hi[2] = {0.f, 0.f};
        for (int pass = 0; pass < 2; ++pass) {
            float hr[2] = {Hr[0], Hr[1]}, hi_[2] = {Hi[0], Hi[1]};
            const char* ugc = (const char*)ugb;
            const unsigned offA = (unsigned)(((wv * 2 + sm) * 256 + jm) * 16 + 8 * hi) * 2u;
            const unsigned offU = (unsigned)((wv * 2 * 256 + l15) * 16 + 8 * (kq & 1)) * 2u;
            bf16x8 Afn = *(const bf16x8*)(ugc + offA);
            for (int step = 0; step < 16; ++step) {
                const bf16x8 Af = Afn;
                if (step < 15) Afn = *(const bf16x8*)(ugc + (offA + (unsigned)(step + 1) * 512u));
#if SSM_PF_U
                bf16x8 Au0 = {0, 0, 0, 0, 0, 0, 0, 0}, Au1 = {0, 0, 0, 0, 0, 0, 0, 0};
                if (pass == 1 && kq < 2) { Au0 = *(const bf16x8*)(ugc + (offU + (unsigned)step * 512u)); Au1 = *(const bf16x8*)(ugc + (offU + 8192u + (unsigned)step * 512u)); }
#endif
                f32x16 x[4];
#pragma unroll
                for (int f = 0; f < 4; ++f) { f32x16 z16 = {}; x[f] = __builtin_amdgcn_mfma_f32_32x32x16_bf16(Af, Bf[f], z16, 0, 0, 0); }
                __builtin_amdgcn_sched_barrier(0);
#pragma unroll
                for (int r = 0; r < 16; ++r)
#pragma unroll
                    for (int ph = 0; ph < 2; ++ph) {
                        float t0 = fmaf(-abi[ph], hi_[ph], x[2 * ph][r]), t1 = fmaf(abi[ph], hr[ph], x[2 * ph + 1][r]);
                        asm("" : "+v"(t0)); asm("" : "+v"(t1));
                        float nr_ = fmaf(abr[ph], hr[ph], t0), ni_ = fmaf(abr[ph], hi_[ph], t1);
                        asm("" : "+v"(nr_)); asm("" : "+v"(ni_));
                        hr[ph] = nr_; hi_[ph] = ni_; x[2 * ph][r] = nr_; x[2 * ph + 1][r] = ni_;
                    }
                __builtin_amdgcn_sched_barrier(0);
                if (pass == 1) {
#pragma unroll
                    for (int ph = 0; ph < 2; ++ph)
#pragma unroll
                        for (int r = 0; r < 16; ++r) *(LAS unsigned*)(img + (hi * 16 + r) * 272 + (ph * 32 + n) * 4) = cvtpk(x[2 * ph][r], x[2 * ph + 1][r]);
                    asm volatile("s_waitcnt lgkmcnt(0)" ::: "memory");
#pragma unroll
                    for (int s2 = 0; s2 < 2; ++s2) {
                        __builtin_amdgcn_sched_barrier(0);
                        f32x4 acc = {0.f, 0.f, 0.f, 0.f};
#pragma unroll
                        for (int kk = 0; kk < 4; ++kk) { const bf16x8 Ah = *(const LAS bf16x8*)(img + (s2 * 16 + l15) * 272 + kk * 64 + kq * 16);
                            acc = __builtin_amdgcn_mfma_f32_16x16x32_bf16(Ah, Cf[kk], acc, 0, 0, 0); }
                        const int tokb = (wv * 2 + s2) * 256 + step * 16;
#if SSM_PF_U
                        acc = __builtin_amdgcn_mfma_f32_16x16x32_bf16(s2 ? Au1 : Au0, Df, acc, 0, 0, 0);
#else
                        { bf16x8 Au = {0, 0, 0, 0, 0, 0, 0, 0}; if (kq < 2) Au = *(const bf16x8*)(ugc + (offU + (unsigned)s2 * 8192u + (unsigned)step * 512u));
                          acc = __builtin_amdgcn_mfma_f32_16x16x32_bf16(Au, Df, acc, 0, 0, 0); }
#endif
#pragma unroll
                        for (int i = 0; i < 4; ++i) { const float yv = gelu_tanh(acc[i]); const int t = tokb + 4 * kq + i;
                            *(bf16_t*)((char*)y1b + ((unsigned)t * (unsigned)DM + (unsigned)l15) * 2u) = (bf16_t)(cvtpk(yv, yv) & 0xffffu); }
                    }
                    asm volatile("s_waitcnt lgkmcnt(0)" ::: "memory");
                }
            }
            if (pass == 0) {
                const int seg = wv * 2 + hi;
#pragma unroll
                for (int ph = 0; ph < 2; ++ph) { Sst[(seg * 64 + ph * 32 + n) * 2 + 0] = hr[ph]; Sst[(seg * 64 + ph * 32 + n) * 2 + 1] = hi_[ph]; }
                __syncthreads();
#pragma unroll
                for (int ph = 0; ph < 2; ++ph) { float cr_ = 0.f, ci_ = 0.f;
#pragma nounroll
                    for (int v = 0; v < 15; ++v) { if (v < seg) { const float sr = Sst[(v * 64 + ph * 32 + n) * 2 + 0], si = Sst[(v * 64 + ph * 32 + n) * 2 + 1];
                        const float t2 = qr_[ph] * cr_ - qi_[ph] * ci_ + sr; ci_ = qr_[ph] * ci_ + qi_[ph] * cr_ + si; cr_ = t2; } }
                    Hr[ph] = cr_; Hi[ph] = ci_; }
                __syncthreads();
            }
        }
    }
}

template <bool FIRST> __device__ __forceinline__ void row_phase(const Params& P, const int tid) {
    const int lane = tid & 63, wave = tid >> 6;
    const int gw = blockIdx.x * 8 + wave, NGW = gridDim.x * 8;
    const bf16_t* O = (const bf16_t*)(P.ws + WS_S3); const float* X = FIRST ? P.in[0] : P.out; float* OUT = P.out;
    const float* gp = P.in[2] + (FIRST ? 0 : DM);
    float* rstd1 = (float*)(P.ws + WS_MISC + MISC_RSTD1); bf16_t* h1b = (bf16_t*)(P.ws + WS_S0);
    for (int m = gw; m < T; m += NGW) {
        const u32x2* orow = (const u32x2*)(O + (size_t)m * DM) + lane; const f32x4* xrow = (const f32x4*)(X + (size_t)m * DM) + lane; f32x4* outr = (f32x4*)(OUT + (size_t)m * DM) + lane;
        f32x4 o[8]; float ss = 0.f;
#pragma unroll
        for (int j = 0; j < 8; ++j) { const u32x2 w = orow[64 * j]; o[j] = (f32x4){bflo(w.x), bfhi(w.x), bflo(w.y), bfhi(w.y)}; ss += (o[j][0] * o[j][0] + o[j][1] * o[j][1]) + (o[j][2] * o[j][2] + o[j][3] * o[j][3]); }
        const float rs = rsqrtf(wave_sum(ss) * (1.f / DM) + EPS);
        float ss1 = 0.f;
#pragma unroll
        for (int j = 0; j < 8; ++j) { const f32x4 g4 = ((const f32x4*)gp)[lane + 64 * j]; const f32x4 xv = xrow[64 * j]; o[j] = xv + o[j] * rs * g4; outr[64 * j] = o[j];
            ss1 += (o[j][0] * o[j][0] + o[j][1] * o[j][1]) + (o[j][2] * o[j][2] + o[j][3] * o[j][3]); }
        if (FIRST) {
            const float r1 = rsqrtf(wave_sum(ss1) * (1.f / DM) + EPS);
            if (lane == 0) rstd1[m] = r1;
            u32x2* o8 = (u32x2*)(h1b + (size_t)m * DM) + lane;
#pragma unroll
            for (int j = 0; j < 8; ++j) { u32x2 w; w.x = cvtpk(o[j][0], o[j][1]); w.y = cvtpk(o[j][2], o[j][3]); o8[64 * j] = w; }
        }
    }
}

__device__ __forceinline__ void logf_phase(const Params& P, LAS unsigned char* lds, const int tid) {
    const int lane = tid & 63, wv = __builtin_amdgcn_readfirstlane(tid >> 6), l15 = lane & 15, kq = lane >> 4;
    const bf16_t* h1b = (const bf16_t*)(P.ws + WS_S0); const bf16_t* wfT = (const bf16_t*)(P.ws + WS_MISC + MISC_WFT);
    const float* rstd1 = (const float*)(P.ws + WS_MISC + MISC_SLOTS) + 65536; const float* bfv = P.in[17];   float* logf = (float*)(P.ws + WS_MISC + MISC_LOGF);
    LAS float* part = (LAS float*)lds;
    for (int rt = blockIdx.x; rt < T / 16; rt += 2 * gridDim.x) {
        const int rt1 = (rt + (int)gridDim.x < T / 16) ? rt + (int)gridDim.x : rt;
        f32x4 acc0 = {0.f, 0.f, 0.f, 0.f}, acc1 = {0.f, 0.f, 0.f, 0.f};
#pragma unroll
        for (int ks = 0; ks < 8; ++ks) { const int k = wv * 256 + ks * 32 + 8 * kq;
            const bf16x8 Bfr = *(const bf16x8*)(wfT + (size_t)l15 * DM + k);
            const bf16x8 A0 = *(const bf16x8*)(h1b + (size_t)(rt * 16 + l15) * DM + k), A1 = *(const bf16x8*)(h1b + (size_t)(rt1 * 16 + l15) * DM + k);
            acc0 = __builtin_amdgcn_mfma_f32_16x16x32_bf16(A0, Bfr, acc0, 0, 0, 0); acc1 = __builtin_amdgcn_mfma_f32_16x16x32_bf16(A1, Bfr, acc1, 0, 0, 0); }
#pragma unroll
        for (int i = 0; i < 4; ++i) { part[(wv * 16 + 4 * kq + i) * 16 + l15] = acc0[i]; part[2048 + (wv * 16 + 4 * kq + i) * 16 + l15] = acc1[i]; }
        __syncthreads();
        { const int tl = tid >> 8, row = (tid >> 4) & 15, c = tid & 15; float s = 0.f;
#pragma unroll
          for (int w = 0; w < 8; ++w) s += part[tl * 2048 + (w * 16 + row) * 16 + c];
          const int grow = (tl ? rt1 : rt) * 16 + row; const f32x4 q0 = *(const f32x4*)(rstd1 + (size_t)grow * 8), q1 = *(const f32x4*)(rstd1 + (size_t)grow * 8 + 4);
          const float f = s * rsqrtf(((q0[0] + q0[1]) + (q0[2] + q0[3]) + (q1[0] + q1[1]) + (q1[2] + q1[3])) * (1.f / DM) + EPS) + bfv[c];
          const float lf = fminf(f, 0.f) - log1pf(expf(-fabsf(f)));
          logf[((size_t)((grow >> 12) * NH + c)) * SEQ + (grow & 4095)] = lf; }
        __syncthreads();
    }
}

__device__ __forceinline__ void attn_bias_fill(const f32x4 a, const f32x4 c, char* ldsg, const int tid) {
    const int lane = tid & 63, wv = tid >> 6;
    float* bias = (float*)(ldsg + ATT_BIAS_OFF); float* wtot = (float*)(ldsg + ATT_WTOT_OFF);
    float v[8]; v[0] = a[0]; v[1] = v[0] + a[1]; v[2] = v[1] + a[2]; v[3] = v[2] + a[3]; v[4] = v[3] + c[0]; v[5] = v[4] + c[1]; v[6] = v[5] + c[2]; v[7] = v[6] + c[3];
    float sc = v[7];
#pragma unroll
    for (int off = 1; off < 64; off <<= 1) { const float t = __shfl_up(sc, off); if (lane >= off) sc += t; }
    if (lane == 63) wtot[wv] = sc;
    __syncthreads();
    float base = sc - v[7];
    for (int w = 0; w < wv; ++w) base += wtot[w];
    constexpr float INV = -1.f / attn::SCALE;
    f32x4 o0, o1;
    o0[0] = (base + v[0]) * INV; o0[1] = (base + v[1]) * INV; o0[2] = (base + v[2]) * INV; o0[3] = (base + v[3]) * INV;
    o1[0] = (base + v[4]) * INV; o1[1] = (base + v[5]) * INV; o1[2] = (base + v[6]) * INV; o1[3] = (base + v[7]) * INV;
    *(f32x4*)(bias + tid * 8) = o0; *(f32x4*)(bias + tid * 8 + 4) = o1;
    __syncthreads();
}
__device__ __forceinline__ void attn_phase(const Params& P, char* ldsg, const int wv_s) {
    typedef attn::bf16 abf; typedef attn::BlockRef<abf, abf> Ref;
    const abf* Q = (const abf*)(P.ws + WS_S3); const abf* K = (const abf*)(P.ws + WS_S1); const abf* V = (const abf*)(P.ws + WS_S2);
    const bf16_t* Z = (const bf16_t*)(P.ws + WS_S4); abf* AO = (abf*)(P.ws + WS_WIN);
    const float* logf = (const float*)(P.ws + WS_MISC + MISC_LOGF);
    constexpr int NQB = SEQ / 256, NX = NQB / 2, TOTAL = NX * NB * NH;
    const int G = gridDim.x;
    const int L = blockIdx.x;
    if (L >= TOTAL) return;
#define MKREF(r, L_, pass_) do { const int bh_ = (L_) / NX, x_ = (L_) % NX, qb_ = (pass_) ? NQB - 1 - x_ : x_, b_ = bh_ / NH, h_ = bh_ % NH; \
        (r).Q = Q + ((size_t)bh_ * SEQ + (size_t)qb_ * 256) * HD; (r).K = K + (size_t)bh_ * SEQ * HD; (r).V = V + (size_t)bh_ * SEQ * HD; \
        (r).O = AO + ((size_t)b_ * SEQ + (size_t)qb_ * 256) * DM + h_ * HD; (r).Z = Z + ((size_t)bh_ * SEQ + (size_t)qb_ * 256) * HD; (r).P0 = qb_ * 256; } while (0)
    {
        const int tid0 = mk_tid(wv_s); const float* lf = logf + (size_t)(L / NX) * SEQ;
        const f32x4 lfa = *(const f32x4*)(lf + tid0 * 8), lfc = *(const f32x4*)(lf + tid0 * 8 + 4);
        Ref lightb, heavyb; MKREF(lightb, L, 0); MKREF(heavyb, L, 1);
        attn::Seam<abf> S;
        attn::causal_swa_prime<abf, abf>(lightb, SEQ, ldsg, S, mk_tid(wv_s));
        attn_bias_fill(lfa, lfc, ldsg, mk_tid(wv_s));
        for (int pass = 0; pass < 2; ++pass) {
            Ref cur = heavyb; if (pass == 0) cur = lightb;
            attn::causal_swa_block<abf, abf>(cur, heavyb, SEQ, SEQ, ldsg, S, mk_tid(wv_s));
        }
    }
#undef MKREF
}

#define XB_TMO      128
#define XB_XCNT(j)  (256  + 64 * (j))
#define XB_XSUB(j)  (1280 + 64 * (j))
#define XB_XGEN(j)  (2304 + 64 * (j))
#define XB_TOP      3328
#define XB_TOPGEN   3392
#define XCD_BAR_WORDS 3456
#define XB_SPIN_CAP (1u << 18)

__device__ __forceinline__ unsigned xb_ld(unsigned* p)              { return __hip_atomic_load(p, __ATOMIC_RELAXED, __HIP_MEMORY_SCOPE_AGENT); }
__device__ __forceinline__ unsigned xb_add(unsigned* p, unsigned v) { return __hip_atomic_fetch_add(p, v, __ATOMIC_RELAXED, __HIP_MEMORY_SCOPE_AGENT); }
__device__ __forceinline__ unsigned xb_xcc_id() { return (unsigned)__builtin_amdgcn_s_getreg((3 << 11) | 20) & 0xFu; }
#define XB_SPIN(cond, bar) do { unsigned _sp = 0; while (cond) { __builtin_amdgcn_s_sleep(1); \
    if ((++_sp & 255u) == 0u) { if (xb_ld(&(bar)[XB_TMO])) break; if (_sp > XB_SPIN_CAP) { atomicAdd(&(bar)[XB_TMO], 1u); break; } } } } while (0)

struct XcdBarrier {
    unsigned* bar; unsigned x;
    volatile LAS unsigned* st;
};

__device__ __forceinline__ XcdBarrier xcd_barrier_post(unsigned* bar, volatile LAS unsigned* st, int tid) {
    XcdBarrier b; b.bar = bar; b.x = xb_xcc_id(); b.st = st;
    if (tid == 0) (void)xb_add(&bar[XB_XCNT(b.x)], 1u);
    return b;
}
__device__ __forceinline__ void xcd_barrier_complete(unsigned* bar, unsigned x, unsigned& nloc, unsigned& nx) {
    const unsigned G = gridDim.x * gridDim.y * gridDim.z;
    unsigned sum, cnt, mine, sp = 0u;
    for (;;) {
        sum = 0u; cnt = 0u; mine = 0u;
#pragma unroll
        for (unsigned j = 0; j < 16; ++j) { const unsigned c = xb_ld(&bar[XB_XCNT(j)]); sum += c; cnt += (c > 0u) ? 1u : 0u; mine = (j == x) ? c : mine; }
        if (sum == G) break;
        __builtin_amdgcn_s_sleep(1);
        if ((++sp & 255u) == 0u) { if (xb_ld(&bar[XB_TMO])) break; if (sp > XB_SPIN_CAP) { atomicAdd(&bar[XB_TMO], 1u); break; } }
    }
    nloc = mine > 0u ? mine : 1u; nx = cnt > 0u ? cnt : 1u;
}

__device__ __forceinline__ void xcd_barrier(const XcdBarrier& b, int tid) {
    asm volatile("s_waitcnt vmcnt(0)" ::: "memory");
    __syncthreads();
    if (tid == 0) {
        unsigned* bar = b.bar;
        __builtin_amdgcn_s_waitcnt(0);
        unsigned nloc = b.st[0], nx = b.st[1];
        if (nloc == 0u) { xcd_barrier_complete(bar, b.x, nloc, nx); b.st[0] = nloc; b.st[1] = nx; }
        const unsigned old = xb_add(&bar[XB_XSUB(b.x)], 1u);
        const unsigned gen = old / nloc;
        if (old + 1u == (gen + 1u) * nloc) {
            __builtin_amdgcn_fence(__ATOMIC_RELEASE, "agent");
            asm volatile("s_waitcnt vmcnt(0)" ::: "memory");
            const unsigned og = xb_add(&bar[XB_TOP], 1u);
            const unsigned tg = og / nx;
            if (og + 1u == (tg + 1u) * nx) xb_add(&bar[XB_TOPGEN], 1u);
            else XB_SPIN(xb_ld(&bar[XB_TOPGEN]) == tg, bar);
            __builtin_amdgcn_fence(__ATOMIC_ACQUIRE, "agent");
            asm volatile("s_waitcnt vmcnt(0)" ::: "memory");
        } else {
            XB_SPIN(xb_ld(&bar[XB_TOPGEN]) == gen, bar);
            __builtin_amdgcn_fence(__ATOMIC_ACQUIRE, "agent");
            asm volatile("s_waitcnt vmcnt(0)" ::: "memory");
        }
    }
    __syncthreads();
}

__global__ void __launch_bounds__(512, 2) yoco_fwd(Params P) {
    extern __shared__ __attribute__((aligned(16))) unsigned char lds_raw[];
    LAS unsigned char* lds = (LAS unsigned char*)lds_raw;
    cg::grid_group grid = cg::this_grid();
    const int lo = P.ph_lo, hi = P.ph_hi;
    typedef const __attribute__((address_space(4))) Params* KPtr;
    const KPtr kp0 = (KPtr)__builtin_amdgcn_kernarg_segment_ptr();
    const int wv_s = __builtin_amdgcn_readfirstlane((int)threadIdx.x >> 6);
    volatile LAS unsigned* bst = (volatile LAS unsigned*)(lds + LDS_TOTAL - 64);
    if (threadIdx.x < 2) bst[threadIdx.x] = 0u;
    __syncthreads();
    XcdBarrier bar;
    { KPtr kq_ = kp0; asm volatile("" : "+s"(kq_)); bar = xcd_barrier_post((unsigned*)(kq_->ws + WS_MISC + MISC_CTL), bst, threadIdx.x); }
    if (P.ph_hi == 0x7fffffff) grid.sync();
#define LOADP() KPtr kp_ = kp0; asm volatile("" : "+s"(kp_)); Params Q; _Pragma("unroll") for (int i_ = 0; i_ < 20; ++i_) Q.in[i_] = kp_->in[i_]; Q.out = kp_->out; Q.ws = kp_->ws; Q.ph_lo = 0; Q.ph_hi = 0; unsigned char* ws = Q.ws
#ifndef PHMASK
#define PHMASK 0x3ff
#endif
#define IN(k) (((PHMASK >> (k)) & 1) && lo <= (k) && (k) < hi)
#ifndef DUPMASK
#define DUPMASK 0
#endif
#define DUP(k) for (int rep_ = 0; rep_ < 1 + ((DUPMASK >> (k)) & 1); ++rep_)
#define SEAM(k) do { if (IN(k) && IN((k) + 1)) xcd_barrier(bar, mk_tid(wv_s)); } while (0)
    if (IN(0)) { LOADP(); (void)ws; p0_phase(Q, lds, mk_tid(wv_s)); __syncthreads(); if (DUPMASK & 1) { p0_phase(Q, lds, mk_tid(wv_s)); __syncthreads(); } } SEAM(0);
    if (IN(1)) DUP(1) { LOADP(); pg8::Gemm g{(const bf16_t*)(ws + WS_S3), (const bf16_t*)(ws + WS_WIN), T, 2 * DM, DM}; pg8::StaticOrder S; S.init(T, 2 * DM, gridDim.x, blockIdx.x);
        pg8::EpiRow8<F1> E{F1{(const float*)(ws + WS_MISC + MISC_RSTD0), (bf16_t*)(ws + WS_S1), (bf16_t*)(ws + WS_S2)}};
        pg8::gemm_phase<pg8::EpiRow8<F1>, pg8::StaticOrder, true, true>(lds, g, S, E, mk_tid(wv_s)); } SEAM(1);
    if (IN(2)) DUP(2) { LOADP(); (void)ws; ssm_phase(Q, lds, mk_tid(wv_s)); __syncthreads(); } SEAM(2);
    if (IN(3)) DUP(3) { LOADP(); pg8::Gemm g{(const bf16_t*)(ws + WS_S0), (const bf16_t*)(ws + WS_WGLU), T, DM, DM}; pg8::StaticOrder S; S.init(T, DM, gridDim.x, blockIdx.x);
        pg8::EpiRow8<F2> E{F2{Q.in[13], (const bf16_t*)(ws + WS_S0), (const bf16_t*)(ws + WS_S2), (bf16_t*)(ws + WS_S1)}};
        pg8::gemm_phase<pg8::EpiRow8<F2>, pg8::StaticOrder, true, true>(lds, g, S, E, mk_tid(wv_s)); } SEAM(3);
    if (IN(4)) DUP(4) { LOADP(); pg8::Gemm g{(const bf16_t*)(ws + WS_S1), (const bf16_t*)(ws + WS_WOUT), T, DM, DM}; pg8::StaticOrder S; S.init(T, DM, gridDim.x, blockIdx.x);
        unsigned* cnts = (unsigned*)(ws + WS_MISC + MISC_CTL + 16384); float* slots = (float*)(ws + WS_MISC + MISC_SLOTS);
        pg8::EpiNormRes<true> E{nullptr, (const bf16_t*)(ws + WS_S3), nullptr, Q.in[2], (bf16_t*)(ws + WS_S0), pg8::RowStat{slots, cnts, nullptr}, pg8::RowStat{slots + 65536, cnts + 2048, (float*)(ws + WS_MISC + MISC_RSTD1)}};
        pg8::gemm_phase<pg8::EpiNormRes<true>, pg8::StaticOrder, false, true>(lds, g, S, E, mk_tid(wv_s)); }
    if (IN(4) && IN(6)) xcd_barrier(bar, mk_tid(wv_s));
    if (IN(6)) DUP(6) { LOADP(); logf_phase(Q, lds, mk_tid(wv_s));
        pg8::Gemm g{(const bf16_t*)(ws + WS_S0), (const bf16_t*)(ws + WS_WCAT), T, 4 * DM, DM}; pg8::StaticOrder S; S.init(T, 4 * DM, gridDim.x, blockIdx.x);
        pg8::EpiRow8<F4> E{F4{(const float*)(ws + WS_MISC + MISC_SLOTS) + 65536, (bf16_t*)(ws + WS_S1), (bf16_t*)(ws + WS_S2), (bf16_t*)(ws + WS_S3), (bf16_t*)(ws + WS_S4)}};
        pg8::gemm_phase<pg8::EpiRow8<F4>, pg8::StaticOrder, true, true>(lds, g, S, E, mk_tid(wv_s)); } SEAM(6);
    if (IN(7)) { LOADP(); (void)ws; attn_phase(Q, (char*)lds_raw, wv_s); }

    if (IN(7) && IN(8)) xcd_barrier(bar, mk_tid(wv_s));
    if (IN(8)) DUP(8) { LOADP(); pg8::Gemm g{(const bf16_t*)(ws + WS_WIN), (const bf16_t*)(ws + WS_WFO), T, DM, DM}; pg8::StaticOrder S; S.init(T, DM, gridDim.x, blockIdx.x);
        unsigned* cnts = (unsigned*)(ws + WS_MISC + MISC_CTL + 16384); float* slots = (float*)(ws + WS_MISC + MISC_SLOTS);
        pg8::EpiNormRes<false> E{nullptr, (const bf16_t*)(ws + WS_S0), Q.out, Q.in[2] + DM, nullptr, pg8::RowStat{slots + 131072, cnts + 4096, nullptr}, pg8::RowStat{nullptr, nullptr, nullptr}};
        pg8::gemm_phase<pg8::EpiNormRes<false>, pg8::StaticOrder, false, true>(lds, g, S, E, mk_tid(wv_s)); }
#undef IN
#undef SEAM
#undef LOADP
}

#ifndef N_LAUNCHES
#define N_LAUNCHES 1
#endif
extern "C" void kernel_launch(void* const* d_in, const int* in_sizes, int n_in, void* d_out, int out_size, void* d_ws, size_t ws_size, hipStream_t stream) {
    static int grid = 0;
    if (grid == 0) {
        if (n_in != 20 || out_size != T * DM || ws_size < 256 * MiB) { fprintf(stderr, "kernel_launch: unexpected shapes (n_in %d out %d ws %zu)\n", n_in, out_size, ws_size); grid = -1; return; }
        int dev = 0, cus = 0, per_cu = 0;
        (void)hipGetDevice(&dev); (void)hipDeviceGetAttribute(&cus, hipDeviceAttributeMultiprocessorCount, dev);
        if (hipFuncSetAttribute((const void*)yoco_fwd, hipFuncAttributeMaxDynamicSharedMemorySize, LDS_TOTAL) != hipSuccess) { fprintf(stderr, "kernel_launch: hipFuncSetAttribute failed\n"); grid = -1; return; }
        if (hipOccupancyMaxActiveBlocksPerMultiprocessor(&per_cu, (const void*)yoco_fwd, 512, LDS_TOTAL) != hipSuccess || per_cu < 1) { fprintf(stderr, "kernel_launch: occupancy query says %d\n", per_cu); per_cu = 1; }
        (void)hipGetLastError();
        if (cus <= 0) cus = 256;
        grid = cus * (per_cu > 1 ? 1 : per_cu);
        if (grid != 256) { fprintf(stderr, "kernel_launch: this kernel needs exactly 256 workgroups (one per CU of a 256-CU device), got %d; nothing launched\n", grid); grid = -1; return; }
    }
    if (grid < 0) return;
    if (hipMemsetAsync((char*)d_ws + WS_MISC + MISC_CTL, 0, 65536, stream) != hipSuccess) { fprintf(stderr, "kernel_launch: memset failed\n"); return; }
    Params p{};
    for (int i = 0; i < 20; ++i) p.in[i] = (const float*)d_in[i];
    p.out = (float*)d_out; p.ws = (unsigned char*)d_ws;
#if N_LAUNCHES == 1
    p.ph_lo = 0; p.ph_hi = 10;
    void* args[] = {&p};
    hipError_t e = hipLaunchCooperativeKernel((const void*)yoco_fwd, dim3(grid), dim3(512), args, LDS_TOTAL, stream);
    if (e != hipSuccess) fprintf(stderr, "cooperative launch failed: %s (grid %d)\n", hipGetErrorString(e), grid);
#else
    for (int k = 0; k < 10; ++k) { p.ph_lo = k; p.ph_hi = k + 1; hipLaunchKernelGGL(yoco_fwd, dim3(grid), dim3(512), LDS_TOTAL, stream, p); }
#endif
}
```

```cpp
#include <hip/hip_runtime.h>
#include <hip/hip_bf16.h>
#include <hip/hip_cooperative_groups.h>
#include <cstdio>
#include <cstdint>
namespace cg = cooperative_groups;
namespace pg8 {
#define PG8_LAS __attribute__((address_space(3)))
typedef unsigned short bf16_t;
typedef short bf16x8 __attribute__((ext_vector_type(8)));
typedef float f32x4 __attribute__((ext_vector_type(4)));
typedef unsigned u32x4 __attribute__((ext_vector_type(4)));
constexpr int BM = 256, BK = 64, HALF = 128, HTB = HALF * BK * 2  , STAGE_BYTES = 8 * HTB, NXCD = 8, WGM = 8;

__host__ __device__ __forceinline__ int lds_byte(int r, int c) { const int st = (r >> 4) * 2 + (c >> 5), rr = r & 15, cc = c & 31, ob = rr * 64 + cc * 2; return st * 1024 + (ob ^ (((ob >> 9) & 1) << 5)); }
__host__ __device__ __forceinline__ void stage_rc(int b, int& R, int& C) { const int st = b / 1024, sb = b % 1024, swz = sb ^ (((sb >> 9) & 1) << 5); R = (st >> 1) * 16 + swz / 64; C = (st & 1) * 32 + (swz % 64) / 2; }
__host__ __device__ __forceinline__ int perm32(int rho) { const int n = rho >> 4, i = rho & 15; return 8 * (i >> 2) + 4 * n + (i & 3); }

struct Unit { int pm, pn; };
struct Gemm { const bf16_t* A; const bf16_t* Bt; int M, N, K; };

struct StaticOrder {
    int nM, nN, nwg, G, c;
    __host__ __device__ void init(int M, int N, int G_, int c_) { nM = M / BM; nN = N / BM; nwg = nM * nN; G = G_; c = c_; }
    __host__ __device__ bool next(int i, Unit& u) const {
        const long L = (long)i * G + c; if (L >= nwg) return false;
        int wgid = (int)L; { const int q = nwg / NXCD, r = nwg % NXCD, xcd = wgid % NXCD, off = wgid / NXCD; wgid = (xcd < r ? xcd * (q + 1) : r * (q + 1) + (xcd - r) * q) + off; }
        const int nig = WGM * nN, gid = wgid / nig, fm = gid * WGM, gsz = (nM - fm) < WGM ? (nM - fm) : WGM;
        u.pm = fm + ((wgid % nig) % gsz); u.pn = (wgid % nig) / gsz; return true;
    }
    __device__ __forceinline__ void a_ready(const Unit&) const {}
    __device__ __forceinline__ void done(const Unit&) const {}
};

__device__ __forceinline__ unsigned cvt_pk_bf16(float lo, float hi) { unsigned r; asm volatile("v_cvt_pk_bf16_f32 %0, %1, %2" : "=v"(r) : "v"(lo), "v"(hi)); return r; }
typedef float f32x2 __attribute__((ext_vector_type(2)));
template <class F> struct EpiRow8 {
    static constexpr bool PERM = true, AFTER_DRAIN = false;
    F f;
    __device__ __forceinline__ void operator()(const f32x4 (&acc)[2][2][4][2], const Unit& u, int wr, int wc, int fr, int fq) const {
        const int row0 = u.pm * BM + wr * 64 + fr, col0 = u.pn * BM + wc * 32 + 8 * fq;
#pragma unroll
        for (int ai = 0; ai < 2; ++ai)
#pragma unroll
            for (int m = 0; m < 4; ++m)
#pragma unroll
                for (int bj = 0; bj < 2; ++bj) f(row0 + ai * HALF + m * 16, col0 + bj * HALF, acc[ai][bj][m][0], acc[ai][bj][m][1]);
    }
    __device__ __forceinline__ void fused(f32x4 (&)[2][2][4][2], const Unit&, int, int, int, int, PG8_LAS unsigned char*, int, int) const {}
};
struct RowStat {
    float* slots;
    unsigned* cnt;
    float* rstd_out;
    __device__ __forceinline__ void run(const f32x4 (&v)[2][2][4][2], const Unit& u, int wr, int wc, int fr, int fq, PG8_LAS unsigned char* lds, int wid, int lane) const {
        PG8_LAS float* Pp = (PG8_LAS float*)lds;
        PG8_LAS float* S = (PG8_LAS float*)(lds + 4096);
#pragma unroll
        for (int ai = 0; ai < 2; ++ai)
#pragma unroll
            for (int m = 0; m < 4; ++m) {
                float s = 0.f;
#pragma unroll
                for (int bj = 0; bj < 2; ++bj)
#pragma unroll
                    for (int n = 0; n < 2; ++n) { const f32x4 x = v[ai][bj][m][n]; s += (x[0] * x[0] + x[1] * x[1]) + (x[2] * x[2] + x[3] * x[3]); }
                s += __shfl_xor(s, 16); s += __shfl_xor(s, 32);
                if (fq == 0) Pp[(ai * HALF + wr * 64 + m * 16 + fr) * 4 + wc] = s;
            }
        asm volatile("s_waitcnt lgkmcnt(0)" ::: "memory"); __builtin_amdgcn_s_barrier(); asm volatile("" ::: "memory");
        const int row = wid * 32 + (lane & 31);
        if (lane < 32) {
            const float t = (Pp[row * 4 + 0] + Pp[row * 4 + 1]) + (Pp[row * 4 + 2] + Pp[row * 4 + 3]);
            __hip_atomic_store(slots + (size_t)(u.pm * BM + row) * 8 + u.pn, t, __ATOMIC_RELAXED, __HIP_MEMORY_SCOPE_AGENT);
        }
        asm volatile("s_waitcnt vmcnt(0)" ::: "memory");
        if (lane == 0) __hip_atomic_fetch_add(cnt + 64 * u.pm, 1u, __ATOMIC_RELAXED, __HIP_MEMORY_SCOPE_AGENT);
        if (wid == 0) {
            unsigned spins = 0;
            while ((unsigned)__builtin_amdgcn_readfirstlane(__hip_atomic_load(cnt + 64 * u.pm, __ATOMIC_RELAXED, __HIP_MEMORY_SCOPE_AGENT)) < 64u) { __builtin_amdgcn_s_sleep(2); if (++spins > (1u << 22)) break; }
            __builtin_amdgcn_fence(__ATOMIC_ACQUIRE, "agent");
        }
        asm volatile("s_waitcnt vmcnt(0) lgkmcnt(0)" ::: "memory"); __builtin_amdgcn_s_barrier(); asm volatile("" ::: "memory");
        if (lane < 32) {
            const float* sl = slots + (size_t)(u.pm * BM + row) * 8; float t = 0.f;
#pragma unroll
            for (int k = 0; k < 8; ++k) t += __hip_atomic_load(sl + k, __ATOMIC_RELAXED, __HIP_MEMORY_SCOPE_AGENT);
            const float rs = rsqrtf(t * (1.f / 2048.f) + 1e-6f);
            S[row] = rs;
            if (rstd_out && u.pn == 0) rstd_out[u.pm * BM + row] = rs;
        }
        asm volatile("s_waitcnt lgkmcnt(0)" ::: "memory"); __builtin_amdgcn_s_barrier(); asm volatile("" ::: "memory");
    }
};
template <bool SECOND> struct EpiNormRes {
    static constexpr bool PERM = true, AFTER_DRAIN = true;
    const float* base  ; const bf16_t* base16; float* out; const float* gain; bf16_t* outb; RowStat st1, st2;
    __device__ __forceinline__ void operator()(const f32x4 (&)[2][2][4][2], const Unit&, int, int, int, int) const {}
    __device__ __forceinline__ void fused(f32x4 (&acc)[2][2][4][2], const Unit& u, int wr, int wc, int fr, int fq, PG8_LAS unsigned char* lds, int wid, int lane) const {
        const PG8_LAS float* S = (const PG8_LAS float*)(lds + 4096);
        st1.run(acc, u, wr, wc, fr, fq, lds, wid, lane);
        const int col0 = u.pn * BM + wc * 32 + 8 * fq;
        f32x4 g[2][2];
#pragma unroll
        for (int bj = 0; bj < 2; ++bj) { g[bj][0] = *(const f32x4*)(gain + col0 + bj * HALF); g[bj][1] = *(const f32x4*)(gain + col0 + bj * HALF + 4); }
#pragma unroll
        for (int ai = 0; ai < 2; ++ai)
#pragma unroll
            for (int m = 0; m < 4; ++m) { const int r = ai * HALF + wr * 64 + m * 16 + fr; const float rs = S[r]; const size_t off = (size_t)(u.pm * BM + r) * 2048 + col0; const float bs = SECOND ? base[u.pm * BM + r] : 1.f;
#pragma unroll
                for (int bj = 0; bj < 2; ++bj) {
                    f32x4 b0, b1;
                    { const u32x4 w = *(const u32x4*)(base16 + off + bj * HALF);
                        b0 = (f32x4){__uint_as_float(w.x << 16), __uint_as_float(w.x & 0xffff0000u), __uint_as_float(w.y << 16), __uint_as_float(w.y & 0xffff0000u)};
                        b1 = (f32x4){__uint_as_float(w.z << 16), __uint_as_float(w.z & 0xffff0000u), __uint_as_float(w.w << 16), __uint_as_float(w.w & 0xffff0000u)}; }
                    const f32x4 h0 = b0 * bs + acc[ai][bj][m][0] * rs * g[bj][0], h1 = b1 * bs + acc[ai][bj][m][1] * rs * g[bj][1];
                    if (!SECOND) { *(f32x4*)(out + off + bj * HALF) = h0; *(f32x4*)(out + off + bj * HALF + 4) = h1; }
                    else { acc[ai][bj][m][0] = h0; acc[ai][bj][m][1] = h1;
                        u32x4 w; w.x = cvt_pk_bf16(h0[0], h0[1]); w.y = cvt_pk_bf16(h0[2], h0[3]); w.z = cvt_pk_bf16(h1[0], h1[1]); w.w = cvt_pk_bf16(h1[2], h1[3]);
                        *(u32x4*)(outb + off + bj * HALF) = w; }
                }
                if (m & 1) asm volatile("" ::: "memory"); }
        if (SECOND) st2.run(acc, u, wr, wc, fr, fq, lds, wid, lane);
    }
};
template <class Epi, class Sched, bool ALIGN_EPI = false, bool SP2 = false>
__device__ __forceinline__ void gemm_phase(PG8_LAS unsigned char* lds, const Gemm g, const Sched& S, const Epi& E, const int tid_in) {
    const int tid = tid_in, wid = __builtin_amdgcn_readfirstlane(tid >> 6), lane = tid & 63, wr = wid >> 2, wc = wid & 3, fr = lane & 15, fq = lane >> 4;
    const int K = g.K, nt = K / BK;
    unsigned voffA[2], voffB[2];
#pragma unroll
    for (int i = 0; i < 2; ++i) { int R, C; stage_rc(tid * 16 + i * 8192, R, C); const int Rb = Epi::PERM ? ((R & ~31) + perm32(R & 31)) : R;
        voffA[i] = (unsigned)(R * K + C) * 2u; voffB[i] = (unsigned)(Rb * K + C) * 2u; }
    const size_t kstep = (size_t)(BK * 2);
    const size_t hstep = (size_t)HALF * K * 2;
    const size_t tstep = 2 * hstep;
    const unsigned ldsw = (unsigned)wid * 1024u;
    const int aoff = lds_byte(wr * 64 + fr, fq * 8), boff = lds_byte(wc * 32 + fr, fq * 8);
#define PG8_SA(b, h) (((b) * 2 + (h)) * HTB)
#define PG8_SB(b, h) ((4 + (b) * 2 + (h)) * HTB)
#define PG8_STAGE(bufoff, gbase, voff) do { _Pragma("unroll") for (int _i = 0; _i < 2; ++_i) \
        __builtin_amdgcn_global_load_lds((const unsigned*)((const char*)(gbase) + (voff)[_i]), (PG8_LAS unsigned*)(lds + (bufoff) + ldsw + _i * 8192), 16, 0, 0); } while (0)
#define PG8_LDA(dst, b, h) do { _Pragma("unroll") for (int m = 0; m < 4; ++m) _Pragma("unroll") for (int k = 0; k < 2; ++k) dst[m][k] = *(const PG8_LAS bf16x8*)(lds + PG8_SA(b, h) + aoff + m * 2048 + k * 1024); } while (0)
#define PG8_LDB(dst, b, h) do { _Pragma("unroll") for (int n = 0; n < 2; ++n) _Pragma("unroll") for (int k = 0; k < 2; ++k) dst[n][k] = *(const PG8_LAS bf16x8*)(lds + PG8_SB(b, h) + boff + n * 2048 + k * 1024); } while (0)
#define PG8_MMA(ai, bj, At, Bt) do { __builtin_amdgcn_s_setprio(1); _Pragma("unroll") for (int m = 0; m < 4; ++m) _Pragma("unroll") for (int n = 0; n < 2; ++n) _Pragma("unroll") for (int k = 0; k < 2; ++k) \
        acc[ai][bj][m][n] = __builtin_amdgcn_mfma_f32_16x16x32_bf16(Bt[n][k], At[m][k], acc[ai][bj][m][n], 0, 0, 0); __builtin_amdgcn_s_setprio(0); } while (0)
#define PG8_WAIT_V(n) asm volatile("s_waitcnt vmcnt(" #n ")" ::: "memory")
#define PG8_WAIT_L(n) asm volatile("s_waitcnt lgkmcnt(" #n ")" ::: "memory")
#define PG8_BAR __builtin_amdgcn_s_barrier()
#define PG8_SCHED __builtin_amdgcn_sched_barrier(0)
    Unit cur, nxt; int ui = 0;
    if (!S.next(0, cur)) return;
    f32x4 acc[2][2][4][2];
#pragma unroll
    for (int a = 0; a < 2; ++a)
#pragma unroll
        for (int b = 0; b < 2; ++b)
#pragma unroll
            for (int m = 0; m < 4; ++m)
#pragma unroll
                for (int n = 0; n < 2; ++n) acc[a][b][m][n] = (f32x4){0.f, 0.f, 0.f, 0.f};
    bf16x8 At[4][2], B0[2][2], B1[2][2];
    const char* cA = (const char*)g.A + (size_t)cur.pm * tstep; const char* cB = (const char*)g.Bt + (size_t)cur.pn * tstep;
    S.a_ready(cur);
    if constexpr (SP2) {
        PG8_STAGE(PG8_SB(0, 0), cB, voffB); PG8_STAGE(PG8_SB(0, 1), cB + hstep, voffB); PG8_STAGE(PG8_SA(0, 0), cA, voffA); PG8_STAGE(PG8_SA(0, 1), cA + hstep, voffA);
        if (wr == 1) PG8_BAR;
        PG8_WAIT_V(2); PG8_BAR;
        PG8_STAGE(PG8_SB(1, 0), cB + kstep, voffB); PG8_STAGE(PG8_SA(1, 0), cA + kstep, voffA); PG8_STAGE(PG8_SB(1, 1), cB + hstep + kstep, voffB);
        PG8_WAIT_V(6); PG8_BAR;
    } else {
        PG8_STAGE(PG8_SB(0, 0), cB, voffB); PG8_STAGE(PG8_SA(0, 0), cA, voffA); PG8_STAGE(PG8_SB(0, 1), cB + hstep, voffB); PG8_STAGE(PG8_SA(0, 1), cA + hstep, voffA);
        if (wr == 1) PG8_BAR;
        PG8_WAIT_V(4); PG8_BAR;
        PG8_STAGE(PG8_SB(1, 0), cB + kstep, voffB); PG8_STAGE(PG8_SA(1, 0), cA + kstep, voffA); PG8_STAGE(PG8_SB(1, 1), cB + hstep + kstep, voffB);
        PG8_WAIT_V(6); PG8_BAR;
    }
    for (;;) {
        const bool has_next = S.next(ui + 1, nxt);
        const char* nA = has_next ? (const char*)g.A + (size_t)nxt.pm * tstep : cA; const char* nB = has_next ? (const char*)g.Bt + (size_t)nxt.pn * tstep : cB;
        for (int t = 0; t < nt; t += 2) {
            const bool last = (t == nt - 2);
            const char* a1 = cA + (size_t)(t + 1) * kstep;
            const char* a2 = last ? nA : cA + (size_t)(t + 2) * kstep; const char* b2 = last ? nB : cB + (size_t)(t + 2) * kstep;
            const char* a3 = a2 + kstep; const char* b3 = b2 + kstep;
            if (last && has_next) S.a_ready(nxt);
            if constexpr (SP2) {
            PG8_LDB(B0, 0, 0); PG8_LDB(B1, 0, 1); PG8_SCHED; PG8_LDA(At, 0, 0); PG8_STAGE(PG8_SA(1, 1), a1 + hstep, voffA);
            PG8_WAIT_V(8); PG8_WAIT_L(0); PG8_BAR; PG8_MMA(0, 0, At, B0); PG8_MMA(0, 1, At, B1); PG8_BAR; PG8_SCHED;
            PG8_LDA(At, 0, 1); PG8_STAGE(PG8_SB(0, 0), b2, voffB); PG8_STAGE(PG8_SB(0, 1), b2 + hstep, voffB); PG8_STAGE(PG8_SA(0, 0), a2, voffA);
            PG8_WAIT_V(8); PG8_WAIT_L(0); PG8_BAR; PG8_MMA(1, 0, At, B0); PG8_MMA(1, 1, At, B1); PG8_BAR; PG8_SCHED;
            PG8_LDB(B0, 1, 0); PG8_LDB(B1, 1, 1); PG8_SCHED; PG8_LDA(At, 1, 0); PG8_STAGE(PG8_SA(0, 1), a2 + hstep, voffA);
            PG8_WAIT_V(8); PG8_WAIT_L(0); PG8_BAR; PG8_MMA(0, 0, At, B0); PG8_MMA(0, 1, At, B1); PG8_BAR; PG8_SCHED;
            PG8_LDA(At, 1, 1); PG8_STAGE(PG8_SB(1, 0), b3, voffB); PG8_STAGE(PG8_SB(1, 1), b3 + hstep, voffB); PG8_STAGE(PG8_SA(1, 0), a3, voffA);
            PG8_WAIT_V(8); PG8_WAIT_L(0); PG8_BAR; PG8_MMA(1, 0, At, B0); PG8_MMA(1, 1, At, B1); PG8_BAR; PG8_SCHED;
            } else {
            PG8_LDB(B0, 0, 0); PG8_SCHED; PG8_LDA(At, 0, 0); PG8_STAGE(PG8_SA(1, 1), a1 + hstep, voffA);
            PG8_WAIT_L(8); PG8_BAR; PG8_WAIT_L(0); PG8_MMA(0, 0, At, B0); PG8_BAR; PG8_SCHED;
            PG8_LDB(B1, 0, 1); PG8_STAGE(PG8_SB(0, 0), b2, voffB);
            PG8_BAR; PG8_WAIT_L(0); PG8_MMA(0, 1, At, B1); PG8_BAR;
            PG8_LDA(At, 0, 1); PG8_STAGE(PG8_SA(0, 0), a2, voffA);
            PG8_BAR; PG8_WAIT_L(0); PG8_MMA(1, 0, At, B0); PG8_BAR; PG8_SCHED;
            PG8_STAGE(PG8_SB(0, 1), b2 + hstep, voffB);
            PG8_WAIT_V(6); PG8_BAR; PG8_MMA(1, 1, At, B1); PG8_BAR;
            PG8_LDB(B0, 1, 0); PG8_SCHED; PG8_LDA(At, 1, 0); PG8_STAGE(PG8_SA(0, 1), a2 + hstep, voffA);
            PG8_WAIT_L(8); PG8_BAR; PG8_WAIT_L(0); PG8_MMA(0, 0, At, B0); PG8_BAR; PG8_SCHED;
            PG8_LDB(B1, 1, 1); PG8_STAGE(PG8_SB(1, 0), b3, voffB);
            PG8_BAR; PG8_WAIT_L(0); PG8_MMA(0, 1, At, B1); PG8_BAR;
            PG8_LDA(At, 1, 1); PG8_STAGE(PG8_SA(1, 0), a3, voffA);
            PG8_BAR; PG8_WAIT_L(0); PG8_MMA(1, 0, At, B0); PG8_BAR; PG8_SCHED;
            PG8_STAGE(PG8_SB(1, 1), b3 + hstep, voffB);
            PG8_WAIT_V(6); PG8_BAR; PG8_MMA(1, 1, At, B1); PG8_BAR;
            }
        }
        if constexpr (ALIGN_EPI) { if (wr == 0) PG8_BAR; }
        if constexpr (!Epi::AFTER_DRAIN) { E(acc, cur, wr, wc, fr, fq); S.done(cur); }
        if (!has_next) break;
#pragma unroll
        for (int a = 0; a < 2; ++a)
#pragma unroll
            for (int b = 0; b < 2; ++b)
#pragma unroll
                for (int m = 0; m < 4; ++m)
#pragma unroll
                    for (int n = 0; n < 2; ++n) acc[a][b][m][n] = (f32x4){0.f, 0.f, 0.f, 0.f};
        cur = nxt; cA = nA; cB = nB; ++ui;
        if constexpr (ALIGN_EPI) { if (wr == 1) PG8_BAR; }
    }
    PG8_WAIT_V(0);
    if constexpr (!ALIGN_EPI) { if (wr == 0) PG8_BAR; }
    PG8_BAR;
    if constexpr (Epi::AFTER_DRAIN) { E.fused(acc, cur, wr, wc, fr, fq, lds, wid, lane); S.done(cur); }
#undef PG8_SA
#undef PG8_SB
#undef PG8_STAGE
#undef PG8_LDA
#undef PG8_LDB
#undef PG8_MMA
#undef PG8_WAIT_V
#undef PG8_WAIT_L
#undef PG8_BAR
#undef PG8_SCHED
}
}
namespace attn {
constexpr int D = 128; constexpr float THR = 8.f; constexpr bool WSKIP = false; constexpr int OSTR = 2048, BIAS_OFF = 69632, OST_OFF = 90112;
constexpr float SCALE = 0.08838834764831845f;
constexpr int NW = 8, QBLK = 32, KVBLK = 64, QB = NW * QBLK;
constexpr int SHM_V = KVBLK * D * 2, SHM_K = KVBLK * D * 2;
constexpr int LDS_BYTES = 2 * SHM_V + 2 * SHM_K + NW * 64 * 4;
using bf16 = __hip_bfloat16;
typedef short bf16x8 __attribute__((ext_vector_type(8)));
typedef short s16x4 __attribute__((ext_vector_type(4)));
typedef float f32x16 __attribute__((ext_vector_type(16)));
typedef float f32x4 __attribute__((ext_vector_type(4)));
typedef unsigned u32x4 __attribute__((ext_vector_type(4)));
template <class A, class Bt> struct same_t { static constexpr bool v = false; };
template <class A> struct same_t<A, A> { static constexpr bool v = true; };

#define KSWZ(row, colB) ((row) * 256 + ((colB) ^ (((row) & 7) << 4)))
#define SBAR() __builtin_amdgcn_sched_barrier(0)
__device__ __forceinline__ int v_st(int k, int c) { const int kk = (k & ~0xC) | ((k & 4) << 1) | ((k & 8) >> 1); return ((kk >> 3) * 4 + (c >> 5)) * 512 + ((kk & 7) * 32 + (c & 31)) * 2; }
__device__ __forceinline__ int v_rd_base(int lane) { return ((lane & 3) << 3) | (((lane >> 2) & 3) << 6) | (((lane >> 4) & 1) << 5) | (((lane >> 5) & 1) << 8); }
constexpr int v_rd_off(int d0, int ks, int half) { return d0 * 512 + ks * 4096 + half * 2048; }
__device__ __forceinline__ int crow(int r, int hi) { return (r & 3) + 8 * (r >> 2) + 4 * hi; }
__device__ __forceinline__ unsigned cvtpk(float lo, float hi) {
    unsigned r; asm volatile("v_cvt_pk_bf16_f32 %0, %1, %2" : "=v"(r) : "v"(lo), "v"(hi)); return r;
}
__device__ __forceinline__ bf16x8 pack8(f32x4 a, f32x4 b) {
    u32x4 w = {cvtpk(a[0], a[1]), cvtpk(a[2], a[3]), cvtpk(b[0], b[1]), cvtpk(b[2], b[3])};
    return *reinterpret_cast<bf16x8*>(&w);
}
template <class T> __device__ __forceinline__ bf16x8 load8(const T* p) {
    if constexpr (same_t<T, float>::v) { return pack8(*(const f32x4*)p, *(const f32x4*)(p + 4)); }
    else { return *reinterpret_cast<const bf16x8*>(p); }
}
__device__ __forceinline__ void mask_tile(f32x16& p0, f32x16& p1, int dq, unsigned W) {
    const float NEG = -__builtin_inff();
#pragma unroll
    for (int r = 0; r < 16; ++r) {
        const int c = (r & 3) + 8 * (r >> 2);
        if ((unsigned)(dq - c) >= W) p0[r] = NEG;
        if ((unsigned)(dq - c - 32) >= W) p1[r] = NEG;
    }
}
__device__ __forceinline__ void partialSM(f32x16& p0, f32x16& p1, float& m_reg, float& mn, float& alpha) {
    float pmax = p0[0]; for (int r = 1; r < 16; ++r) pmax = fmaxf(pmax, p0[r]); for (int r = 0; r < 16; ++r) pmax = fmaxf(pmax, p1[r]);
    { auto rr = __builtin_amdgcn_permlane32_swap(__float_as_uint(pmax), __float_as_uint(pmax), false, false);
      pmax = fmaxf(__uint_as_float(rr[0]), __uint_as_float(rr[1])); }
    constexpr float C2 = 1.4426950408889634f * SCALE;
    if (__builtin_expect(__all((pmax - m_reg) * SCALE <= THR), 1)) { mn = m_reg; alpha = 1.f; }
    else { mn = fmaxf(m_reg, pmax); alpha = __builtin_amdgcn_exp2f((m_reg - mn) * C2); m_reg = mn; }
    const float mnL = -mn * C2;
    for (int r = 0; r < 16; ++r) p0[r] = fmaf(p0[r], C2, mnL); for (int r = 0; r < 16; ++r) p1[r] = fmaf(p1[r], C2, mnL);
    for (int r = 0; r < 16; ++r) p0[r] = __builtin_amdgcn_exp2f(p0[r]);
}
__device__ __forceinline__ void finishSM(f32x16& p0, f32x16& p1, float alpha, float& l_reg, bf16x8& pa0, bf16x8& pa1, bf16x8& pa2, bf16x8& pa3) {
    for (int r = 0; r < 16; ++r) p1[r] = __builtin_amdgcn_exp2f(p1[r]);
    float ps = 0; for (int r = 0; r < 16; ++r) ps += p0[r]; for (int r = 0; r < 16; ++r) ps += p1[r];
    { auto rr = __builtin_amdgcn_permlane32_swap(__float_as_uint(ps), __float_as_uint(ps), false, false);
      ps = __uint_as_float(rr[0]) + __uint_as_float(rr[1]); }
    l_reg = l_reg * alpha + ps;
#define PK4(P, B_, OUT) do { unsigned a0 = cvtpk(P[B_+0], P[B_+1]), a1 = cvtpk(P[B_+2], P[B_+3]);                          \
        unsigned b0 = cvtpk(P[B_+4], P[B_+5]), b1 = cvtpk(P[B_+6], P[B_+7]);                                             \
        auto r0 = __builtin_amdgcn_permlane32_swap(a0, b0, false, false); auto r1 = __builtin_amdgcn_permlane32_swap(a1, b1, false, false); \
        u32x4 w = {r0[0], r1[0], r0[1], r1[1]}; OUT = *reinterpret_cast<bf16x8*>(&w); } while (0)
    PK4(p0, 0, pa0); PK4(p0, 8, pa1); PK4(p1, 0, pa2); PK4(p1, 8, pa3);
#undef PK4
}
__device__ __forceinline__ const float* bl_addr(const char* lds, int hi, int kbase) { int h = hi; asm volatile("" : "+v"(h)); return (const float*)(lds + BIAS_OFF) + 4 * h + kbase; }
template <int KB, bool SK>
__device__ __forceinline__ void qkt(f32x16& p0, f32x16& p1, const char* K_lds, int r32, int hi, const bf16x8* qr, bool act, const float* bl) {
    if (SK && !act) { const float NEG = -__builtin_inff();
#pragma unroll
        for (int r = 0; r < 16; ++r) { p0[r] = NEG; p1[r] = NEG; } return; }
    { const f32x4 c0 = *(const f32x4*)(bl), c1 = *(const f32x4*)(bl + 8), c2 = *(const f32x4*)(bl + 16), c3 = *(const f32x4*)(bl + 24);
      const f32x4 e0 = *(const f32x4*)(bl + 32), e1 = *(const f32x4*)(bl + 40), e2 = *(const f32x4*)(bl + 48), e3 = *(const f32x4*)(bl + 56);
      p0 = (f32x16){c0[0], c0[1], c0[2], c0[3], c1[0], c1[1], c1[2], c1[3], c2[0], c2[1], c2[2], c2[3], c3[0], c3[1], c3[2], c3[3]};
      p1 = (f32x16){e0[0], e0[1], e0[2], e0[3], e1[0], e1[1], e1[2], e1[3], e2[0], e2[1], e2[2], e2[3], e3[0], e3[1], e3[2], e3[3]}; }
    const char* kb[4];
#pragma unroll
    for (int dd = 0; dd < 4; ++dd) kb[dd] = K_lds + KB * SHM_K + KSWZ(r32, (dd * 16 + hi * 8) * 2);
#pragma unroll
    for (int d0 = 0; d0 < 8; ++d0) { const char* a = kb[d0 & 3] + (d0 >> 2) * 128;
        bf16x8 b0 = *reinterpret_cast<const bf16x8*>(a);
        bf16x8 b1 = *reinterpret_cast<const bf16x8*>(a + 32 * 256);
        p0 = __builtin_amdgcn_mfma_f32_32x32x16_bf16(b0, qr[d0], p0, 0, 0, 0);
        p1 = __builtin_amdgcn_mfma_f32_32x32x16_bf16(b1, qr[d0], p1, 0, 0, 0); }
}
template <int VB, bool SK>
__device__ __forceinline__ void pv_tile(f32x16* o, int vb0, bf16x8 pa0, bf16x8 pa1, bf16x8 pa2, bf16x8 pa3, bool act) {
    if (SK && !act) return;
#define TRRD(dst, off) asm volatile("ds_read_b64_tr_b16 %0, %1 offset:%2" : "=&v"(dst) : "v"(vb0), "i"(off) : "memory")
#define PV_D0(d0) do { s16x4 l0, l1, l2, l3, h0, h1, h2, h3; constexpr int b_ = VB * SHM_V + v_rd_off(d0, 0, 0);     \
        TRRD(l0, b_); TRRD(h0, b_ + 2048); TRRD(l1, b_ + 4096); TRRD(h1, b_ + 6144); TRRD(l2, b_ + 8192); TRRD(h2, b_ + 10240); TRRD(l3, b_ + 12288); TRRD(h3, b_ + 14336); \
        asm volatile("s_waitcnt lgkmcnt(0)" ::: "memory"); SBAR();                 \
        o[d0] = __builtin_amdgcn_mfma_f32_32x32x16_bf16(pa0, (bf16x8){l0[0], l0[1], l0[2], l0[3], h0[0], h0[1], h0[2], h0[3]}, o[d0], 0, 0, 0);   \
        o[d0] = __builtin_amdgcn_mfma_f32_32x32x16_bf16(pa1, (bf16x8){l1[0], l1[1], l1[2], l1[3], h1[0], h1[1], h1[2], h1[3]}, o[d0], 0, 0, 0);   \
        o[d0] = __builtin_amdgcn_mfma_f32_32x32x16_bf16(pa2, (bf16x8){l2[0], l2[1], l2[2], l2[3], h2[0], h2[1], h2[2], h2[3]}, o[d0], 0, 0, 0);   \
        o[d0] = __builtin_amdgcn_mfma_f32_32x32x16_bf16(pa3, (bf16x8){l3[0], l3[1], l3[2], l3[3], h3[0], h3[1], h3[2], h3[3]}, o[d0], 0, 0, 0); } while (0)
    PV_D0(0); PV_D0(1); PV_D0(2); PV_D0(3);
#undef PV_D0
#undef TRRD
}

template <class TIn, class TOut> struct BlockRef { const TIn* Q; const TIn* K; const TIn* V; TOut* O; const unsigned short* Z; int P0; };
template <class TIn> struct Seam {
    bf16x8 qr[8];
    bf16x8 st_v0, st_v1, st_k0, st_k1; f32x4 sf0, sf1, sf2, sf3;
    f32x4 tq[16];
};
__device__ __forceinline__ int swa_jlo(int P0, int W) { const int lowk = P0 - W + 1; return lowk > 0 ? lowk / KVBLK : 0; }
__device__ __forceinline__ int hm16(int r, int d) { return (r & ~15) * 128 + ((((d >> 5) * 16 + (r & 15)) * 4 + ((d >> 3) & 3)) << 3); }
#define ROW(p, k0, rr) ((p) + (size_t)(k0) * D + hm16((rr), sc))
#define VMW() asm volatile("s_waitcnt vmcnt(0)" ::: "memory")
#define VMWN(n) asm volatile("s_waitcnt vmcnt(%0)" :: "i"(n) : "memory")
#define SLOAD_H(Kp, Vp, k0) do { S.st_v0 = load8<TIn>(ROW(Vp, k0, sr)); S.st_v1 = load8<TIn>(ROW(Vp, k0, 32 + sr));              \
                         S.st_k0 = load8<TIn>(ROW(Kp, k0, sr)); S.st_k1 = load8<TIn>(ROW(Kp, k0, 32 + sr)); } while (0)
#define SWRITE_HK(bf) do { *(bf16x8*)(K_lds + (bf) * SHM_K + kws) = S.st_k0; *(bf16x8*)(K_lds + (bf) * SHM_K + kws + 32 * 256) = S.st_k1; } while (0)
#define SWRITE_HV(bf) do { *(bf16x8*)(V_lds + (bf) * SHM_V + vst0) = S.st_v0; *(bf16x8*)(V_lds + (bf) * SHM_V + vst1) = S.st_v1; } while (0)
#define SWRITE_H(bf) do { SWRITE_HV(bf); SWRITE_HK(bf); } while (0)
#define SLOAD_F(p, k0) do { S.sf0 = *(const f32x4*)ROW(p, k0, sr); S.sf1 = *(const f32x4*)(ROW(p, k0, sr) + 4);                \
                            S.sf2 = *(const f32x4*)ROW(p, k0, 32 + sr); S.sf3 = *(const f32x4*)(ROW(p, k0, 32 + sr) + 4); } while (0)
#define SWRITE_KF(bf) do { *(bf16x8*)(K_lds + (bf) * SHM_K + kws) = pack8(S.sf0, S.sf1); *(bf16x8*)(K_lds + (bf) * SHM_K + kws + 32 * 256) = pack8(S.sf2, S.sf3); } while (0)
#define SWRITE_VF(bf) do { *(bf16x8*)(V_lds + (bf) * SHM_V + vst0) = pack8(S.sf0, S.sf1); *(bf16x8*)(V_lds + (bf) * SHM_V + vst1) = pack8(S.sf2, S.sf3); } while (0)
template <class TIn, class TOut>
__device__ __forceinline__ void causal_swa_prime(const BlockRef<TIn, TOut>& cur, int W, char* lds, Seam<TIn>& S, const int tid_in) {
    constexpr bool F32 = same_t<TIn, float>::v;
    const int tid = tid_in, wid = __builtin_amdgcn_readfirstlane(tid >> 6), lane = tid & 63, r32 = lane & 31, hi = lane >> 5;
    const int sr = tid >> 4, sc = (tid & 15) * 8, kws = KSWZ(sr, sc * 2); char* K_lds = lds + 2 * SHM_V;
    const int kb0 = swa_jlo(cur.P0, W) * KVBLK;
    for (int d0 = 0; d0 < 8; ++d0) S.qr[d0] = load8<TIn>(cur.Q + hm16(wid * QBLK + r32, d0 * 16 + hi * 8));
    if constexpr (F32) { SLOAD_F((const float*)cur.K, kb0); VMW(); SWRITE_KF(0); SBAR(); SLOAD_F((const float*)cur.V, kb0); }
    else { SLOAD_H(cur.K, cur.V, kb0); VMW(); SWRITE_HK(0); }
    __syncthreads();
}
template <class TIn, class TOut>
__device__ __forceinline__ void causal_swa_block(const BlockRef<TIn, TOut>& cur, const BlockRef<TIn, TOut>& nxt, int skv, int W, char* lds, Seam<TIn>& S, const int tid_in) {
    constexpr bool F32 = same_t<TIn, float>::v;
    const int tid = tid_in, wid = __builtin_amdgcn_readfirstlane(tid >> 6), lane = tid & 63, r32 = lane & 31, hi = lane >> 5;
    const int j_lo = swa_jlo(cur.P0, W);
    int j_hi = (cur.P0 + QB - 1) / KVBLK + 1; if (j_hi > skv / KVBLK) j_hi = skv / KVBLK;
    const int NT = j_hi - j_lo;
    const int kbn = swa_jlo(nxt.P0, W) * KVBLK;
    const int qlo = cur.P0 + wid * QBLK, qm = qlo + r32 - 4 * hi;
    char* V_lds = lds; char* K_lds = lds + 2 * SHM_V;
    float* ws = (float*)(lds + 2 * SHM_V + 2 * SHM_K) + wid * 64; float* li_l = ws, * al_l = ws + 32;
    float m_reg = ((const float*)(lds + BIAS_OFF))[cur.P0 + wid * QBLK + r32], l_reg = 0; f32x16 o[4] = {};
    const int sr = tid >> 4, sc = (tid & 15) * 8, vst0 = v_st(sr, sc), vst1 = v_st(32 + sr, sc), kws = KSWZ(sr, sc * 2);
    const int vb0 = (int)(uintptr_t)V_lds + v_rd_base(lane);
    const TIn* Kh = cur.K; const TIn* Vh = cur.V;
#define RESC(a) do { if (__any((a) < 1.f)) { if (hi == 0) al_l[r32] = (a); asm volatile("s_waitcnt lgkmcnt(0)" ::: "memory");              \
                     for (int d_ = 0; d_ < 4; ++d_) for (int r = 0; r < 16; ++r) o[d_][r] *= al_l[crow(r, hi)]; } } while (0)
#define KBASE(t) ((j_lo + (t)) * KVBLK)
#define BL(t) bl_addr(lds, hi, KBASE(t))
#define ACT(t) (KBASE(t) <= qlo + QBLK - 1 && KBASE(t) + KVBLK - 1 >= qlo - W + 1)
#define MASKT(P0_, P1_, t) do { const int kb_ = KBASE(t); if ((!SK || ACT(t)) && (kb_ + KVBLK - 1 > qlo || kb_ <= qlo + QBLK - 1 - W)) mask_tile(P0_, P1_, qm - kb_, (unsigned)W); } while (0)
    constexpr int NQL = F32 ? 16 : 8;
    constexpr bool SK = WSKIP && !F32;
#define SEAM_K0() do { VMWN(NQL); if constexpr (F32) { SWRITE_KF(0); SBAR(); SLOAD_F((const float*)nxt.V, kbn); } else { SWRITE_HK(0); } SBAR(); } while (0)
    f32x16 pA0, pA1, pB0, pB1; float mnA, mnB, alA, alB; bf16x8 pa0, pa1, pa2, pa3;
    if constexpr (F32) { VMW(); SWRITE_VF(0); SBAR(); } else { SWRITE_HV(0); SBAR(); }
    if (NT > 1) { if constexpr (F32) SLOAD_F((const float*)Kh, KBASE(1)); else SLOAD_H(Kh, Vh, KBASE(1)); }
    SBAR(); qkt<0, SK>(pA0, pA1, K_lds, r32, hi, S.qr, ACT(0), BL(0));
    if constexpr (F32) { if (NT > 1) { VMW(); SWRITE_KF(1); SBAR(); SLOAD_F((const float*)Vh, KBASE(1)); } }
    MASKT(pA0, pA1, 0); partialSM(pA0, pA1, m_reg, mnA, alA);
    if (NT > 1) { VMW(); if constexpr (F32) { SWRITE_VF(1); SBAR(); if (NT > 2) SLOAD_F((const float*)Kh, KBASE(2)); } else SWRITE_H(1); }
    __syncthreads();
#define HALF_STEP(PX0, PX1, mnX, alX, PY0, PY1, alY, t, KB, VB, SB) do {                                                      \
        SBAR(); qkt<KB, SK>(PX0, PX1, K_lds, r32, hi, S.qr, ACT(t), BL(t));                                             \
        finishSM(PY0, PY1, alY, l_reg, pa0, pa1, pa2, pa3); SBAR();                                                           \
        if ((t) + 1 < NT) { if constexpr (F32) { VMW(); SWRITE_KF(SB); SBAR(); SLOAD_F((const float*)Vh, KBASE((t) + 1)); }  \
                            else { SLOAD_H(Kh, Vh, KBASE((t) + 1)); } SBAR(); }                                               \
        pv_tile<VB, SK>(o, vb0, pa0, pa1, pa2, pa3, ACT((t) - 1)); MASKT(PX0, PX1, (t)); partialSM(PX0, PX1, m_reg, mnX, alX);                                        \
        __syncthreads();                                                                                                      \
        if ((t) + 1 < NT) { VMW(); if constexpr (F32) { SWRITE_VF(SB); SBAR(); if ((t) + 2 < NT) SLOAD_F((const float*)Kh, KBASE((t) + 2)); } \
                            else { SWRITE_H(SB); } }                                                                          \
        RESC(alX); __syncthreads(); } while (0)
    for (int t = 1; t + 1 < NT; t += 2) {
        HALF_STEP(pB0, pB1, mnB, alB, pA0, pA1, alA, t, 1, 0, 0);
        HALF_STEP(pA0, pA1, mnA, alA, pB0, pB1, alB, t + 1, 0, 1, 1);
    }
    const bool even = (NT & 1) == 0;
    if (even) { SBAR(); qkt<1, SK>(pB0, pB1, K_lds, r32, hi, S.qr, ACT(NT - 1), BL(NT - 1)); SBAR(); }
#define QROW(e) (nxt.Q + (size_t)(wid * QBLK + r32) * D + ((e) >> 1) * 16 + hi * 8 + ((e) & 1) * 4)
    if constexpr (F32) { SLOAD_F((const float*)nxt.K, kbn); SBAR();
#pragma unroll
        for (int e = 0; e < 8; ++e) S.tq[e] = *(const f32x4*)QROW(e); }
    else { SLOAD_H(nxt.K, nxt.V, kbn); SBAR();
#pragma unroll
        for (int d0 = 0; d0 < 8; ++d0) S.qr[d0] = load8<TIn>(nxt.Q + hm16(wid * QBLK + r32, d0 * 16 + hi * 8)); }
    SBAR();
    finishSM(pA0, pA1, alA, l_reg, pa0, pa1, pa2, pa3); SBAR();
    if constexpr (F32) {
#pragma unroll
        for (int e = 8; e < 16; ++e) S.tq[e] = *(const f32x4*)QROW(e); SBAR(); }
#undef QROW
    pv_tile<0, SK>(o, vb0, pa0, pa1, pa2, pa3, ACT(even ? NT - 2 : NT - 1));
    if (even) { MASKT(pB0, pB1, NT - 1); partialSM(pB0, pB1, m_reg, mnB, alB); __syncthreads(); RESC(alB);
        finishSM(pB0, pB1, alB, l_reg, pa0, pa1, pa2, pa3); SBAR(); pv_tile<1, SK>(o, vb0, pa0, pa1, pa2, pa3, ACT(NT - 1)); }
    SBAR(); SEAM_K0();
    if (hi == 0) li_l[r32] = l_reg; asm volatile("s_waitcnt lgkmcnt(0)" ::: "memory");
    float rli[16];
#pragma unroll
    for (int r = 0; r < 16; ++r) rli[r] = __builtin_amdgcn_rcpf(li_l[crow(r, hi)]);
    { unsigned short* stg = (unsigned short*)(lds + OST_OFF) + wid * 2048;
      size_t obase = (size_t)cur.O, zbase = (size_t)cur.Z; int ln = lane; asm volatile("" : "+s"(obase), "+s"(zbase), "+v"(ln));
#pragma unroll
      for (int half = 0; half < 2; ++half) {
#pragma unroll
        for (int r = 0; r < 16; ++r) { const int orow = crow(r, hi);
#pragma unroll
          for (int dl = 0; dl < 2; ++dl) { const float v = o[half * 2 + dl][r] * rli[r]; stg[orow * 64 + dl * 32 + r32] = (unsigned short)(cvtpk(v, v) & 0xffffu); } }
        asm volatile("s_waitcnt lgkmcnt(0)" ::: "memory");
#pragma unroll
        for (int i = 0; i < 4; ++i) { const int row = i * 8 + (ln >> 3), ch = ln & 7;
          const u32x4 v = *(const u32x4*)(stg + row * 64 + ch * 8);
          const size_t off = ((size_t)(wid * QBLK + row) * OSTR + half * 64 + ch * 8) * 2;
          const u32x4 z = *(const u32x4*)(zbase + (size_t)hm16(wid * QBLK + row, half * 64 + ch * 8) * 2); u32x4 w;
#define MUL2(a_, b_) cvtpk(__uint_as_float((a_) << 16) * __uint_as_float((b_) << 16), __uint_as_float((a_) & 0xffff0000u) * __uint_as_float((b_) & 0xffff0000u))
          w.x = MUL2(v.x, z.x); w.y = MUL2(v.y, z.y); w.z = MUL2(v.z, z.z); w.w = MUL2(v.w, z.w);
#undef MUL2
          *(u32x4*)(obase + off) = w; }
        asm volatile("s_waitcnt lgkmcnt(0)" ::: "memory");
      } }
    if constexpr (F32) {
#pragma unroll
        for (int d0 = 0; d0 < 8; ++d0) S.qr[d0] = pack8(S.tq[2 * d0], S.tq[2 * d0 + 1]); }
    __syncthreads();
#undef RESC
#undef KBASE
#undef BL
#undef ACT
#undef MASKT
#undef SEAM_K0
#undef HALF_STEP
}
#undef ROW
#undef VMW
#undef VMWN
#undef SLOAD_H
#undef SWRITE_HK
#undef SWRITE_HV
#undef SWRITE_H
#undef SLOAD_F
#undef SWRITE_KF
#undef SWRITE_VF

}
#define LAS __attribute__((address_space(3)))
typedef unsigned short bf16_t;
typedef short bf16x8 __attribute__((ext_vector_type(8)));
typedef float f32x4 __attribute__((ext_vector_type(4)));
typedef float f32x16 __attribute__((ext_vector_type(16)));
typedef unsigned u32x4 __attribute__((ext_vector_type(4)));
typedef unsigned u32x2 __attribute__((ext_vector_type(2)));

constexpr int DM = 2048, NB = 2, SEQ = 4096, T = NB * SEQ, NH = 16, HD = 128, NG = 128;
constexpr float EPS = 1e-6f;
constexpr size_t MiB = 1u << 20;
constexpr size_t WS_WIN = 0, WS_WGLU = 16 * MiB, WS_WOUT = 24 * MiB, WS_WCAT = 32 * MiB, WS_WFO = 64 * MiB;
constexpr size_t WS_S0 = 72 * MiB;
constexpr size_t WS_S1 = 104 * MiB;
constexpr size_t WS_S2 = 136 * MiB;
constexpr size_t WS_S3 = 168 * MiB;
constexpr size_t WS_S4 = 200 * MiB;
constexpr size_t WS_MISC = 232 * MiB;
constexpr size_t MISC_RSTD0 = 0, MISC_RSTD1 = 32768, MISC_LOGF = 65536, MISC_WFT = 65536 + 524288, MISC_CTL = 65536 + 524288 + 65536  , MISC_SLOTS = MISC_CTL + 65536  ;
constexpr int LDS_TOTAL = 147456;
constexpr int ATT_BIAS_OFF = 69632;
constexpr int ATT_WTOT_OFF = ATT_BIAS_OFF + 16384;

struct Params { const float* in[20]; float* out; unsigned char* ws; int ph_lo, ph_hi; };

__device__ __forceinline__ int mk_tid(int wv_s) { int t = wv_s * 64 + (int)__lane_id(); asm volatile("" : "+v"(t)); return t; }
__device__ __forceinline__ unsigned cvtpk(float lo, float hi) { unsigned r; asm volatile("v_cvt_pk_bf16_f32 %0, %1, %2" : "=v"(r) : "v"(lo), "v"(hi)); return r; }
__device__ __forceinline__ float bflo(unsigned w) { return __uint_as_float(w << 16); }
__device__ __forceinline__ float bfhi(unsigned w) { return __uint_as_float(w & 0xffff0000u); }
__device__ __forceinline__ float sigmoidf_(float v) { return __builtin_amdgcn_rcpf(1.f + __expf(-v)); }
__device__ __forceinline__ float wave_sum(float v) {
#pragma unroll
    for (int o = 1; o < 64; o <<= 1) v += __shfl_xor(v, o);
    return v;
}
__device__ __forceinline__ void store8(bf16_t* dst, f32x4 a, f32x4 b) {
    u32x4 w; w.x = cvtpk(a[0], a[1]); w.y = cvtpk(a[2], a[3]); w.z = cvtpk(b[0], b[1]); w.w = cvtpk(b[2], b[3]);
    *(u32x4*)dst = w;
}

__device__ __forceinline__ void transpose_item(const float* W, int ldw, bf16_t* WT, int row_off, const float* gk, LAS float* scr, int nblk, int item, int lane) {
    const int kb = item / nblk, nb = item % nblk, k0 = 64 * kb, n0 = 32 * nb;
    float wv_[32], gv_[32];
    const float* wp = W + (size_t)(k0 + (lane >> 5)) * ldw + n0 + (lane & 31);
#pragma unroll
    for (int i = 0; i < 32; ++i) wv_[i] = __builtin_nontemporal_load(wp + (size_t)(2 * i) * ldw);
    if (gk) {
#pragma unroll
        for (int i = 0; i < 32; ++i) gv_[i] = gk[k0 + 2 * i + (lane >> 5)];
#pragma unroll
        for (int i = 0; i < 32; ++i) wv_[i] *= gv_[i];
    }
#pragma unroll
    for (int i = 0; i < 32; ++i) scr[(2 * i + (lane >> 5)) * 33 + (lane & 31)] = wv_[i];
    asm volatile("s_waitcnt lgkmcnt(0)" ::: "memory");
    const int c = lane & 7;
#pragma unroll
    for (int j = 0; j < 4; ++j) { const int n = (lane >> 3) + 8 * j; const LAS float* s = scr + (8 * c) * 33 + n;
        u32x4 o; o.x = cvtpk(s[0 * 33], s[1 * 33]); o.y = cvtpk(s[2 * 33], s[3 * 33]); o.z = cvtpk(s[4 * 33], s[5 * 33]); o.w = cvtpk(s[6 * 33], s[7 * 33]);
        *(u32x4*)(WT + (size_t)(row_off + n0 + n) * DM + k0 + 8 * c) = o; }
    asm volatile("s_waitcnt lgkmcnt(0)" ::: "memory");
}
__device__ __forceinline__ void titem_load(const float* W, int ldw, int nblk, int item, int lane, float (&cv)[32]) {
    const int kb = item / nblk, nb = item % nblk, k0 = 64 * kb, n0 = 32 * nb;
    const float* wp = W + (size_t)(k0 + (lane >> 5)) * ldw + n0 + (lane & 31);
#pragma unroll
    for (int i = 0; i < 32; ++i) cv[i] = __builtin_nontemporal_load(wp + (size_t)(2 * i) * ldw);
}
__device__ __forceinline__ void titem_store(bf16_t* WT, int row_off, const float* gk, int nblk, int item, int lane, LAS float* scr, const float (&cv)[32]) {
    const int kb = item / nblk, nb = item % nblk, k0 = 64 * kb, n0 = 32 * nb;
#pragma unroll
    for (int i = 0; i < 32; ++i) scr[(2 * i + (lane >> 5)) * 33 + (lane & 31)] = cv[i];
    asm volatile("s_waitcnt lgkmcnt(0)" ::: "memory");
    const int c = lane & 7;
    f32x4 g0 = {1.f, 1.f, 1.f, 1.f}, g1 = {1.f, 1.f, 1.f, 1.f};
    if (gk) { g0 = *(const f32x4*)(gk + k0 + 8 * c); g1 = *(const f32x4*)(gk + k0 + 8 * c + 4); }
#pragma unroll
    for (int j = 0; j < 4; ++j) { const int n = (lane >> 3) + 8 * j; const LAS float* s = scr + (8 * c) * 33 + n;
        u32x4 o; o.x = cvtpk(s[0 * 33] * g0[0], s[1 * 33] * g0[1]); o.y = cvtpk(s[2 * 33] * g0[2], s[3 * 33] * g0[3]); o.z = cvtpk(s[4 * 33] * g1[0], s[5 * 33] * g1[1]); o.w = cvtpk(s[6 * 33] * g1[2], s[7 * 33] * g1[3]);
        *(u32x4*)(WT + (size_t)(row_off + n0 + n) * DM + k0 + 8 * c) = o; }
    asm volatile("s_waitcnt lgkmcnt(0)" ::: "memory");
}
#define P0_DECODE(S, it_) int r##S = (it_); const float* W##S; int ldw##S, roff##S, nblk##S; bf16_t* WT##S; const float* gk##S; \
    if (r##S < I_IN) { W##S = w3; ldw##S = 4096; WT##S = (bf16_t*)(ws + WS_WIN); roff##S = 0; gk##S = g1p; nblk##S = 128; } \
    else if (r##S < I_IN + I_SQ) { r##S -= I_IN; W##S = w12; ldw##S = 2048; WT##S = (bf16_t*)(ws + WS_WGLU); roff##S = 0; gk##S = nullptr; nblk##S = 64; } \
    else if (r##S < I_IN + 2 * I_SQ) { r##S -= I_IN + I_SQ; W##S = w14; ldw##S = 2048; WT##S = (bf16_t*)(ws + WS_WOUT); roff##S = 0; gk##S = nullptr; nblk##S = 64; } \
    else if (r##S < 2 * I_IN + 2 * I_SQ) { r##S -= I_IN + 2 * I_SQ; W##S = w16; ldw##S = 4112; WT##S = (bf16_t*)(ws + WS_WCAT); roff##S = 0; gk##S = g15; nblk##S = 128; } \
    else if (r##S < 3 * I_IN + 2 * I_SQ) { r##S -= 2 * I_IN + 2 * I_SQ; W##S = w18; ldw##S = 4096; WT##S = (bf16_t*)(ws + WS_WCAT); roff##S = 4096; gk##S = g1p + DM; nblk##S = 128; } \
    else { r##S -= 3 * I_IN + 2 * I_SQ; W##S = w19; ldw##S = 2048; WT##S = (bf16_t*)(ws + WS_WFO); roff##S = 0; gk##S = nullptr; nblk##S = 64; }
__device__ __forceinline__ void p0_phase(const Params& P, LAS unsigned char* lds, const int tid) {
    const int lane = tid & 63, wave = tid >> 6;
    LAS float* scrA = (LAS float*)(lds + wave * 16896); LAS float* scrB = scrA + 64 * 33;
    const int gw = blockIdx.x * 8 + wave, NGW = gridDim.x * 8;
    constexpr int I_IN = 32 * 128, I_SQ = 32 * 64, NIT = 3 * I_IN + 3 * I_SQ;
    unsigned char* ws = P.ws;
    const float* w3 = P.in[3]; const float* w12 = P.in[12]; const float* w14 = P.in[14]; const float* w16 = P.in[16]; const float* w18 = P.in[18]; const float* w19 = P.in[19];
    const float* g1p = P.in[1]; const float* g15 = P.in[15];
    asm("" : "+s"(w3)); asm("" : "+s"(w12)); asm("" : "+s"(w14)); asm("" : "+s"(w16)); asm("" : "+s"(w18)); asm("" : "+s"(w19)); asm("" : "+s"(g1p)); asm("" : "+s"(g15));
    for (int it = gw; it < NIT; it += 2 * NGW) {
        const bool hasB = it + NGW < NIT;
        P0_DECODE(A, it); P0_DECODE(B, hasB ? it + NGW : it);
        float ca[32], cb[32];
        titem_load(WA, ldwA, nblkA, rA, lane, ca);
        titem_load(WB, ldwB, nblkB, rB, lane, cb);
        titem_store(WTA, roffA, gkA, nblkA, rA, lane, scrA, ca);
        if (hasB) titem_store(WTB, roffB, gkB, nblkB, rB, lane, scrB, cb);
    }
    { bf16_t* wfT = (bf16_t*)(ws + WS_MISC + MISC_WFT); const float* kvw = P.in[16]; const float* gkv = P.in[15];
      for (int i = blockIdx.x * 512 + tid; i < 16 * DM; i += gridDim.x * 512) { const int c = i >> 11, k = i & 2047;
          const float v = gkv[k] * kvw[(size_t)k * 4112 + 4096 + c]; wfT[i] = (bf16_t)(cvtpk(v, v) & 0xffffu); } }
    { const float* x = P.in[0]; bf16_t* xb = (bf16_t*)(ws + WS_S3); float* rstd0 = (float*)(ws + WS_MISC + MISC_RSTD0);
      for (int m = gw; m < T; m += 2 * NGW) {
          const int m1 = (m + NGW < T) ? m + NGW : m;
          const f32x4* xr0 = (const f32x4*)(x + (size_t)m * DM) + lane; const f32x4* xr1 = (const f32x4*)(x + (size_t)m1 * DM) + lane; f32x4 v0[8], v1[8]; float s0 = 0.f, s1 = 0.f;
#pragma unroll
          for (int j = 0; j < 8; ++j) v0[j] = __builtin_nontemporal_load(xr0 + 64 * j);
#pragma unroll
          for (int j = 0; j < 8; ++j) v1[j] = __builtin_nontemporal_load(xr1 + 64 * j);
#pragma unroll
          for (int j = 0; j < 8; ++j) { s0 += (v0[j][0] * v0[j][0] + v0[j][1] * v0[j][1]) + (v0[j][2] * v0[j][2] + v0[j][3] * v0[j][3]); s1 += (v1[j][0] * v1[j][0] + v1[j][1] * v1[j][1]) + (v1[j][2] * v1[j][2] + v1[j][3] * v1[j][3]); }
          const float rs0 = rsqrtf(wave_sum(s0) * (1.f / DM) + EPS), rs1 = rsqrtf(wave_sum(s1) * (1.f / DM) + EPS);
          if (lane == 0) { rstd0[m] = 1.f / rs0; rstd0[m1] = 1.f / rs1; }
          u32x2* o0 = (u32x2*)(xb + (size_t)m * DM) + lane; u32x2* o1 = (u32x2*)(xb + (size_t)m1 * DM) + lane;
#pragma unroll
          for (int j = 0; j < 8; ++j) { v0[j] = v0[j] * rs0; v1[j] = v1[j] * rs1; u32x2 w; w.x = cvtpk(v0[j][0], v0[j][1]); w.y = cvtpk(v0[j][2], v0[j][3]); o0[64 * j] = w; u32x2 w1; w1.x = cvtpk(v1[j][0], v1[j][1]); w1.y = cvtpk(v1[j][2], v1[j][3]); o1[64 * j] = w1; }
      } }
}

__device__ __forceinline__ size_t sz_off(int row, int c) { return ((size_t)((row >> 4) * 64 + (c >> 5)) << 9) + ((((row & 15) * 4 + ((c >> 3) & 3))) << 3); }
struct F1 {
    const float* rstd; bf16_t* ug; bf16_t* sz;
    __device__ __forceinline__ void operator()(int row, int col, f32x4 a, f32x4 b) const {
        (void)rstd;
        if (col < DM) { const int bb = row >> 12, t = row & 4095, g = col >> 4;
            store8(ug + ((size_t)(bb * NG + g) * SEQ + t) * 16 + (col & 15), a, b); }
        else {
#pragma unroll
            for (int i = 0; i < 4; ++i) { a[i] = a[i] * sigmoidf_(a[i]); b[i] = b[i] * sigmoidf_(b[i]); }
            store8(sz + sz_off(row, col - DM), a, b); }
    }
};
struct F2 {
    const float* bias; const bf16_t* y1; const bf16_t* sz; bf16_t* y2;
    __device__ __forceinline__ void operator()(int row, int col, f32x4 a, f32x4 b) const {
        const f32x4 b0 = *(const f32x4*)(bias + col), b1 = *(const f32x4*)(bias + col + 4);
        const u32x4 yv = *(const u32x4*)(y1 + (size_t)row * DM + col), zv = *(const u32x4*)(sz + sz_off(row, col));
        a = a + b0; b = b + b1;
        f32x4 oa, ob;
        oa[0] = bflo(yv.x) * sigmoidf_(a[0]) * bflo(zv.x); oa[1] = bfhi(yv.x) * sigmoidf_(a[1]) * bfhi(zv.x);
        oa[2] = bflo(yv.y) * sigmoidf_(a[2]) * bflo(zv.y); oa[3] = bfhi(yv.y) * sigmoidf_(a[3]) * bfhi(zv.y);
        ob[0] = bflo(yv.z) * sigmoidf_(b[0]) * bflo(zv.z); ob[1] = bfhi(yv.z) * sigmoidf_(b[1]) * bfhi(zv.z);
        ob[2] = bflo(yv.w) * sigmoidf_(b[2]) * bflo(zv.w); ob[3] = bfhi(yv.w) * sigmoidf_(b[3]) * bfhi(zv.w);
        store8(y2 + (size_t)row * DM + col, oa, ob);
    }
};
struct F3 {
    bf16_t* o;
    __device__ __forceinline__ void operator()(int row, int col, f32x4 a, f32x4 b) const { store8(o + (size_t)row * DM + col, a, b); }
};
struct F4 {
    const float* rstd; bf16_t* kb; bf16_t* vb; bf16_t* qb; bf16_t* sz2;
    __device__ __forceinline__ void operator()(int row, int col, f32x4 a, f32x4 b) const {
        const float r = rstd[row]; a = a * r; b = b * r;
        const int sec = col >> 11, c = col & 2047;
        if (sec == 3) {
#pragma unroll
            for (int i = 0; i < 4; ++i) { a[i] = a[i] * sigmoidf_(a[i]); b[i] = b[i] * sigmoidf_(b[i]); } }
        const int bb = row >> 12, t = row & 4095, hh = c >> 7, d = c & 127;
        store8(kb + (size_t)sec * (16u << 20) + ((size_t)(bb * NH + hh) * SEQ) * HD + attn::hm16(t, d), a, b);
    }
};

#ifndef SSM_PF_U
#define SSM_PF_U 1
#endif
__device__ __forceinline__ void sincos_small(float x, float& s, float& c) {
    const float k = rintf(x * 0.63661977236758134f);
    float r = fmaf(-k, 1.57079625129699707031f, x); r = fmaf(-k, 7.54978941586159635335e-08f, r);
    const float r2 = r * r;
    const float sp = r + r * r2 * (-1.6666666666666666e-1f + r2 * (8.3333333333333332e-3f + r2 * (-1.9841269841269841e-4f + r2 * 2.7557319223985893e-6f)));
    const float cp = 1.f + r2 * (-0.5f + r2 * (4.1666666666666664e-2f + r2 * (-1.3888888888888889e-3f + r2 * (2.4801587301587302e-5f + r2 * -2.7557319223985888e-7f))));
    const int q = (int)k & 3;
    s = (q == 0) ? sp : (q == 1) ? cp : (q == 2) ? -sp : -cp;
    c = (q == 0) ? cp : (q == 1) ? -sp : (q == 2) ? -cp : sp;
}
__device__ __forceinline__ float gelu_tanh(float x) { const float u = 1.5957691216057308f * (x + 0.044715f * x * x * x); return x * sigmoidf_(u); }
__device__ __forceinline__ void ssm_phase(const Params& P, LAS unsigned char* lds, const int tid) {
    const int wv = __builtin_amdgcn_readfirstlane(tid >> 6);
    const float* a_re = P.in[4]; const float* a_im = P.in[5]; const float* log_dt = P.in[6]; const float* b_re = P.in[7]; const float* b_im = P.in[8];
    const float* c_re = P.in[9]; const float* c_im = P.in[10]; const float* dsk = P.in[11];
    const bf16_t* ug = (const bf16_t*)(P.ws + WS_S1); bf16_t* y1 = (bf16_t*)(P.ws + WS_S0);
    LAS float* Sst = (LAS float*)lds;
    LAS unsigned char* img = lds + 8192 + wv * 8704;
    for (int bg = blockIdx.x; bg < NB * NG; bg += gridDim.x) {
        int lane = tid & 63; asm volatile("" : "+v"(lane));
        const int n = lane & 31, hi = lane >> 5, l15 = lane & 15, kq = lane >> 4;
        const int b = bg >> 7, g = bg & 127;
        const float dt = expf(log_dt[g]);
        float abr[2], abi[2], qr_[2], qi_[2]; bf16x8 Bf[4];
#pragma unroll
        for (int ph = 0; ph < 2; ++ph) {
            const int p = ph * 32 + n; const float ar = a_re[g * 64 + p], ai = a_im[g * 64 + p];
            const float mag = expf(ar * dt); float cs, sn; sincos_small(ai * dt, sn, cs);
            abr[ph] = mag * cs; abi[ph] = mag * sn;
            const float den = ar * ar + ai * ai, nr = abr[ph] - 1.f;
            const float cr = (nr * ar + abi[ph] * ai) / den, ci = (abi[ph] * ar - nr * ai) / den;
            float pr = abr[ph], pi = abi[ph];
#pragma unroll
            for (int i = 0; i < 8; ++i) { const float t2 = pr * pr - pi * pi; pi = 2.f * pr * pi; pr = t2; }
            qr_[ph] = pr; qi_[ph] = pi;
            const float* brp = b_re + ((size_t)(g * 64 + p) * 16 + 8 * hi); const float* bip = b_im + ((size_t)(g * 64 + p) * 16 + 8 * hi);
            const f32x4 r0 = *(const f32x4*)brp, r1 = *(const f32x4*)(brp + 4), i0 = *(const f32x4*)bip, i1 = *(const f32x4*)(bip + 4);
            const f32x4 xr0 = r0 * cr - i0 * ci, xr1 = r1 * cr - i1 * ci, xi0 = i0 * cr + r0 * ci, xi1 = i1 * cr + r1 * ci;
            u32x4 wr_, wi_; wr_.x = cvtpk(xr0[0], xr0[1]); wr_.y = cvtpk(xr0[2], xr0[3]); wr_.z = cvtpk(xr1[0], xr1[1]); wr_.w = cvtpk(xr1[2], xr1[3]);
            wi_.x = cvtpk(xi0[0], xi0[1]); wi_.y = cvtpk(xi0[2], xi0[3]); wi_.z = cvtpk(xi1[0], xi1[1]); wi_.w = cvtpk(xi1[2], xi1[3]);
            Bf[ph * 2 + 0] = __builtin_bit_cast(bf16x8, wr_); Bf[ph * 2 + 1] = __builtin_bit_cast(bf16x8, wi_);
        }
        bf16x8 Cf[4], Df;
#pragma unroll
        for (int kk = 0; kk < 4; ++kk) {
            const f32x4 cr4 = *(const f32x4*)(c_re + (size_t)(g * 16 + l15) * 64 + kk * 16 + 4 * kq), ci4 = *(const f32x4*)(c_im + (size_t)(g * 16 + l15) * 64 + kk * 16 + 4 * kq);
            u32x4 w; w.x = cvtpk(cr4[0], -ci4[0]); w.y = cvtpk(cr4[1], -ci4[1]); w.z = cvtpk(cr4[2], -ci4[2]); w.w = cvtpk(cr4[3], -ci4[3]);
            Cf[kk] = __builtin_bit_cast(bf16x8, w);
        }
        { const float dv = dsk[g * 16 + l15]; float e[8];
#pragma unroll
          for (int j = 0; j < 8; ++j) e[j] = (kq < 2 && 8 * kq + j == l15) ? dv : 0.f;
          u32x4 w; w.x = cvtpk(e[0], e[1]); w.y = cvtpk(e[2], e[3]); w.z = cvtpk(e[4], e[5]); w.w = cvtpk(e[6], e[7]); Df = __builtin_bit_cast(bf16x8, w); }
        const bf16_t* ugb = ug + (size_t)bg * SEQ * 16;
        bf16_t* y1b = y1 + (size_t)b * SEQ * DM + g * 16;
        const int sm = (n >> 2) & 1, jm = (n & 3) + 4 * (n >> 3);
        float Hr[2] = {0.f, 0.f}, Hi[2] = {0.f, 0.f};
        for (int pass = 0; pass < 2; ++pass) {
            float hr[2] = {Hr[0], Hr[1]}, hi_[2] = {Hi[0], Hi[1]};
            const char* ugc = (const char*)ugb;
            const unsigned offA = (unsigned)(((wv * 2 + sm) * 256 + jm) * 16 + 8 * hi) * 2u;
            const unsigned offU = (unsigned)((wv * 2 * 256 + l15) * 16 + 8 * (kq & 1)) * 2u;
            bf16x8 Afn = *(const bf16x8*)(ugc + offA);
            for (int step = 0; step < 16; ++step) {
                const bf16x8 Af = Afn;
                if (step < 15) Afn = *(const bf16x8*)(ugc + (offA + (unsigned)(step + 1) * 512u));
#if SSM_PF_U
                bf16x8 Au0 = {0, 0, 0, 0, 0, 0, 0, 0}, Au1 = {0, 0, 0, 0, 0, 0, 0, 0};
                if (pass == 1 && kq < 2) { Au0 = *(const bf16x8*)(ugc + (offU + (unsigned)step * 512u)); Au1 = *(const bf16x8*)(ugc + (offU + 8192u + (unsigned)step * 512u)); }
#endif
                f32x16 x[4];
#pragma unroll
                for (int f = 0; f < 4; ++f) { f32x16 z16 = {}; x[f] = __builtin_amdgcn_mfma_f32_32x32x16_bf16(Af, Bf[f], z16, 0, 0, 0); }
                __builtin_amdgcn_sched_barrier(0);
#pragma unroll
                for (int r = 0; r < 16; ++r)
#pragma unroll
                    for (int ph = 0; ph < 2; ++ph) {
                        float t0 = fmaf(-abi[ph], hi_[ph], x[2 * ph][r]), t1 = fmaf(abi[ph], hr[ph], x[2 * ph + 1][r]);
                        asm("" : "+v"(t0)); asm("" : "+v"(t1));
                        float nr_ = fmaf(abr[ph], hr[ph], t0), ni_ = fmaf(abr[ph], hi_[ph], t1);
                        asm("" : "+v"(nr_)); asm("" : "+v"(ni_));
                        hr[ph] = nr_; hi_[ph] = ni_; x[2 * ph][r] = nr_; x[2 * ph + 1][r] = ni_;
                    }
                __builtin_amdgcn_sched_barrier(0);
                if (pass == 1) {
#pragma unroll
                    for (int ph = 0; ph < 2; ++ph)
#pragma unroll
                        for (int r = 0; r < 16; ++r) *(LAS unsigned*)(img + (hi * 16 + r) * 272 + (ph * 32 + n) * 4) = cvtpk(x[2 * ph][r], x[2 * ph + 1][r]);
                    asm volatile("s_waitcnt lgkmcnt(0)" ::: "memory");
#pragma unroll
                    for (int s2 = 0; s2 < 2; ++s2) {
                        __builtin_amdgcn_sched_barrier(0);
                        f32x4 acc = {0.f, 0.f, 0.f, 0.f};
#pragma unroll
                        for (int kk = 0; kk < 4; ++kk) { const bf16x8 Ah = *(const LAS bf16x8*)(img + (s2 * 16 + l15) * 272 + kk * 64 + kq * 16);
                            acc = __builtin_amdgcn_mfma_f32_16x16x32_bf16(Ah, Cf[kk], acc, 0, 0, 0); }
                        const int tokb = (wv * 2 + s2) * 256 + step * 16;
#if SSM_PF_U
                        acc = __builtin_amdgcn_mfma_f32_16x16x32_bf16(s2 ? Au1 : Au0, Df, acc, 0, 0, 0);
#else
                        { bf16x8 Au = {0, 0, 0, 0, 0, 0, 0, 0}; if (kq < 2) Au = *(const bf16x8*)(ugc + (offU + (unsigned)s2 * 8192u + (unsigned)step * 512u));
                          acc = __builtin_amdgcn_mfma_f32_16x16x32_bf16(Au, Df, acc, 0, 0, 0); }
#endif
#pragma unroll
                        for (int i = 0; i < 4; ++i) { const float yv = gelu_tanh(acc[i]); const int t = tokb + 4 * kq + i;
                            *(bf16_t*)((char*)y1b + ((unsigned)t * (unsigned)DM + (unsigned)l15) * 2u) = (bf16_t)(cvtpk(yv, yv) & 0xffffu); }
                    }
                    asm volatile("s_waitcnt lgkmcnt(0)" ::: "memory");
                }
            }
            if (pass == 0) {
                const int seg = wv * 2 + hi;
#pragma unroll
                for (int ph = 0; ph < 2; ++ph) { Sst[(seg * 64 + ph * 32 + n) * 2 + 0] = hr[ph]; Sst[(seg * 64 + ph * 32 + n) * 2 + 1] = hi_[ph]; }
                __syncthreads();
#pragma unroll
                for (int ph = 0; ph < 2; ++ph) { float cr_ = 0.f, ci_ = 0.f;
#pragma nounroll
                    for (int v = 0; v < 15; ++v) { if (v < seg) { const float sr = Sst[(v * 64 + ph * 32 + n) * 2 + 0], si = Sst[(v * 64 + ph * 32 + n) * 2 + 1];
                        const float t2 = qr_[ph] * cr_ - qi_[ph] * ci_ + sr; ci_ = qr_[ph] * ci_ + qi_[ph] * cr_ + si; cr_ = t2; } }
                    Hr[ph] = cr_; Hi[ph] = ci_; }
                __syncthreads();
            }
        }
    }
}

template <bool FIRST> __device__ __forceinline__ void row_phase(const Params& P, const int tid) {
    const int lane = tid & 63, wave = tid >> 6;
    const int gw = blockIdx.x * 8 + wave, NGW = gridDim.x * 8;
    const bf16_t* O = (const bf16_t*)(P.ws + WS_S3); const float* X = FIRST ? P.in[0] : P.out; float* OUT = P.out;
    const float* gp = P.in[2] + (FIRST ? 0 : DM);
    float* rstd1 = (float*)(P.ws + WS_MISC + MISC_RSTD1); bf16_t* h1b = (bf16_t*)(P.ws + WS_S0);
    for (int m = gw; m < T; m += NGW) {
        const u32x2* orow = (const u32x2*)(O + (size_t)m * DM) + lane; const f32x4* xrow = (const f32x4*)(X + (size_t)m * DM) + lane; f32x4* outr = (f32x4*)(OUT + (size_t)m * DM) + lane;
        f32x4 o[8]; float ss = 0.f;
#pragma unroll
        for (int j = 0; j < 8; ++j) { const u32x2 w = orow[64 * j]; o[j] = (f32x4){bflo(w.x), bfhi(w.x), bflo(w.y), bfhi(w.y)}; ss += (o[j][0] * o[j][0] + o[j][1] * o[j][1]) + (o[j][2] * o[j][2] + o[j][3] * o[j][3]); }
        const float rs = rsqrtf(wave_sum(ss) * (1.f / DM) + EPS);
        float ss1 = 0.f;
#pragma unroll
        for (int j = 0; j < 8; ++j) { const f32x4 g4 = ((const f32x4*)gp)[lane + 64 * j]; const f32x4 xv = xrow[64 * j]; o[j] = xv + o[j] * rs * g4; outr[64 * j] = o[j];
            ss1 += (o[j][0] * o[j][0] + o[j][1] * o[j][1]) + (o[j][2] * o[j][2] + o[j][3] * o[j][3]); }
        if (FIRST) {
            const float r1 = rsqrtf(wave_sum(ss1) * (1.f / DM) + EPS);
            if (lane == 0) rstd1[m] = r1;
            u32x2* o8 = (u32x2*)(h1b + (size_t)m * DM) + lane;
#pragma unroll
            for (int j = 0; j < 8; ++j) { u32x2 w; w.x = cvtpk(o[j][0], o[j][1]); w.y = cvtpk(o[j][2], o[j][3]); o8[64 * j] = w; }
        }
    }
}

__device__ __forceinline__ void logf_phase(const Params& P, LAS unsigned char* lds, const int tid) {
    const int lane = tid & 63, wv = __builtin_amdgcn_readfirstlane(tid >> 6), l15 = lane & 15, kq = lane >> 4;
    const bf16_t* h1b = (const bf16_t*)(P.ws + WS_S0); const bf16_t* wfT = (const bf16_t*)(P.ws + WS_MISC + MISC_WFT);
    const float* rstd1 = (const float*)(P.ws + WS_MISC + MISC_RSTD1); const float* bfv = P.in[17]; float* logf = (float*)(P.ws + WS_MISC + MISC_LOGF);
    LAS float* part = (LAS float*)lds;
    for (int rt = blockIdx.x; rt < T / 16; rt += 2 * gridDim.x) {
        const int rt1 = (rt + (int)gridDim.x < T / 16) ? rt + (int)gridDim.x : rt;
        f32x4 acc0 = {0.f, 0.f, 0.f, 0.f}, acc1 = {0.f, 0.f, 0.f, 0.f};
#pragma unroll
        for (int ks = 0; ks < 8; ++ks) { const int k = wv * 256 + ks * 32 + 8 * kq;
            const bf16x8 Bfr = *(const bf16x8*)(wfT + (size_t)l15 * DM + k);
            const bf16x8 A0 = *(const bf16x8*)(h1b + (size_t)(rt * 16 + l15) * DM + k), A1 = *(const bf16x8*)(h1b + (size_t)(rt1 * 16 + l15) * DM + k);
            acc0 = __builtin_amdgcn_mfma_f32_16x16x32_bf16(A0, Bfr, acc0, 0, 0, 0); acc1 = __builtin_amdgcn_mfma_f32_16x16x32_bf16(A1, Bfr, acc1, 0, 0, 0); }
#pragma unroll
        for (int i = 0; i < 4; ++i) { part[(wv * 16 + 4 * kq + i) * 16 + l15] = acc0[i]; part[2048 + (wv * 16 + 4 * kq + i) * 16 + l15] = acc1[i]; }
        __syncthreads();
        { const int tl = tid >> 8, row = (tid >> 4) & 15, c = tid & 15; float s = 0.f;
#pragma unroll
          for (int w = 0; w < 8; ++w) s += part[tl * 2048 + (w * 16 + row) * 16 + c];
          const int grow = (tl ? rt1 : rt) * 16 + row; const float f = s * rstd1[grow] + bfv[c];
          const float lf = fminf(f, 0.f) - log1pf(expf(-fabsf(f)));
          logf[((size_t)((grow >> 12) * NH + c)) * SEQ + (grow & 4095)] = lf; }
        __syncthreads();
    }
}

__device__ __forceinline__ void attn_bias_fill(const f32x4 a, const f32x4 c, char* ldsg, const int tid) {
    const int lane = tid & 63, wv = tid >> 6;
    float* bias = (float*)(ldsg + ATT_BIAS_OFF); float* wtot = (float*)(ldsg + ATT_WTOT_OFF);
    float v[8]; v[0] = a[0]; v[1] = v[0] + a[1]; v[2] = v[1] + a[2]; v[3] = v[2] + a[3]; v[4] = v[3] + c[0]; v[5] = v[4] + c[1]; v[6] = v[5] + c[2]; v[7] = v[6] + c[3];
    float sc = v[7];
#pragma unroll
    for (int off = 1; off < 64; off <<= 1) { const float t = __shfl_up(sc, off); if (lane >= off) sc += t; }
    if (lane == 63) wtot[wv] = sc;
    __syncthreads();
    float base = sc - v[7];
    for (int w = 0; w < wv; ++w) base += wtot[w];
    constexpr float INV = -1.f / attn::SCALE;
    f32x4 o0, o1;
    o0[0] = (base + v[0]) * INV; o0[1] = (base + v[1]) * INV; o0[2] = (base + v[2]) * INV; o0[3] = (base + v[3]) * INV;
    o1[0] = (base + v[4]) * INV; o1[1] = (base + v[5]) * INV; o1[2] = (base + v[6]) * INV; o1[3] = (base + v[7]) * INV;
    *(f32x4*)(bias + tid * 8) = o0; *(f32x4*)(bias + tid * 8 + 4) = o1;
    __syncthreads();
}
__device__ __forceinline__ void attn_phase(const Params& P, char* ldsg, const int wv_s) {
    typedef attn::bf16 abf; typedef attn::BlockRef<abf, abf> Ref;
    const abf* Q = (const abf*)(P.ws + WS_S3); const abf* K = (const abf*)(P.ws + WS_S1); const abf* V = (const abf*)(P.ws + WS_S2);
    const bf16_t* Z = (const bf16_t*)(P.ws + WS_S4); abf* AO = (abf*)(P.ws + WS_WIN);
    const float* logf = (const float*)(P.ws + WS_MISC + MISC_LOGF);
    constexpr int NQB = SEQ / 256, NX = NQB / 2, TOTAL = NX * NB * NH;
    const int G = gridDim.x;
    const int L = blockIdx.x;
    if (L >= TOTAL) return;
#define MKREF(r, L_, pass_) do { const int bh_ = (L_) / NX, x_ = (L_) % NX, qb_ = (pass_) ? NQB - 1 - x_ : x_, b_ = bh_ / NH, h_ = bh_ % NH; \
        (r).Q = Q + ((size_t)bh_ * SEQ + (size_t)qb_ * 256) * HD; (r).K = K + (size_t)bh_ * SEQ * HD; (r).V = V + (size_t)bh_ * SEQ * HD; \
        (r).O = AO + ((size_t)b_ * SEQ + (size_t)qb_ * 256) * DM + h_ * HD; (r).Z = Z + ((size_t)bh_ * SEQ + (size_t)qb_ * 256) * HD; (r).P0 = qb_ * 256; } while (0)
    {
        const int tid0 = mk_tid(wv_s); const float* lf = logf + (size_t)(L / NX) * SEQ;
        const f32x4 lfa = *(const f32x4*)(lf + tid0 * 8), lfc = *(const f32x4*)(lf + tid0 * 8 + 4);
        Ref lightb, heavyb; MKREF(lightb, L, 0); MKREF(heavyb, L, 1);
        attn::Seam<abf> S;
        attn::causal_swa_prime<abf, abf>(lightb, SEQ, ldsg, S, mk_tid(wv_s));
        attn_bias_fill(lfa, lfc, ldsg, mk_tid(wv_s));
        for (int pass = 0; pass < 2; ++pass) {
            Ref cur = heavyb; if (pass == 0) cur = lightb;
            attn::causal_swa_block<abf, abf>(cur, heavyb, SEQ, SEQ, ldsg, S, mk_tid(wv_s));
        }
    }
#undef MKREF
}

#define XB_TMO      128
#define XB_XCNT(j)  (256  + 64 * (j))
#define XB_XSUB(j)  (1280 + 64 * (j))
#define XB_XGEN(j)  (2304 + 64 * (j))
#define XB_TOP      3328
#define XB_TOPGEN   3392
#define XCD_BAR_WORDS 3456
#define XB_SPIN_CAP (1u << 18)

__device__ __forceinline__ unsigned xb_ld(unsigned* p)              { return __hip_atomic_load(p, __ATOMIC_RELAXED, __HIP_MEMORY_SCOPE_AGENT); }
__device__ __forceinline__ unsigned xb_add(unsigned* p, unsigned v) { return __hip_atomic_fetch_add(p, v, __ATOMIC_RELAXED, __HIP_MEMORY_SCOPE_AGENT); }
__device__ __forceinline__ unsigned xb_xcc_id() { return (unsigned)__builtin_amdgcn_s_getreg((3 << 11) | 20) & 0xFu; }
#define XB_SPIN(cond, bar) do { unsigned _sp = 0; while (cond) { __builtin_amdgcn_s_sleep(1); \
    if ((++_sp & 255u) == 0u) { if (xb_ld(&(bar)[XB_TMO])) break; if (_sp > XB_SPIN_CAP) { atomicAdd(&(bar)[XB_TMO], 1u); break; } } } } while (0)

struct XcdBarrier {
    unsigned* bar; unsigned x;
    volatile LAS unsigned* st;
};

__device__ __forceinline__ XcdBarrier xcd_barrier_post(unsigned* bar, volatile LAS unsigned* st, int tid) {
    XcdBarrier b; b.bar = bar; b.x = xb_xcc_id(); b.st = st;
    if (tid == 0) (void)xb_add(&bar[XB_XCNT(b.x)], 1u);
    return b;
}
__device__ __forceinline__ void xcd_barrier_complete(unsigned* bar, unsigned x, unsigned& nloc, unsigned& nx) {
    const unsigned G = gridDim.x * gridDim.y * gridDim.z;
    unsigned sum, cnt, mine, sp = 0u;
    for (;;) {
        sum = 0u; cnt = 0u; mine = 0u;
#pragma unroll
        for (unsigned j = 0; j < 16; ++j) { const unsigned c = xb_ld(&bar[XB_XCNT(j)]); sum += c; cnt += (c > 0u) ? 1u : 0u; mine = (j == x) ? c : mine; }
        if (sum == G) break;
        __builtin_amdgcn_s_sleep(1);
        if ((++sp & 255u) == 0u) { if (xb_ld(&bar[XB_TMO])) break; if (sp > XB_SPIN_CAP) { atomicAdd(&bar[XB_TMO], 1u); break; } }
    }
    nloc = mine > 0u ? mine : 1u; nx = cnt > 0u ? cnt : 1u;
}

__device__ __forceinline__ void xcd_barrier(const XcdBarrier& b, int tid) {
    asm volatile("s_waitcnt vmcnt(0)" ::: "memory");
    __syncthreads();
    if (tid == 0) {
        unsigned* bar = b.bar;
        __builtin_amdgcn_s_waitcnt(0);
        unsigned nloc = b.st[0], nx = b.st[1];
        if (nloc == 0u) { xcd_barrier_complete(bar, b.x, nloc, nx); b.st[0] = nloc; b.st[1] = nx; }
        const unsigned old = xb_add(&bar[XB_XSUB(b.x)], 1u);
        const unsigned gen = old / nloc;
        if (old + 1u == (gen + 1u) * nloc) {
            __builtin_amdgcn_fence(__ATOMIC_RELEASE, "agent");
            asm volatile("s_waitcnt vmcnt(0)" ::: "memory");
            const unsigned og = xb_add(&bar[XB_TOP], 1u);
            const unsigned tg = og / nx;
            if (og + 1u == (tg + 1u) * nx) xb_add(&bar[XB_TOPGEN], 1u);
            else XB_SPIN(xb_ld(&bar[XB_TOPGEN]) == tg, bar);
            __builtin_amdgcn_fence(__ATOMIC_ACQUIRE, "agent");
            asm volatile("s_waitcnt vmcnt(0)" ::: "memory");
        } else {
            XB_SPIN(xb_ld(&bar[XB_TOPGEN]) == gen, bar);
            __builtin_amdgcn_fence(__ATOMIC_ACQUIRE, "agent");
            asm volatile("s_waitcnt vmcnt(0)" ::: "memory");
        }
    }
    __syncthreads();
}

__global__ void __launch_bounds__(512, 2) yoco_fwd(Params P) {
    extern __shared__ __attribute__((aligned(16))) unsigned char lds_raw[];
    LAS unsigned char* lds = (LAS unsigned char*)lds_raw;
    cg::grid_group grid = cg::this_grid();
    const int lo = P.ph_lo, hi = P.ph_hi;
    typedef const __attribute__((address_space(4))) Params* KPtr;
    const KPtr kp0 = (KPtr)__builtin_amdgcn_kernarg_segment_ptr();
    const int wv_s = __builtin_amdgcn_readfirstlane((int)threadIdx.x >> 6);
    volatile LAS unsigned* bst = (volatile LAS unsigned*)(lds + LDS_TOTAL - 64);
    if (threadIdx.x < 2) bst[threadIdx.x] = 0u;
    __syncthreads();
    XcdBarrier bar;
    { KPtr kq_ = kp0; asm volatile("" : "+s"(kq_)); bar = xcd_barrier_post((unsigned*)(kq_->ws + WS_MISC + MISC_CTL), bst, threadIdx.x); }
    if (P.ph_hi == 0x7fffffff) grid.sync();
#define LOADP() KPtr kp_ = kp0; asm volatile("" : "+s"(kp_)); Params Q; _Pragma("unroll") for (int i_ = 0; i_ < 20; ++i_) Q.in[i_] = kp_->in[i_]; Q.out = kp_->out; Q.ws = kp_->ws; Q.ph_lo = 0; Q.ph_hi = 0; unsigned char* ws = Q.ws
#ifndef PHMASK
#define PHMASK 0x3ff
#endif
#define IN(k) (((PHMASK >> (k)) & 1) && lo <= (k) && (k) < hi)
#ifndef DUPMASK
#define DUPMASK 0
#endif
#define DUP(k) for (int rep_ = 0; rep_ < 1 + ((DUPMASK >> (k)) & 1); ++rep_)
#define SEAM(k) do { if (IN(k) && IN((k) + 1)) xcd_barrier(bar, mk_tid(wv_s)); } while (0)
    if (IN(0)) { LOADP(); (void)ws; p0_phase(Q, lds, mk_tid(wv_s)); __syncthreads(); if (DUPMASK & 1) { p0_phase(Q, lds, mk_tid(wv_s)); __syncthreads(); } } SEAM(0);
    if (IN(1)) DUP(1) { LOADP(); pg8::Gemm g{(const bf16_t*)(ws + WS_S3), (const bf16_t*)(ws + WS_WIN), T, 2 * DM, DM}; pg8::StaticOrder S; S.init(T, 2 * DM, gridDim.x, blockIdx.x);
        pg8::EpiRow8<F1> E{F1{(const float*)(ws + WS_MISC + MISC_RSTD0), (bf16_t*)(ws + WS_S1), (bf16_t*)(ws + WS_S2)}};
        pg8::gemm_phase<pg8::EpiRow8<F1>, pg8::StaticOrder, true, true>(lds, g, S, E, mk_tid(wv_s)); } SEAM(1);
    if (IN(2)) DUP(2) { LOADP(); (void)ws; ssm_phase(Q, lds, mk_tid(wv_s)); __syncthreads(); } SEAM(2);
    if (IN(3)) DUP(3) { LOADP(); pg8::Gemm g{(const bf16_t*)(ws + WS_S0), (const bf16_t*)(ws + WS_WGLU), T, DM, DM}; pg8::StaticOrder S; S.init(T, DM, gridDim.x, blockIdx.x);
        pg8::EpiRow8<F2> E{F2{Q.in[13], (const bf16_t*)(ws + WS_S0), (const bf16_t*)(ws + WS_S2), (bf16_t*)(ws + WS_S1)}};
        pg8::gemm_phase<pg8::EpiRow8<F2>, pg8::StaticOrder, true, true>(lds, g, S, E, mk_tid(wv_s)); } SEAM(3);
    if (IN(4)) DUP(4) { LOADP(); pg8::Gemm g{(const bf16_t*)(ws + WS_S1), (const bf16_t*)(ws + WS_WOUT), T, DM, DM}; pg8::StaticOrder S; S.init(T, DM, gridDim.x, blockIdx.x);
        unsigned* cnts = (unsigned*)(ws + WS_MISC + MISC_CTL + 16384); float* slots = (float*)(ws + WS_MISC + MISC_SLOTS);
        pg8::EpiNormRes<true> E{(const float*)(ws + WS_MISC + MISC_RSTD0), (const bf16_t*)(ws + WS_S3), nullptr, Q.in[2], (bf16_t*)(ws + WS_S0), pg8::RowStat{slots, cnts, nullptr}, pg8::RowStat{slots + 65536, cnts + 2048, (float*)(ws + WS_MISC + MISC_RSTD1)}};
        pg8::gemm_phase<pg8::EpiNormRes<true>, pg8::StaticOrder, false, true>(lds, g, S, E, mk_tid(wv_s)); }
    if (IN(4) && IN(6)) xcd_barrier(bar, mk_tid(wv_s));
    if (IN(6)) DUP(6) { LOADP(); logf_phase(Q, lds, mk_tid(wv_s));
        pg8::Gemm g{(const bf16_t*)(ws + WS_S0), (const bf16_t*)(ws + WS_WCAT), T, 4 * DM, DM}; pg8::StaticOrder S; S.init(T, 4 * DM, gridDim.x, blockIdx.x);
        pg8::EpiRow8<F4> E{F4{(const float*)(ws + WS_MISC + MISC_RSTD1), (bf16_t*)(ws + WS_S1), (bf16_t*)(ws + WS_S2), (bf16_t*)(ws + WS_S3), (bf16_t*)(ws + WS_S4)}};
        pg8::gemm_phase<pg8::EpiRow8<F4>, pg8::StaticOrder, true, true>(lds, g, S, E, mk_tid(wv_s)); } SEAM(6);
    if (IN(7)) { LOADP(); (void)ws; attn_phase(Q, (char*)lds_raw, wv_s); }

    if (IN(7) && IN(8)) xcd_barrier(bar, mk_tid(wv_s));
    if (IN(8)) DUP(8) { LOADP(); pg8::Gemm g{(const bf16_t*)(ws + WS_WIN), (const bf16_t*)(ws + WS_WFO), T, DM, DM}; pg8::StaticOrder S; S.init(T, DM, gridDim.x, blockIdx.x);
        unsigned* cnts = (unsigned*)(ws + WS_MISC + MISC_CTL + 16384); float* slots = (float*)(ws + WS_MISC + MISC_SLOTS);
        pg8::EpiNormRes<false> E{nullptr, (const bf16_t*)(ws + WS_S0), Q.out, Q.in[2] + DM, nullptr, pg8::RowStat{slots + 131072, cnts + 4096, nullptr}, pg8::RowStat{nullptr, nullptr, nullptr}};
        pg8::gemm_phase<pg8::EpiNormRes<false>, pg8::StaticOrder, false, true>(lds, g, S, E, mk_tid(wv_s)); }
#undef IN
#undef SEAM
#undef LOADP
}

#ifndef N_LAUNCHES
#define N_LAUNCHES 1
#endif
extern "C" void kernel_launch(void* const* d_in, const int* in_sizes, int n_in, void* d_out, int out_size, void* d_ws, size_t ws_size, hipStream_t stream) {
    static int grid = 0;
    if (grid == 0) {
        if (n_in != 20 || out_size != T * DM || ws_size < 256 * MiB) { fprintf(stderr, "kernel_launch: unexpected shapes (n_in %d out %d ws %zu)\n", n_in, out_size, ws_size); grid = -1; return; }
        int dev = 0, cus = 0, per_cu = 0;
        (void)hipGetDevice(&dev); (void)hipDeviceGetAttribute(&cus, hipDeviceAttributeMultiprocessorCount, dev);
        if (hipFuncSetAttribute((const void*)yoco_fwd, hipFuncAttributeMaxDynamicSharedMemorySize, LDS_TOTAL) != hipSuccess) { fprintf(stderr, "kernel_launch: hipFuncSetAttribute failed\n"); grid = -1; return; }
        if (hipOccupancyMaxActiveBlocksPerMultiprocessor(&per_cu, (const void*)yoco_fwd, 512, LDS_TOTAL) != hipSuccess || per_cu < 1) { fprintf(stderr, "kernel_launch: occupancy query says %d\n", per_cu); per_cu = 1; }
        (void)hipGetLastError();
        if (cus <= 0) cus = 256;
        grid = cus * (per_cu > 1 ? 1 : per_cu);
        if (grid != 256) { fprintf(stderr, "kernel_launch: this kernel needs exactly 256 workgroups (one per CU of a 256-CU device), got %d; nothing launched\n", grid); grid = -1; return; }
    }
    if (grid < 0) return;
    if (hipMemsetAsync((char*)d_ws + WS_MISC + MISC_CTL, 0, 65536, stream) != hipSuccess) { fprintf(stderr, "kernel_launch: memset failed\n"); return; }
    Params p{};
    for (int i = 0; i < 20; ++i) p.in[i] = (const float*)d_in[i];
    p.out = (float*)d_out; p.ws = (unsigned char*)d_ws;
#if N_LAUNCHES == 1
    p.ph_lo = 0; p.ph_hi = 10;
    void* args[] = {&p};
    hipError_t e = hipLaunchCooperativeKernel((const void*)yoco_fwd, dim3(grid), dim3(512), args, LDS_TOTAL, stream);
    if (e != hipSuccess) fprintf(stderr, "cooperative launch failed: %s (grid %d)\n", hipGetErrorString(e), grid);
#else
    for (int k = 0; k < 10; ++k) { p.ph_lo = k; p.ph_hi = k + 1; hipLaunchKernelGGL(yoco_fwd, dim3(grid), dim3(512), LDS_TOTAL, stream, p); }
#endif
}
```

```cpp
#include <hip/hip_runtime.h>
#include <hip/hip_bf16.h>
#include <hip/hip_cooperative_groups.h>
#include <cstdio>
#include <cstdint>
namespace cg = cooperative_groups;
namespace pg8 {
#define PG8_LAS __attribute__((address_space(3)))
typedef unsigned short bf16_t;
typedef short bf16x8 __attribute__((ext_vector_type(8)));
typedef float f32x4 __attribute__((ext_vector_type(4)));
typedef unsigned u32x4 __attribute__((ext_vector_type(4)));
constexpr int BM = 256, BK = 64, HALF = 128, HTB = HALF * BK * 2  , STAGE_BYTES = 8 * HTB, NXCD = 8, WGM = 8;

__host__ __device__ __forceinline__ int lds_byte(int r, int c) { const int st = (r >> 4) * 2 + (c >> 5), rr = r & 15, cc = c & 31, ob = rr * 64 + cc * 2; return st * 1024 + (ob ^ (((ob >> 9) & 1) << 5)); }
__host__ __device__ __forceinline__ void stage_rc(int b, int& R, int& C) { const int st = b / 1024, sb = b % 1024, swz = sb ^ (((sb >> 9) & 1) << 5); R = (st >> 1) * 16 + swz / 64; C = (st & 1) * 32 + (swz % 64) / 2; }
__host__ __device__ __forceinline__ int perm32(int rho) { const int n = rho >> 4, i = rho & 15; return 8 * (i >> 2) + 4 * n + (i & 3); }

struct Unit { int pm, pn; };
struct Gemm { const bf16_t* A; const bf16_t* Bt; int M, N, K; };

struct StaticOrder {
    int nM, nN, nwg, G, c;
    __host__ __device__ void init(int M, int N, int G_, int c_) { nM = M / BM; nN = N / BM; nwg = nM * nN; G = G_; c = c_; }
    __host__ __device__ bool next(int i, Unit& u) const {
        const long L = (long)i * G + c; if (L >= nwg) return false;
        int wgid = (int)L; { const int q = nwg / NXCD, r = nwg % NXCD, xcd = wgid % NXCD, off = wgid / NXCD; wgid = (xcd < r ? xcd * (q + 1) : r * (q + 1) + (xcd - r) * q) + off; }
        const int nig = WGM * nN, gid = wgid / nig, fm = gid * WGM, gsz = (nM - fm) < WGM ? (nM - fm) : WGM;
        u.pm = fm + ((wgid % nig) % gsz); u.pn = (wgid % nig) / gsz; return true;
    }
    __device__ __forceinline__ void a_ready(const Unit&) const {}
    __device__ __forceinline__ void done(const Unit&) const {}
};

__device__ __forceinline__ unsigned cvt_pk_bf16(float lo, float hi) { unsigned r; asm volatile("v_cvt_pk_bf16_f32 %0, %1, %2" : "=v"(r) : "v"(lo), "v"(hi)); return r; }
typedef float f32x2 __attribute__((ext_vector_type(2)));
template <class F> struct EpiRow8 {
    static constexpr bool PERM = true, AFTER_DRAIN = false;
    F f;
    __device__ __forceinline__ void operator()(const f32x4 (&acc)[2][2][4][2], const Unit& u, int wr, int wc, int fr, int fq) const {
        const int row0 = u.pm * BM + wr * 64 + fr, col0 = u.pn * BM + wc * 32 + 8 * fq;
#pragma unroll
        for (int ai = 0; ai < 2; ++ai)
#pragma unroll
            for (int m = 0; m < 4; ++m)
#pragma unroll
                for (int bj = 0; bj < 2; ++bj) f(row0 + ai * HALF + m * 16, col0 + bj * HALF, acc[ai][bj][m][0], acc[ai][bj][m][1]);
    }
    __device__ __forceinline__ void fused(f32x4 (&)[2][2][4][2], const Unit&, int, int, int, int, PG8_LAS unsigned char*, int, int) const {}
};
struct RowStat {
    float* slots;
    unsigned* cnt;
    float* rstd_out;
    __device__ __forceinline__ void run(const f32x4 (&v)[2][2][4][2], const Unit& u, int wr, int wc, int fr, int fq, PG8_LAS unsigned char* lds, int wid, int lane) const {
        PG8_LAS float* Pp = (PG8_LAS float*)lds;
        PG8_LAS float* S = (PG8_LAS float*)(lds + 4096);
#pragma unroll
        for (int ai = 0; ai < 2; ++ai)
#pragma unroll
            for (int m = 0; m < 4; ++m) {
                float s = 0.f;
#pragma unroll
                for (int bj = 0; bj < 2; ++bj)
#pragma unroll
                    for (int n = 0; n < 2; ++n) { const f32x4 x = v[ai][bj][m][n]; s += (x[0] * x[0] + x[1] * x[1]) + (x[2] * x[2] + x[3] * x[3]); }
                s += __shfl_xor(s, 16); s += __shfl_xor(s, 32);
                if (fq == 0) Pp[(ai * HALF + wr * 64 + m * 16 + fr) * 4 + wc] = s;
            }
        asm volatile("s_waitcnt lgkmcnt(0)" ::: "memory"); __builtin_amdgcn_s_barrier(); asm volatile("" ::: "memory");
        const int row = wid * 32 + (lane & 31);
        if (lane < 32) {
            const float t = (Pp[row * 4 + 0] + Pp[row * 4 + 1]) + (Pp[row * 4 + 2] + Pp[row * 4 + 3]);
            __hip_atomic_store(slots + (size_t)(u.pm * BM + row) * 8 + u.pn, t, __ATOMIC_RELAXED, __HIP_MEMORY_SCOPE_AGENT);
        }
        asm volatile("s_waitcnt vmcnt(0)" ::: "memory");
        if (lane == 0) __hip_atomic_fetch_add(cnt + 64 * u.pm, 1u, __ATOMIC_RELAXED, __HIP_MEMORY_SCOPE_AGENT);
        if (wid == 0) {
            unsigned spins = 0;
            while ((unsigned)__builtin_amdgcn_readfirstlane(__hip_atomic_load(cnt + 64 * u.pm, __ATOMIC_RELAXED, __HIP_MEMORY_SCOPE_AGENT)) < 64u) { __builtin_amdgcn_s_sleep(2); if (++spins > (1u << 22)) break; }
            __builtin_amdgcn_fence(__ATOMIC_ACQUIRE, "agent");
        }
        asm volatile("s_waitcnt vmcnt(0) lgkmcnt(0)" ::: "memory"); __builtin_amdgcn_s_barrier(); asm volatile("" ::: "memory");
        if (lane < 32) {
            const float* sl = slots + (size_t)(u.pm * BM + row) * 8; float t = 0.f;
#pragma unroll
            for (int k = 0; k < 8; ++k) t += __hip_atomic_load(sl + k, __ATOMIC_RELAXED, __HIP_MEMORY_SCOPE_AGENT);
            const float rs = rsqrtf(t * (1.f / 2048.f) + 1e-6f);
            S[row] = rs;
            if (rstd_out && u.pn == 0) rstd_out[u.pm * BM + row] = rs;
        }
        asm volatile("s_waitcnt lgkmcnt(0)" ::: "memory"); __builtin_amdgcn_s_barrier(); asm volatile("" ::: "memory");
    }
};
template <bool SECOND> struct EpiNormRes {
    static constexpr bool PERM = true, AFTER_DRAIN = true;
    const float* base  ; const bf16_t* base16; float* out; const float* gain; bf16_t* outb; RowStat st1, st2;
    __device__ __forceinline__ void operator()(const f32x4 (&)[2][2][4][2], const Unit&, int, int, int, int) const {}
    __device__ __forceinline__ void fused(f32x4 (&acc)[2][2][4][2], const Unit& u, int wr, int wc, int fr, int fq, PG8_LAS unsigned char* lds, int wid, int lane) const {
        const PG8_LAS float* S = (const PG8_LAS float*)(lds + 4096);
        st1.run(acc, u, wr, wc, fr, fq, lds, wid, lane);
        const int col0 = u.pn * BM + wc * 32 + 8 * fq;
        f32x4 g[2][2];
#pragma unroll
        for (int bj = 0; bj < 2; ++bj) { g[bj][0] = *(const f32x4*)(gain + col0 + bj * HALF); g[bj][1] = *(const f32x4*)(gain + col0 + bj * HALF + 4); }
#pragma unroll
        for (int ai = 0; ai < 2; ++ai)
#pragma unroll
            for (int m = 0; m < 4; ++m) { const int r = ai * HALF + wr * 64 + m * 16 + fr; const float rs = S[r]; const size_t off = (size_t)(u.pm * BM + r) * 2048 + col0; const float bs = SECOND ? base[u.pm * BM + r] : __builtin_amdgcn_rcpf(base[u.pm * BM + r]);
#pragma unroll
                for (int bj = 0; bj < 2; ++bj) {
                    f32x4 b0, b1;
                    { const u32x4 w = *(const u32x4*)(base16 + off + bj * HALF);
                        b0 = (f32x4){__uint_as_float(w.x << 16), __uint_as_float(w.x & 0xffff0000u), __uint_as_float(w.y << 16), __uint_as_float(w.y & 0xffff0000u)};
                        b1 = (f32x4){__uint_as_float(w.z << 16), __uint_as_float(w.z & 0xffff0000u), __uint_as_float(w.w << 16), __uint_as_float(w.w & 0xffff0000u)}; }
                    const f32x4 h0 = b0 * bs + acc[ai][bj][m][0] * rs * g[bj][0], h1 = b1 * bs + acc[ai][bj][m][1] * rs * g[bj][1];
                    if (!SECOND) { *(f32x4*)(out + off + bj * HALF) = h0; *(f32x4*)(out + off + bj * HALF + 4) = h1; }
                    else { acc[ai][bj][m][0] = h0; acc[ai][bj][m][1] = h1; }
                }
                if (m & 1) asm volatile("" ::: "memory"); }
        if (SECOND) { st2.run(acc, u, wr, wc, fr, fq, lds, wid, lane);
#pragma unroll
            for (int ai = 0; ai < 2; ++ai)
#pragma unroll
                for (int m = 0; m < 4; ++m) { const int r = ai * HALF + wr * 64 + m * 16 + fr; const float r1 = S[r]; const size_t off = (size_t)(u.pm * BM + r) * 2048 + col0;
#pragma unroll
                    for (int bj = 0; bj < 2; ++bj) { const f32x4 h0 = acc[ai][bj][m][0] * r1, h1 = acc[ai][bj][m][1] * r1;
                        u32x4 w; w.x = cvt_pk_bf16(h0[0], h0[1]); w.y = cvt_pk_bf16(h0[2], h0[3]); w.z = cvt_pk_bf16(h1[0], h1[1]); w.w = cvt_pk_bf16(h1[2], h1[3]);
                        *(u32x4*)(outb + off + bj * HALF) = w; } } }
    }
};
template <class Epi, class Sched, bool ALIGN_EPI = false, bool SP2 = false>
__device__ __forceinline__ void gemm_phase(PG8_LAS unsigned char* lds, const Gemm g, const Sched& S, const Epi& E, const int tid_in) {
    const int tid = tid_in, wid = __builtin_amdgcn_readfirstlane(tid >> 6), lane = tid & 63, wr = wid >> 2, wc = wid & 3, fr = lane & 15, fq = lane >> 4;
    const int K = g.K, nt = K / BK;
    unsigned voffA[2], voffB[2];
#pragma unroll
    for (int i = 0; i < 2; ++i) { int R, C; stage_rc(tid * 16 + i * 8192, R, C); const int Rb = Epi::PERM ? ((R & ~31) + perm32(R & 31)) : R;
        voffA[i] = (unsigned)(R * K + C) * 2u; voffB[i] = (unsigned)(Rb * K + C) * 2u; }
    const size_t kstep = (size_t)(BK * 2);
    const size_t hstep = (size_t)HALF * K * 2;
    const size_t tstep = 2 * hstep;
    const unsigned ldsw = (unsigned)wid * 1024u;
    const int aoff = lds_byte(wr * 64 + fr, fq * 8), boff = lds_byte(wc * 32 + fr, fq * 8);
#define PG8_SA(b, h) (((b) * 2 + (h)) * HTB)
#define PG8_SB(b, h) ((4 + (b) * 2 + (h)) * HTB)
#define PG8_STAGE(bufoff, gbase, voff) do { _Pragma("unroll") for (int _i = 0; _i < 2; ++_i) \
        __builtin_amdgcn_global_load_lds((const unsigned*)((const char*)(gbase) + (voff)[_i]), (PG8_LAS unsigned*)(lds + (bufoff) + ldsw + _i * 8192), 16, 0, 0); } while (0)
#define PG8_LDA(dst, b, h) do { _Pragma("unroll") for (int m = 0; m < 4; ++m) _Pragma("unroll") for (int k = 0; k < 2; ++k) dst[m][k] = *(const PG8_LAS bf16x8*)(lds + PG8_SA(b, h) + aoff + m * 2048 + k * 1024); } while (0)
#define PG8_LDB(dst, b, h) do { _Pragma("unroll") for (int n = 0; n < 2; ++n) _Pragma("unroll") for (int k = 0; k < 2; ++k) dst[n][k] = *(const PG8_LAS bf16x8*)(lds + PG8_SB(b, h) + boff + n * 2048 + k * 1024); } while (0)
#define PG8_MMA(ai, bj, At, Bt) do { __builtin_amdgcn_s_setprio(1); _Pragma("unroll") for (int m = 0; m < 4; ++m) _Pragma("unroll") for (int n = 0; n < 2; ++n) _Pragma("unroll") for (int k = 0; k < 2; ++k) \
        acc[ai][bj][m][n] = __builtin_amdgcn_mfma_f32_16x16x32_bf16(Bt[n][k], At[m][k], acc[ai][bj][m][n], 0, 0, 0); __builtin_amdgcn_s_setprio(0); } while (0)
#define PG8_WAIT_V(n) asm volatile("s_waitcnt vmcnt(" #n ")" ::: "memory")
#define PG8_WAIT_L(n) asm volatile("s_waitcnt lgkmcnt(" #n ")" ::: "memory")
#define PG8_BAR __builtin_amdgcn_s_barrier()
#define PG8_SCHED __builtin_amdgcn_sched_barrier(0)
    Unit cur, nxt; int ui = 0;
    if (!S.next(0, cur)) return;
    f32x4 acc[2][2][4][2];
#pragma unroll
    for (int a = 0; a < 2; ++a)
#pragma unroll
        for (int b = 0; b < 2; ++b)
#pragma unroll
            for (int m = 0; m < 4; ++m)
#pragma unroll
                for (int n = 0; n < 2; ++n) acc[a][b][m][n] = (f32x4){0.f, 0.f, 0.f, 0.f};
    bf16x8 At[4][2], B0[2][2], B1[2][2];
    const char* cA = (const char*)g.A + (size_t)cur.pm * tstep; const char* cB = (const char*)g.Bt + (size_t)cur.pn * tstep;
    S.a_ready(cur);
    if constexpr (SP2) {
        PG8_STAGE(PG8_SB(0, 0), cB, voffB); PG8_STAGE(PG8_SB(0, 1), cB + hstep, voffB); PG8_STAGE(PG8_SA(0, 0), cA, voffA); PG8_STAGE(PG8_SA(0, 1), cA + hstep, voffA);
        if (wr == 1) PG8_BAR;
        PG8_WAIT_V(2); PG8_BAR;
        PG8_STAGE(PG8_SB(1, 0), cB + kstep, voffB); PG8_STAGE(PG8_SA(1, 0), cA + kstep, voffA); PG8_STAGE(PG8_SB(1, 1), cB + hstep + kstep, voffB);
        PG8_WAIT_V(6); PG8_BAR;
    } else {
        PG8_STAGE(PG8_SB(0, 0), cB, voffB); PG8_STAGE(PG8_SA(0, 0), cA, voffA); PG8_STAGE(PG8_SB(0, 1), cB + hstep, voffB); PG8_STAGE(PG8_SA(0, 1), cA + hstep, voffA);
        if (wr == 1) PG8_BAR;
        PG8_WAIT_V(4); PG8_BAR;
        PG8_STAGE(PG8_SB(1, 0), cB + kstep, voffB); PG8_STAGE(PG8_SA(1, 0), cA + kstep, voffA); PG8_STAGE(PG8_SB(1, 1), cB + hstep + kstep, voffB);
        PG8_WAIT_V(6); PG8_BAR;
    }
    for (;;) {
        const bool has_next = S.next(ui + 1, nxt);
        const char* nA = has_next ? (const char*)g.A + (size_t)nxt.pm * tstep : cA; const char* nB = has_next ? (const char*)g.Bt + (size_t)nxt.pn * tstep : cB;
        for (int t = 0; t < nt; t += 2) {
            const bool last = (t == nt - 2);
            const char* a1 = cA + (size_t)(t + 1) * kstep;
            const char* a2 = last ? nA : cA + (size_t)(t + 2) * kstep; const char* b2 = last ? nB : cB + (size_t)(t + 2) * kstep;
            const char* a3 = a2 + kstep; const char* b3 = b2 + kstep;
            if (last && has_next) S.a_ready(nxt);
            if constexpr (SP2) {
            PG8_LDB(B0, 0, 0); PG8_LDB(B1, 0, 1); PG8_SCHED; PG8_LDA(At, 0, 0); PG8_STAGE(PG8_SA(1, 1), a1 + hstep, voffA);
            PG8_WAIT_V(8); PG8_WAIT_L(0); PG8_BAR; PG8_MMA(0, 0, At, B0); PG8_MMA(0, 1, At, B1); PG8_BAR; PG8_SCHED;
            PG8_LDA(At, 0, 1); PG8_STAGE(PG8_SB(0, 0), b2, voffB); PG8_STAGE(PG8_SB(0, 1), b2 + hstep, voffB); PG8_STAGE(PG8_SA(0, 0), a2, voffA);
            PG8_WAIT_V(8); PG8_WAIT_L(0); PG8_BAR; PG8_MMA(1, 0, At, B0); PG8_MMA(1, 1, At, B1); PG8_BAR; PG8_SCHED;
            PG8_LDB(B0, 1, 0); PG8_LDB(B1, 1, 1); PG8_SCHED; PG8_LDA(At, 1, 0); PG8_STAGE(PG8_SA(0, 1), a2 + hstep, voffA);
            PG8_WAIT_V(8); PG8_WAIT_L(0); PG8_BAR; PG8_MMA(0, 0, At, B0); PG8_MMA(0, 1, At, B1); PG8_BAR; PG8_SCHED;
            PG8_LDA(At, 1, 1); PG8_STAGE(PG8_SB(1, 0), b3, voffB); PG8_STAGE(PG8_SB(1, 1), b3 + hstep, voffB); PG8_STAGE(PG8_SA(1, 0), a3, voffA);
            PG8_WAIT_V(8); PG8_WAIT_L(0); PG8_BAR; PG8_MMA(1, 0, At, B0); PG8_MMA(1, 1, At, B1); PG8_BAR; PG8_SCHED;
            } else {
            PG8_LDB(B0, 0, 0); PG8_SCHED; PG8_LDA(At, 0, 0); PG8_STAGE(PG8_SA(1, 1), a1 + hstep, voffA);
            PG8_WAIT_L(8); PG8_BAR; PG8_WAIT_L(0); PG8_MMA(0, 0, At, B0); PG8_BAR; PG8_SCHED;
            PG8_LDB(B1, 0, 1); PG8_STAGE(PG8_SB(0, 0), b2, voffB);
            PG8_BAR; PG8_WAIT_L(0); PG8_MMA(0, 1, At, B1); PG8_BAR;
            PG8_LDA(At, 0, 1); PG8_STAGE(PG8_SA(0, 0), a2, voffA);
            PG8_BAR; PG8_WAIT_L(0); PG8_MMA(1, 0, At, B0); PG8_BAR; PG8_SCHED;
            PG8_STAGE(PG8_SB(0, 1), b2 + hstep, voffB);
            PG8_WAIT_V(6); PG8_BAR; PG8_MMA(1, 1, At, B1); PG8_BAR;
            PG8_LDB(B0, 1, 0); PG8_SCHED; PG8_LDA(At, 1, 0); PG8_STAGE(PG8_SA(0, 1), a2 + hstep, voffA);
            PG8_WAIT_L(8); PG8_BAR; PG8_WAIT_L(0); PG8_MMA(0, 0, At, B0); PG8_BAR; PG8_SCHED;
            PG8_LDB(B1, 1, 1); PG8_STAGE(PG8_SB(1, 0), b3, voffB);
            PG8_BAR; PG8_WAIT_L(0); PG8_MMA(0, 1, At, B1); PG8_BAR;
            PG8_LDA(At, 1, 1); PG8_STAGE(PG8_SA(1, 0), a3, voffA);
            PG8_BAR; PG8_WAIT_L(0); PG8_MMA(1, 0, At, B0); PG8_BAR; PG8_SCHED;
            PG8_STAGE(PG8_SB(1, 1), b3 + hstep, voffB);
            PG8_WAIT_V(6); PG8_BAR; PG8_MMA(1, 1, At, B1); PG8_BAR;
            }
        }
        if constexpr (ALIGN_EPI) { if (wr == 0) PG8_BAR; }
        if constexpr (!Epi::AFTER_DRAIN) { E(acc, cur, wr, wc, fr, fq); S.done(cur); }
        if (!has_next) break;
#pragma unroll
        for (int a = 0; a < 2; ++a)
#pragma unroll
            for (int b = 0; b < 2; ++b)
#pragma unroll
                for (int m = 0; m < 4; ++m)
#pragma unroll
                    for (int n = 0; n < 2; ++n) acc[a][b][m][n] = (f32x4){0.f, 0.f, 0.f, 0.f};
        cur = nxt; cA = nA; cB = nB; ++ui;
        if constexpr (ALIGN_EPI) { if (wr == 1) PG8_BAR; }
    }
    PG8_WAIT_V(0);
    if constexpr (!ALIGN_EPI) { if (wr == 0) PG8_BAR; }
    PG8_BAR;
    if constexpr (Epi::AFTER_DRAIN) { E.fused(acc, cur, wr, wc, fr, fq, lds, wid, lane); S.done(cur); }
#undef PG8_SA
#undef PG8_SB
#undef PG8_STAGE
#undef PG8_LDA
#undef PG8_LDB
#undef PG8_MMA
#undef PG8_WAIT_V
#undef PG8_WAIT_L
#undef PG8_BAR
#undef PG8_SCHED
}
}
namespace attn {
constexpr int D = 128; constexpr float THR = 8.f; constexpr bool WSKIP = false; constexpr int OSTR = 2048, BIAS_OFF = 69632, OST_OFF = 90112;
constexpr float SCALE = 0.08838834764831845f;
constexpr int NW = 8, QBLK = 32, KVBLK = 64, QB = NW * QBLK;
constexpr int SHM_V = KVBLK * D * 2, SHM_K = KVBLK * D * 2;
constexpr int LDS_BYTES = 2 * SHM_V + 2 * SHM_K + NW * 64 * 4;
using bf16 = __hip_bfloat16;
typedef short bf16x8 __attribute__((ext_vector_type(8)));
typedef short s16x4 __attribute__((ext_vector_type(4)));
typedef float f32x16 __attribute__((ext_vector_type(16)));
typedef float f32x4 __attribute__((ext_vector_type(4)));
typedef unsigned u32x4 __attribute__((ext_vector_type(4)));
template <class A, class Bt> struct same_t { static constexpr bool v = false; };
template <class A> struct same_t<A, A> { static constexpr bool v = true; };

#define KSWZ(row, colB) ((row) * 256 + ((colB) ^ (((row) & 7) << 4)))
#define SBAR() __builtin_amdgcn_sched_barrier(0)
__device__ __forceinline__ int v_st(int k, int c) { const int kk = (k & ~0xC) | ((k & 4) << 1) | ((k & 8) >> 1); return ((kk >> 3) * 4 + (c >> 5)) * 512 + ((kk & 7) * 32 + (c & 31)) * 2; }
__device__ __forceinline__ int v_rd_base(int lane) { return ((lane & 3) << 3) | (((lane >> 2) & 3) << 6) | (((lane >> 4) & 1) << 5) | (((lane >> 5) & 1) << 8); }
constexpr int v_rd_off(int d0, int ks, int half) { return d0 * 512 + ks * 4096 + half * 2048; }
__device__ __forceinline__ int crow(int r, int hi) { return (r & 3) + 8 * (r >> 2) + 4 * hi; }
__device__ __forceinline__ unsigned cvtpk(float lo, float hi) {
    unsigned r; asm volatile("v_cvt_pk_bf16_f32 %0, %1, %2" : "=v"(r) : "v"(lo), "v"(hi)); return r;
}
__device__ __forceinline__ bf16x8 pack8(f32x4 a, f32x4 b) {
    u32x4 w = {cvtpk(a[0], a[1]), cvtpk(a[2], a[3]), cvtpk(b[0], b[1]), cvtpk(b[2], b[3])};
    return *reinterpret_cast<bf16x8*>(&w);
}
template <class T> __device__ __forceinline__ bf16x8 load8(const T* p) {
    if constexpr (same_t<T, float>::v) { return pack8(*(const f32x4*)p, *(const f32x4*)(p + 4)); }
    else { return *reinterpret_cast<const bf16x8*>(p); }
}
__device__ __forceinline__ void mask_tile(f32x16& p0, f32x16& p1, int dq, unsigned W) {
    const float NEG = -__builtin_inff();
#pragma unroll
    for (int r = 0; r < 16; ++r) {
        const int c = (r & 3) + 8 * (r >> 2);
        if ((unsigned)(dq - c) >= W) p0[r] = NEG;
        if ((unsigned)(dq - c - 32) >= W) p1[r] = NEG;
    }
}
__device__ __forceinline__ void partialSM(f32x16& p0, f32x16& p1, float& m_reg, float& mn, float& alpha) {
    float pmax = p0[0]; for (int r = 1; r < 16; ++r) pmax = fmaxf(pmax, p0[r]); for (int r = 0; r < 16; ++r) pmax = fmaxf(pmax, p1[r]);
    { auto rr = __builtin_amdgcn_permlane32_swap(__float_as_uint(pmax), __float_as_uint(pmax), false, false);
      pmax = fmaxf(__uint_as_float(rr[0]), __uint_as_float(rr[1])); }
    constexpr float C2 = 1.4426950408889634f * SCALE;
    if (__builtin_expect(__all((pmax - m_reg) * SCALE <= THR), 1)) { mn = m_reg; alpha = 1.f; }
    else { mn = fmaxf(m_reg, pmax); alpha = __builtin_amdgcn_exp2f((m_reg - mn) * C2); m_reg = mn; }
    const float mnL = -mn * C2;
    for (int r = 0; r < 16; ++r) p0[r] = fmaf(p0[r], C2, mnL); for (int r = 0; r < 16; ++r) p1[r] = fmaf(p1[r], C2, mnL);
    for (int r = 0; r < 16; ++r) p0[r] = __builtin_amdgcn_exp2f(p0[r]);
}
__device__ __forceinline__ void finishSM(f32x16& p0, f32x16& p1, float alpha, float& l_reg, bf16x8& pa0, bf16x8& pa1, bf16x8& pa2, bf16x8& pa3) {
    for (int r = 0; r < 16; ++r) p1[r] = __builtin_amdgcn_exp2f(p1[r]);
    float ps = 0; for (int r = 0; r < 16; ++r) ps += p0[r]; for (int r = 0; r < 16; ++r) ps += p1[r];
    { auto rr = __builtin_amdgcn_permlane32_swap(__float_as_uint(ps), __float_as_uint(ps), false, false);
      ps = __uint_as_float(rr[0]) + __uint_as_float(rr[1]); }
    l_reg = l_reg * alpha + ps;
#define PK4(P, B_, OUT) do { unsigned a0 = cvtpk(P[B_+0], P[B_+1]), a1 = cvtpk(P[B_+2], P[B_+3]);                          \
        unsigned b0 = cvtpk(P[B_+4], P[B_+5]), b1 = cvtpk(P[B_+6], P[B_+7]);                                             \
        auto r0 = __builtin_amdgcn_permlane32_swap(a0, b0, false, false); auto r1 = __builtin_amdgcn_permlane32_swap(a1, b1, false, false); \
        u32x4 w = {r0[0], r1[0], r0[1], r1[1]}; OUT = *reinterpret_cast<bf16x8*>(&w); } while (0)
    PK4(p0, 0, pa0); PK4(p0, 8, pa1); PK4(p1, 0, pa2); PK4(p1, 8, pa3);
#undef PK4
}
__device__ __forceinline__ const float* bl_addr(const char* lds, int hi, int kbase) { int h = hi; asm volatile("" : "+v"(h)); return (const float*)(lds + BIAS_OFF) + 4 * h + kbase; }
template <int KB, bool SK>
__device__ __forceinline__ void qkt(f32x16& p0, f32x16& p1, const char* K_lds, int r32, int hi, const bf16x8* qr, bool act, const float* bl) {
    if (SK && !act) { const float NEG = -__builtin_inff();
#pragma unroll
        for (int r = 0; r < 16; ++r) { p0[r] = NEG; p1[r] = NEG; } return; }
    { const f32x4 c0 = *(const f32x4*)(bl), c1 = *(const f32x4*)(bl + 8), c2 = *(const f32x4*)(bl + 16), c3 = *(const f32x4*)(bl + 24);
      const f32x4 e0 = *(const f32x4*)(bl + 32), e1 = *(const f32x4*)(bl + 40), e2 = *(const f32x4*)(bl + 48), e3 = *(const f32x4*)(bl + 56);
      p0 = (f32x16){c0[0], c0[1], c0[2], c0[3], c1[0], c1[1], c1[2], c1[3], c2[0], c2[1], c2[2], c2[3], c3[0], c3[1], c3[2], c3[3]};
      p1 = (f32x16){e0[0], e0[1], e0[2], e0[3], e1[0], e1[1], e1[2], e1[3], e2[0], e2[1], e2[2], e2[3], e3[0], e3[1], e3[2], e3[3]}; }
    const char* kb[4];
#pragma unroll
    for (int dd = 0; dd < 4; ++dd) kb[dd] = K_lds + KB * SHM_K + KSWZ(r32, (dd * 16 + hi * 8) * 2);
#pragma unroll
    for (int d0 = 0; d0 < 8; ++d0) { const char* a = kb[d0 & 3] + (d0 >> 2) * 128;
        bf16x8 b0 = *reinterpret_cast<const bf16x8*>(a);
        bf16x8 b1 = *reinterpret_cast<const bf16x8*>(a + 32 * 256);
        p0 = __builtin_amdgcn_mfma_f32_32x32x16_bf16(b0, qr[d0], p0, 0, 0, 0);
        p1 = __builtin_amdgcn_mfma_f32_32x32x16_bf16(b1, qr[d0], p1, 0, 0, 0); }
}
template <int VB, bool SK>
__device__ __forceinline__ void pv_tile(f32x16* o, int vb0, bf16x8 pa0, bf16x8 pa1, bf16x8 pa2, bf16x8 pa3, bool act) {
    if (SK && !act) return;
#define TRRD(dst, off) asm volatile("ds_read_b64_tr_b16 %0, %1 offset:%2" : "=&v"(dst) : "v"(vb0), "i"(off) : "memory")
#define PV_D0(d0) do { s16x4 l0, l1, l2, l3, h0, h1, h2, h3; constexpr int b_ = VB * SHM_V + v_rd_off(d0, 0, 0);     \
        TRRD(l0, b_); TRRD(h0, b_ + 2048); TRRD(l1, b_ + 4096); TRRD(h1, b_ + 6144); TRRD(l2, b_ + 8192); TRRD(h2, b_ + 10240); TRRD(l3, b_ + 12288); TRRD(h3, b_ + 14336); \
        asm volatile("s_waitcnt lgkmcnt(0)" ::: "memory"); SBAR();                 \
        o[d0] = __builtin_amdgcn_mfma_f32_32x32x16_bf16(pa0, (bf16x8){l0[0], l0[1], l0[2], l0[3], h0[0], h0[1], h0[2], h0[3]}, o[d0], 0, 0, 0);   \
        o[d0] = __builtin_amdgcn_mfma_f32_32x32x16_bf16(pa1, (bf16x8){l1[0], l1[1], l1[2], l1[3], h1[0], h1[1], h1[2], h1[3]}, o[d0], 0, 0, 0);   \
        o[d0] = __builtin_amdgcn_mfma_f32_32x32x16_bf16(pa2, (bf16x8){l2[0], l2[1], l2[2], l2[3], h2[0], h2[1], h2[2], h2[3]}, o[d0], 0, 0, 0);   \
        o[d0] = __builtin_amdgcn_mfma_f32_32x32x16_bf16(pa3, (bf16x8){l3[0], l3[1], l3[2], l3[3], h3[0], h3[1], h3[2], h3[3]}, o[d0], 0, 0, 0); } while (0)
    PV_D0(0); PV_D0(1); PV_D0(2); PV_D0(3);
#undef PV_D0
#undef TRRD
}

template <class TIn, class TOut> struct BlockRef { const TIn* Q; const TIn* K; const TIn* V; TOut* O; const unsigned short* Z; int P0; };
template <class TIn> struct Seam {
    bf16x8 qr[8];
    bf16x8 st_v0, st_v1, st_k0, st_k1; f32x4 sf0, sf1, sf2, sf3;
    f32x4 tq[16];
};
__device__ __forceinline__ int swa_jlo(int P0, int W) { const int lowk = P0 - W + 1; return lowk > 0 ? lowk / KVBLK : 0; }
__device__ __forceinline__ int hm16(int r, int d) { return (r & ~15) * 128 + ((((d >> 5) * 16 + (r & 15)) * 4 + ((d >> 3) & 3)) << 3); }
#define ROW(p, k0, rr) ((p) + (size_t)(k0) * D + hm16((rr), sc))
#define VMW() asm volatile("s_waitcnt vmcnt(0)" ::: "memory")
#define VMWN(n) asm volatile("s_waitcnt vmcnt(%0)" :: "i"(n) : "memory")
#define SLOAD_H(Kp, Vp, k0) do { S.st_v0 = load8<TIn>(ROW(Vp, k0, sr)); S.st_v1 = load8<TIn>(ROW(Vp, k0, 32 + sr));              \
                         S.st_k0 = load8<TIn>(ROW(Kp, k0, sr)); S.st_k1 = load8<TIn>(ROW(Kp, k0, 32 + sr)); } while (0)
#define SWRITE_HK(bf) do { *(bf16x8*)(K_lds + (bf) * SHM_K + kws) = S.st_k0; *(bf16x8*)(K_lds + (bf) * SHM_K + kws + 32 * 256) = S.st_k1; } while (0)
#define SWRITE_HV(bf) do { *(bf16x8*)(V_lds + (bf) * SHM_V + vst0) = S.st_v0; *(bf16x8*)(V_lds + (bf) * SHM_V + vst1) = S.st_v1; } while (0)
#define SWRITE_H(bf) do { SWRITE_HV(bf); SWRITE_HK(bf); } while (0)
#define SLOAD_F(p, k0) do { S.sf0 = *(const f32x4*)ROW(p, k0, sr); S.sf1 = *(const f32x4*)(ROW(p, k0, sr) + 4);                \
                            S.sf2 = *(const f32x4*)ROW(p, k0, 32 + sr); S.sf3 = *(const f32x4*)(ROW(p, k0, 32 + sr) + 4); } while (0)
#define SWRITE_KF(bf) do { *(bf16x8*)(K_lds + (bf) * SHM_K + kws) = pack8(S.sf0, S.sf1); *(bf16x8*)(K_lds + (bf) * SHM_K + kws + 32 * 256) = pack8(S.sf2, S.sf3); } while (0)
#define SWRITE_VF(bf) do { *(bf16x8*)(V_lds + (bf) * SHM_V + vst0) = pack8(S.sf0, S.sf1); *(bf16x8*)(V_lds + (bf) * SHM_V + vst1) = pack8(S.sf2, S.sf3); } while (0)
template <class TIn, class TOut>
__device__ __forceinline__ void causal_swa_prime(const BlockRef<TIn, TOut>& cur, int W, char* lds, Seam<TIn>& S, const int tid_in) {
    constexpr bool F32 = same_t<TIn, float>::v;
    const int tid = tid_in, wid = __builtin_amdgcn_readfirstlane(tid >> 6), lane = tid & 63, r32 = lane & 31, hi = lane >> 5;
    const int sr = tid >> 4, sc = (tid & 15) * 8, kws = KSWZ(sr, sc * 2); char* K_lds = lds + 2 * SHM_V;
    const int kb0 = swa_jlo(cur.P0, W) * KVBLK;
    for (int d0 = 0; d0 < 8; ++d0) S.qr[d0] = load8<TIn>(cur.Q + hm16(wid * QBLK + r32, d0 * 16 + hi * 8));
    if constexpr (F32) { SLOAD_F((const float*)cur.K, kb0); VMW(); SWRITE_KF(0); SBAR(); SLOAD_F((const float*)cur.V, kb0); }
    else { SLOAD_H(cur.K, cur.V, kb0); VMW(); SWRITE_HK(0); }
    __syncthreads();
}
template <class TIn, class TOut>
__device__ __forceinline__ void causal_swa_block(const BlockRef<TIn, TOut>& cur, const BlockRef<TIn, TOut>& nxt, int skv, int W, char* lds, Seam<TIn>& S, const int tid_in) {
    constexpr bool F32 = same_t<TIn, float>::v;
    const int tid = tid_in, wid = __builtin_amdgcn_readfirstlane(tid >> 6), lane = tid & 63, r32 = lane & 31, hi = lane >> 5;
    const int j_lo = swa_jlo(cur.P0, W);
    int j_hi = (cur.P0 + QB - 1) / KVBLK + 1; if (j_hi > skv / KVBLK) j_hi = skv / KVBLK;
    const int NT = j_hi - j_lo;
    const int kbn = swa_jlo(nxt.P0, W) * KVBLK;
    const int qlo = cur.P0 + wid * QBLK, qm = qlo + r32 - 4 * hi;
    char* V_lds = lds; char* K_lds = lds + 2 * SHM_V;
    float* ws = (float*)(lds + 2 * SHM_V + 2 * SHM_K) + wid * 64; float* li_l = ws, * al_l = ws + 32;
    float m_reg = ((const float*)(lds + BIAS_OFF))[cur.P0 + wid * QBLK + r32], l_reg = 0; f32x16 o[4] = {};
    const int sr = tid >> 4, sc = (tid & 15) * 8, vst0 = v_st(sr, sc), vst1 = v_st(32 + sr, sc), kws = KSWZ(sr, sc * 2);
    const int vb0 = (int)(uintptr_t)V_lds + v_rd_base(lane);
    const TIn* Kh = cur.K; const TIn* Vh = cur.V;
#define RESC(a) do { if (__any((a) < 1.f)) { if (hi == 0) al_l[r32] = (a); asm volatile("s_waitcnt lgkmcnt(0)" ::: "memory");              \
                     for (int d_ = 0; d_ < 4; ++d_) for (int r = 0; r < 16; ++r) o[d_][r] *= al_l[crow(r, hi)]; } } while (0)
#define KBASE(t) ((j_lo + (t)) * KVBLK)
#define BL(t) bl_addr(lds, hi, KBASE(t))
#define ACT(t) (KBASE(t) <= qlo + QBLK - 1 && KBASE(t) + KVBLK - 1 >= qlo - W + 1)
#define MASKT(P0_, P1_, t) do { const int kb_ = KBASE(t); if ((!SK || ACT(t)) && (kb_ + KVBLK - 1 > qlo || kb_ <= qlo + QBLK - 1 - W)) mask_tile(P0_, P1_, qm - kb_, (unsigned)W); } while (0)
    constexpr int NQL = F32 ? 16 : 8;
    constexpr bool SK = WSKIP && !F32;
#define SEAM_K0() do { VMWN(NQL); if constexpr (F32) { SWRITE_KF(0); SBAR(); SLOAD_F((const float*)nxt.V, kbn); } else { SWRITE_HK(0); } SBAR(); } while (0)
    f32x16 pA0, pA1, pB0, pB1; float mnA, mnB, alA, alB; bf16x8 pa0, pa1, pa2, pa3;
    if constexpr (F32) { VMW(); SWRITE_VF(0); SBAR(); } else { SWRITE_HV(0); SBAR(); }
    if (NT > 1) { if constexpr (F32) SLOAD_F((const float*)Kh, KBASE(1)); else SLOAD_H(Kh, Vh, KBASE(1)); }
    SBAR(); qkt<0, SK>(pA0, pA1, K_lds, r32, hi, S.qr, ACT(0), BL(0));
    if constexpr (F32) { if (NT > 1) { VMW(); SWRITE_KF(1); SBAR(); SLOAD_F((const float*)Vh, KBASE(1)); } }
    MASKT(pA0, pA1, 0); partialSM(pA0, pA1, m_reg, mnA, alA);
    if (NT > 1) { VMW(); if constexpr (F32) { SWRITE_VF(1); SBAR(); if (NT > 2) SLOAD_F((const float*)Kh, KBASE(2)); } else SWRITE_H(1); }
    __syncthreads();
#define HALF_STEP(PX0, PX1, mnX, alX, PY0, PY1, alY, t, KB, VB, SB) do {                                                      \
        SBAR(); qkt<KB, SK>(PX0, PX1, K_lds, r32, hi, S.qr, ACT(t), BL(t));                                             \
        finishSM(PY0, PY1, alY, l_reg, pa0, pa1, pa2, pa3); SBAR();                                                           \
        if ((t) + 1 < NT) { if constexpr (F32) { VMW(); SWRITE_KF(SB); SBAR(); SLOAD_F((const float*)Vh, KBASE((t) + 1)); }  \
                            else { SLOAD_H(Kh, Vh, KBASE((t) + 1)); } SBAR(); }                                               \
        pv_tile<VB, SK>(o, vb0, pa0, pa1, pa2, pa3, ACT((t) - 1)); MASKT(PX0, PX1, (t)); partialSM(PX0, PX1, m_reg, mnX, alX);                                        \
        __syncthreads();                                                                                                      \
        if ((t) + 1 < NT) { VMW(); if constexpr (F32) { SWRITE_VF(SB); SBAR(); if ((t) + 2 < NT) SLOAD_F((const float*)Kh, KBASE((t) + 2)); } \
                            else { SWRITE_H(SB); } }                                                                          \
        RESC(alX); __syncthreads(); } while (0)
    for (int t = 1; t + 1 < NT; t += 2) {
        HALF_STEP(pB0, pB1, mnB, alB, pA0, pA1, alA, t, 1, 0, 0);
        HALF_STEP(pA0, pA1, mnA, alA, pB0, pB1, alB, t + 1, 0, 1, 1);
    }
    const bool even = (NT & 1) == 0;
    if (even) { SBAR(); qkt<1, SK>(pB0, pB1, K_lds, r32, hi, S.qr, ACT(NT - 1), BL(NT - 1)); SBAR(); }
#define QROW(e) (nxt.Q + (size_t)(wid * QBLK + r32) * D + ((e) >> 1) * 16 + hi * 8 + ((e) & 1) * 4)
    if constexpr (F32) { SLOAD_F((const float*)nxt.K, kbn); SBAR();
#pragma unroll
        for (int e = 0; e < 8; ++e) S.tq[e] = *(const f32x4*)QROW(e); }
    else { SLOAD_H(nxt.K, nxt.V, kbn); SBAR();
#pragma unroll
        for (int d0 = 0; d0 < 8; ++d0) S.qr[d0] = load8<TIn>(nxt.Q + hm16(wid * QBLK + r32, d0 * 16 + hi * 8)); }
    SBAR();
    finishSM(pA0, pA1, alA, l_reg, pa0, pa1, pa2, pa3); SBAR();
    if constexpr (F32) {
#pragma unroll
        for (int e = 8; e < 16; ++e) S.tq[e] = *(const f32x4*)QROW(e); SBAR(); }
#undef QROW
    pv_tile<0, SK>(o, vb0, pa0, pa1, pa2, pa3, ACT(even ? NT - 2 : NT - 1));
    if (even) { MASKT(pB0, pB1, NT - 1); partialSM(pB0, pB1, m_reg, mnB, alB); __syncthreads(); RESC(alB);
        finishSM(pB0, pB1, alB, l_reg, pa0, pa1, pa2, pa3); SBAR(); pv_tile<1, SK>(o, vb0, pa0, pa1, pa2, pa3, ACT(NT - 1)); }
    SBAR(); SEAM_K0();
    if (hi == 0) li_l[r32] = l_reg; asm volatile("s_waitcnt lgkmcnt(0)" ::: "memory");
    float rli[16];
#pragma unroll
    for (int r = 0; r < 16; ++r) rli[r] = __builtin_amdgcn_rcpf(li_l[crow(r, hi)]);
    { unsigned short* stg = (unsigned short*)(lds + OST_OFF) + wid * 2048;
      size_t obase = (size_t)cur.O, zbase = (size_t)cur.Z; int ln = lane; asm volatile("" : "+s"(obase), "+s"(zbase), "+v"(ln));
#pragma unroll
      for (int half = 0; half < 2; ++half) {
#pragma unroll
        for (int r = 0; r < 16; ++r) { const int orow = crow(r, hi);
#pragma unroll
          for (int dl = 0; dl < 2; ++dl) { const float v = o[half * 2 + dl][r] * rli[r]; stg[orow * 64 + dl * 32 + r32] = (unsigned short)(cvtpk(v, v) & 0xffffu); } }
        asm volatile("s_waitcnt lgkmcnt(0)" ::: "memory");
#pragma unroll
        for (int i = 0; i < 4; ++i) { const int row = i * 8 + (ln >> 3), ch = ln & 7;
          const u32x4 v = *(const u32x4*)(stg + row * 64 + ch * 8);
          const size_t off = ((size_t)(wid * QBLK + row) * OSTR + half * 64 + ch * 8) * 2;
          const u32x4 z = *(const u32x4*)(zbase + (size_t)hm16(wid * QBLK + row, half * 64 + ch * 8) * 2); u32x4 w;
#define MUL2(a_, b_) cvtpk(__uint_as_float((a_) << 16) * __uint_as_float((b_) << 16), __uint_as_float((a_) & 0xffff0000u) * __uint_as_float((b_) & 0xffff0000u))
          w.x = MUL2(v.x, z.x); w.y = MUL2(v.y, z.y); w.z = MUL2(v.z, z.z); w.w = MUL2(v.w, z.w);
#undef MUL2
          *(u32x4*)(obase + off) = w; }
        asm volatile("s_waitcnt lgkmcnt(0)" ::: "memory");
      } }
    if constexpr (F32) {
#pragma unroll
        for (int d0 = 0; d0 < 8; ++d0) S.qr[d0] = pack8(S.tq[2 * d0], S.tq[2 * d0 + 1]); }
    __syncthreads();
#undef RESC
#undef KBASE
#undef BL
#undef ACT
#undef MASKT
#undef SEAM_K0
#undef HALF_STEP
}
#undef ROW
#undef VMW
#undef VMWN
#undef SLOAD_H
#undef SWRITE_HK
#undef SWRITE_HV
#undef SWRITE_H
#undef SLOAD_F
#undef SWRITE_KF
#undef SWRITE_VF

}
#define LAS __attribute__((address_space(3)))
typedef unsigned short bf16_t;
typedef short bf16x8 __attribute__((ext_vector_type(8)));
typedef float f32x4 __attribute__((ext_vector_type(4)));
typedef float f32x16 __attribute__((ext_vector_type(16)));
typedef unsigned u32x4 __attribute__((ext_vector_type(4)));
typedef unsigned u32x2 __attribute__((ext_vector_type(2)));

constexpr int DM = 2048, NB = 2, SEQ = 4096, T = NB * SEQ, NH = 16, HD = 128, NG = 128;
constexpr float EPS = 1e-6f;
constexpr size_t MiB = 1u << 20;
constexpr size_t WS_WIN = 0, WS_WGLU = 16 * MiB, WS_WOUT = 24 * MiB, WS_WCAT = 32 * MiB, WS_WFO = 64 * MiB;
constexpr size_t WS_S0 = 72 * MiB;
constexpr size_t WS_S1 = 104 * MiB;
constexpr size_t WS_S2 = 136 * MiB;
constexpr size_t WS_S3 = 168 * MiB;
constexpr size_t WS_S4 = 200 * MiB;
constexpr size_t WS_MISC = 232 * MiB;
constexpr size_t MISC_RSTD0 = 0, MISC_RSTD1 = 32768, MISC_LOGF = 65536, MISC_WFT = 65536 + 524288, MISC_CTL = 65536 + 524288 + 65536  , MISC_SLOTS = MISC_CTL + 65536  ;
constexpr int LDS_TOTAL = 147456;
constexpr int ATT_BIAS_OFF = 69632;
constexpr int ATT_WTOT_OFF = ATT_BIAS_OFF + 16384;

struct Params { const float* in[20]; float* out; unsigned char* ws; int ph_lo, ph_hi; };

__device__ __forceinline__ int mk_tid(int wv_s) { int t = wv_s * 64 + (int)__lane_id(); asm volatile("" : "+v"(t)); return t; }
__device__ __forceinline__ unsigned cvtpk(float lo, float hi) { unsigned r; asm volatile("v_cvt_pk_bf16_f32 %0, %1, %2" : "=v"(r) : "v"(lo), "v"(hi)); return r; }
__device__ __forceinline__ float bflo(unsigned w) { return __uint_as_float(w << 16); }
__device__ __forceinline__ float bfhi(unsigned w) { return __uint_as_float(w & 0xffff0000u); }
__device__ __forceinline__ float sigmoidf_(float v) { return __builtin_amdgcn_rcpf(1.f + __expf(-v)); }
__device__ __forceinline__ float wave_sum(float v) {
#pragma unroll
    for (int o = 1; o < 64; o <<= 1) v += __shfl_xor(v, o);
    return v;
}
__device__ __forceinline__ void store8(bf16_t* dst, f32x4 a, f32x4 b) {
    u32x4 w; w.x = cvtpk(a[0], a[1]); w.y = cvtpk(a[2], a[3]); w.z = cvtpk(b[0], b[1]); w.w = cvtpk(b[2], b[3]);
    *(u32x4*)dst = w;
}

__device__ __forceinline__ void transpose_item(const float* W, int ldw, bf16_t* WT, int row_off, const float* gk, LAS float* scr, int nblk, int item, int lane) {
    const int kb = item / nblk, nb = item % nblk, k0 = 64 * kb, n0 = 32 * nb;
    float wv_[32], gv_[32];
    const float* wp = W + (size_t)(k0 + (lane >> 5)) * ldw + n0 + (lane & 31);
#pragma unroll
    for (int i = 0; i < 32; ++i) wv_[i] = __builtin_nontemporal_load(wp + (size_t)(2 * i) * ldw);
    if (gk) {
#pragma unroll
        for (int i = 0; i < 32; ++i) gv_[i] = gk[k0 + 2 * i + (lane >> 5)];
#pragma unroll
        for (int i = 0; i < 32; ++i) wv_[i] *= gv_[i];
    }
#pragma unroll
    for (int i = 0; i < 32; ++i) scr[(2 * i + (lane >> 5)) * 33 + (lane & 31)] = wv_[i];
    asm volatile("s_waitcnt lgkmcnt(0)" ::: "memory");
    const int c = lane & 7;
#pragma unroll
    for (int j = 0; j < 4; ++j) { const int n = (lane >> 3) + 8 * j; const LAS float* s = scr + (8 * c) * 33 + n;
        u32x4 o; o.x = cvtpk(s[0 * 33], s[1 * 33]); o.y = cvtpk(s[2 * 33], s[3 * 33]); o.z = cvtpk(s[4 * 33], s[5 * 33]); o.w = cvtpk(s[6 * 33], s[7 * 33]);
        *(u32x4*)(WT + (size_t)(row_off + n0 + n) * DM + k0 + 8 * c) = o; }
    asm volatile("s_waitcnt lgkmcnt(0)" ::: "memory");
}
__device__ __forceinline__ void titem_load(const float* W, int ldw, int nblk, int item, int lane, float (&cv)[32]) {
    const int kb = item / nblk, nb = item % nblk, k0 = 64 * kb, n0 = 32 * nb;
    const float* wp = W + (size_t)(k0 + (lane >> 5)) * ldw + n0 + (lane & 31);
#pragma unroll
    for (int i = 0; i < 32; ++i) cv[i] = __builtin_nontemporal_load(wp + (size_t)(2 * i) * ldw);
}
__device__ __forceinline__ void titem_store(bf16_t* WT, int row_off, const float* gk, int nblk, int item, int lane, LAS float* scr, const float (&cv)[32]) {
    const int kb = item / nblk, nb = item % nblk, k0 = 64 * kb, n0 = 32 * nb;
#pragma unroll
    for (int i = 0; i < 32; ++i) scr[(2 * i + (lane >> 5)) * 33 + (lane & 31)] = cv[i];
    asm volatile("s_waitcnt lgkmcnt(0)" ::: "memory");
    const int c = lane & 7;
    f32x4 g0 = {1.f, 1.f, 1.f, 1.f}, g1 = {1.f, 1.f, 1.f, 1.f};
    if (gk) { g0 = *(const f32x4*)(gk + k0 + 8 * c); g1 = *(const f32x4*)(gk + k0 + 8 * c + 4); }
#pragma unroll
    for (int j = 0; j < 4; ++j) { const int n = (lane >> 3) + 8 * j; const LAS float* s = scr + (8 * c) * 33 + n;
        u32x4 o; o.x = cvtpk(s[0 * 33] * g0[0], s[1 * 33] * g0[1]); o.y = cvtpk(s[2 * 33] * g0[2], s[3 * 33] * g0[3]); o.z = cvtpk(s[4 * 33] * g1[0], s[5 * 33] * g1[1]); o.w = cvtpk(s[6 * 33] * g1[2], s[7 * 33] * g1[3]);
        *(u32x4*)(WT + (size_t)(row_off + n0 + n) * DM + k0 + 8 * c) = o; }
    asm volatile("s_waitcnt lgkmcnt(0)" ::: "memory");
}
#define P0_DECODE(S, it_) int r##S = (it_); const float* W##S; int ldw##S, roff##S, nblk##S; bf16_t* WT##S; const float* gk##S; \
    if (r##S < I_IN) { W##S = w3; ldw##S = 4096; WT##S = (bf16_t*)(ws + WS_WIN); roff##S = 0; gk##S = g1p; nblk##S = 128; } \
    else if (r##S < I_IN + I_SQ) { r##S -= I_IN; W##S = w12; ldw##S = 2048; WT##S = (bf16_t*)(ws + WS_WGLU); roff##S = 0; gk##S = nullptr; nblk##S = 64; } \
    else if (r##S < I_IN + 2 * I_SQ) { r##S -= I_IN + I_SQ; W##S = w14; ldw##S = 2048; WT##S = (bf16_t*)(ws + WS_WOUT); roff##S = 0; gk##S = nullptr; nblk##S = 64; } \
    else if (r##S < 2 * I_IN + 2 * I_SQ) { r##S -= I_IN + 2 * I_SQ; W##S = w16; ldw##S = 4112; WT##S = (bf16_t*)(ws + WS_WCAT); roff##S = 0; gk##S = g15; nblk##S = 128; } \
    else if (r##S < 3 * I_IN + 2 * I_SQ) { r##S -= 2 * I_IN + 2 * I_SQ; W##S = w18; ldw##S = 4096; WT##S = (bf16_t*)(ws + WS_WCAT); roff##S = 4096; gk##S = g1p + DM; nblk##S = 128; } \
    else { r##S -= 3 * I_IN + 2 * I_SQ; W##S = w19; ldw##S = 2048; WT##S = (bf16_t*)(ws + WS_WFO); roff##S = 0; gk##S = nullptr; nblk##S = 64; }
__device__ __forceinline__ void p0_phase(const Params& P, LAS unsigned char* lds, const int tid) {
    const int lane = tid & 63, wave = tid >> 6;
    LAS float* scrA = (LAS float*)(lds + wave * 16896); LAS float* scrB = scrA + 64 * 33;
    const int gw = blockIdx.x * 8 + wave, NGW = gridDim.x * 8;
    constexpr int I_IN = 32 * 128, I_SQ = 32 * 64, NIT = 3 * I_IN + 3 * I_SQ;
    unsigned char* ws = P.ws;
    const float* w3 = P.in[3]; const float* w12 = P.in[12]; const float* w14 = P.in[14]; const float* w16 = P.in[16]; const float* w18 = P.in[18]; const float* w19 = P.in[19];
    const float* g1p = P.in[1]; const float* g15 = P.in[15];
    asm("" : "+s"(w3)); asm("" : "+s"(w12)); asm("" : "+s"(w14)); asm("" : "+s"(w16)); asm("" : "+s"(w18)); asm("" : "+s"(w19)); asm("" : "+s"(g1p)); asm("" : "+s"(g15));
    for (int it = gw; it < NIT; it += 2 * NGW) {
        const bool hasB = it + NGW < NIT;
        P0_DECODE(A, it); P0_DECODE(B, hasB ? it + NGW : it);
        float ca[32], cb[32];
        titem_load(WA, ldwA, nblkA, rA, lane, ca);
        titem_load(WB, ldwB, nblkB, rB, lane, cb);
        titem_store(WTA, roffA, gkA, nblkA, rA, lane, scrA, ca);
        if (hasB) titem_store(WTB, roffB, gkB, nblkB, rB, lane, scrB, cb);
    }
    { bf16_t* wfT = (bf16_t*)(ws + WS_MISC + MISC_WFT); const float* kvw = P.in[16]; const float* gkv = P.in[15];
      for (int i = blockIdx.x * 512 + tid; i < 16 * DM; i += gridDim.x * 512) { const int c = i >> 11, k = i & 2047;
          const float v = gkv[k] * kvw[(size_t)k * 4112 + 4096 + c]; wfT[i] = (bf16_t)(cvtpk(v, v) & 0xffffu); } }
    { const float* x = P.in[0]; bf16_t* xb = (bf16_t*)(ws + WS_S3); float* rstd0 = (float*)(ws + WS_MISC + MISC_RSTD0);
      for (int m = gw; m < T; m += 2 * NGW) {
          const int m1 = (m + NGW < T) ? m + NGW : m;
          const f32x4* xr0 = (const f32x4*)(x + (size_t)m * DM) + lane; const f32x4* xr1 = (const f32x4*)(x + (size_t)m1 * DM) + lane; f32x4 v0[8], v1[8]; float s0 = 0.f, s1 = 0.f;
#pragma unroll
          for (int j = 0; j < 8; ++j) v0[j] = __builtin_nontemporal_load(xr0 + 64 * j);
#pragma unroll
          for (int j = 0; j < 8; ++j) v1[j] = __builtin_nontemporal_load(xr1 + 64 * j);
#pragma unroll
          for (int j = 0; j < 8; ++j) { s0 += (v0[j][0] * v0[j][0] + v0[j][1] * v0[j][1]) + (v0[j][2] * v0[j][2] + v0[j][3] * v0[j][3]); s1 += (v1[j][0] * v1[j][0] + v1[j][1] * v1[j][1]) + (v1[j][2] * v1[j][2] + v1[j][3] * v1[j][3]); }
          const float rs0 = rsqrtf(wave_sum(s0) * (1.f / DM) + EPS), rs1 = rsqrtf(wave_sum(s1) * (1.f / DM) + EPS);
          if (lane == 0) { rstd0[m] = 1.f / rs0; rstd0[m1] = 1.f / rs1; }
          u32x2* o0 = (u32x2*)(xb + (size_t)m * DM) + lane; u32x2* o1 = (u32x2*)(xb + (size_t)m1 * DM) + lane;
#pragma unroll
          for (int j = 0; j < 8; ++j) { v0[j] = v0[j] * rs0; v1[j] = v1[j] * rs1; u32x2 w; w.x = cvtpk(v0[j][0], v0[j][1]); w.y = cvtpk(v0[j][2], v0[j][3]); o0[64 * j] = w; u32x2 w1; w1.x = cvtpk(v1[j][0], v1[j][1]); w1.y = cvtpk(v1[j][2], v1[j][3]); o1[64 * j] = w1; }
      } }
}

__device__ __forceinline__ size_t sz_off(int row, int c) { return ((size_t)((row >> 4) * 64 + (c >> 5)) << 9) + ((((row & 15) * 4 + ((c >> 3) & 3))) << 3); }
struct F1 {
    const float* rstd; bf16_t* ug; bf16_t* sz;
    __device__ __forceinline__ void operator()(int row, int col, f32x4 a, f32x4 b) const {
        (void)rstd;
        if (col < DM) { const int bb = row >> 12, t = row & 4095, g = col >> 4;
            store8(ug + ((size_t)(bb * NG + g) * SEQ + t) * 16 + (col & 15), a, b); }
        else {
#pragma unroll
            for (int i = 0; i < 4; ++i) { a[i] = a[i] * sigmoidf_(a[i]); b[i] = b[i] * sigmoidf_(b[i]); }
            store8(sz + sz_off(row, col - DM), a, b); }
    }
};
struct F2 {
    const float* bias; const bf16_t* y1; const bf16_t* sz; bf16_t* y2;
    __device__ __forceinline__ void operator()(int row, int col, f32x4 a, f32x4 b) const {
        const f32x4 b0 = *(const f32x4*)(bias + col), b1 = *(const f32x4*)(bias + col + 4);
        const u32x4 yv = *(const u32x4*)(y1 + (size_t)row * DM + col), zv = *(const u32x4*)(sz + sz_off(row, col));
        a = a + b0; b = b + b1;
        f32x4 oa, ob;
        oa[0] = bflo(yv.x) * sigmoidf_(a[0]) * bflo(zv.x); oa[1] = bfhi(yv.x) * sigmoidf_(a[1]) * bfhi(zv.x);
        oa[2] = bflo(yv.y) * sigmoidf_(a[2]) * bflo(zv.y); oa[3] = bfhi(yv.y) * sigmoidf_(a[3]) * bfhi(zv.y);
        ob[0] = bflo(yv.z) * sigmoidf_(b[0]) * bflo(zv.z); ob[1] = bfhi(yv.z) * sigmoidf_(b[1]) * bfhi(zv.z);
        ob[2] = bflo(yv.w) * sigmoidf_(b[2]) * bflo(zv.w); ob[3] = bfhi(yv.w) * sigmoidf_(b[3]) * bfhi(zv.w);
        store8(y2 + (size_t)row * DM + col, oa, ob);
    }
};
struct F3 {
    bf16_t* o;
    __device__ __forceinline__ void operator()(int row, int col, f32x4 a, f32x4 b) const { store8(o + (size_t)row * DM + col, a, b); }
};
struct F4 {
    const float* rstd; bf16_t* kb; bf16_t* vb; bf16_t* qb; bf16_t* sz2;
    __device__ __forceinline__ void operator()(int row, int col, f32x4 a, f32x4 b) const {
        (void)rstd;
        const int sec = col >> 11, c = col & 2047;
        if (sec == 3) {
#pragma unroll
            for (int i = 0; i < 4; ++i) { a[i] = a[i] * sigmoidf_(a[i]); b[i] = b[i] * sigmoidf_(b[i]); } }
        const int bb = row >> 12, t = row & 4095, hh = c >> 7, d = c & 127;
        store8(kb + (size_t)sec * (16u << 20) + ((size_t)(bb * NH + hh) * SEQ) * HD + attn::hm16(t, d), a, b);
    }
};

#ifndef SSM_PF_U
#define SSM_PF_U 1
#endif
__device__ __forceinline__ void sincos_small(float x, float& s, float& c) {
    const float k = rintf(x * 0.63661977236758134f);
    float r = fmaf(-k, 1.57079625129699707031f, x); r = fmaf(-k, 7.54978941586159635335e-08f, r);
    const float r2 = r * r;
    const float sp = r + r * r2 * (-1.6666666666666666e-1f + r2 * (8.3333333333333332e-3f + r2 * (-1.9841269841269841e-4f + r2 * 2.7557319223985893e-6f)));
    const float cp = 1.f + r2 * (-0.5f + r2 * (4.1666666666666664e-2f + r2 * (-1.3888888888888889e-3f + r2 * (2.4801587301587302e-5f + r2 * -2.7557319223985888e-7f))));
    const int q = (int)k & 3;
    s = (q == 0) ? sp : (q == 1) ? cp : (q == 2) ? -sp : -cp;
    c = (q == 0) ? cp : (q == 1) ? -sp : (q == 2) ? -cp : sp;
}
__device__ __forceinline__ float gelu_tanh(float x) { const float u = 1.5957691216057308f * (x + 0.044715f * x * x * x); return x * sigmoidf_(u); }
__device__ __forceinline__ void ssm_phase(const Params& P, LAS unsigned char* lds, const int tid) {
    const int wv = __builtin_amdgcn_readfirstlane(tid >> 6);
    const float* a_re = P.in[4]; const float* a_im = P.in[5]; const float* log_dt = P.in[6]; const float* b_re = P.in[7]; const float* b_im = P.in[8];
    const float* c_re = P.in[9]; const float* c_im = P.in[10]; const float* dsk = P.in[11];
    const bf16_t* ug = (const bf16_t*)(P.ws + WS_S1); bf16_t* y1 = (bf16_t*)(P.ws + WS_S0);
    LAS float* Sst = (LAS float*)lds;
    LAS unsigned char* img = lds + 8192 + wv * 8704;
    for (int bg = blockIdx.x; bg < NB * NG; bg += gridDim.x) {
        int lane = tid & 63; asm volatile("" : "+v"(lane));
        const int n = lane & 31, hi = lane >> 5, l15 = lane & 15, kq = lane >> 4;
        const int b = bg >> 7, g = bg & 127;
        const float dt = expf(log_dt[g]);
        float abr[2], abi[2], qr_[2], qi_[2]; bf16x8 Bf[4];
#pragma unroll
        for (int ph = 0; ph < 2; ++ph) {
            const int p = ph * 32 + n; const float ar = a_re[g * 64 + p], ai = a_im[g * 64 + p];
            const float mag = expf(ar * dt); float cs, sn; sincos_small(ai * dt, sn, cs);
            abr[ph] = mag * cs; abi[ph] = mag * sn;
            const float den = ar * ar + ai * ai, nr = abr[ph] - 1.f;
            const float cr = (nr * ar + abi[ph] * ai) / den, ci = (abi[ph] * ar - nr * ai) / den;
            float pr = abr[ph], pi = abi[ph];
#pragma unroll
            for (int i = 0; i < 8; ++i) { const float t2 = pr * pr - pi * pi; pi = 2.f * pr * pi; pr = t2; }
            qr_[ph] = pr; qi_[ph] = pi;
            const float* brp = b_re + ((size_t)(g * 64 + p) * 16 + 8 * hi); const float* bip = b_im + ((size_t)(g * 64 + p) * 16 + 8 * hi);
            const f32x4 r0 = *(const f32x4*)brp, r1 = *(const f32x4*)(brp + 4), i0 = *(const f32x4*)bip, i1 = *(const f32x4*)(bip + 4);
            const f32x4 xr0 = r0 * cr - i0 * ci, xr1 = r1 * cr - i1 * ci, xi0 = i0 * cr + r0 * ci, xi1 = i1 * cr + r1 * ci;
            u32x4 wr_, wi_; wr_.x = cvtpk(xr0[0], xr0[1]); wr_.y = cvtpk(xr0[2], xr0[3]); wr_.z = cvtpk(xr1[0], xr1[1]); wr_.w = cvtpk(xr1[2], xr1[3]);
            wi_.x = cvtpk(xi0[0], xi0[1]); wi_.y = cvtpk(xi0[2], xi0[3]); wi_.z = cvtpk(xi1[0], xi1[1]); wi_.w = cvtpk(xi1[2], xi1[3]);
            Bf[ph * 2 + 0] = __builtin_bit_cast(bf16x8, wr_); Bf[ph * 2 + 1] = __builtin_bit_cast(bf16x8, wi_);
        }
        bf16x8 Cf[4], Df;
#pragma unroll
        for (int kk = 0; kk < 4; ++kk) {
            const f32x4 cr4 = *(const f32x4*)(c_re + (size_t)(g * 16 + l15) * 64 + kk * 16 + 4 * kq), ci4 = *(const f32x4*)(c_im + (size_t)(g * 16 + l15) * 64 + kk * 16 + 4 * kq);
            u32x4 w; w.x = cvtpk(cr4[0], -ci4[0]); w.y = cvtpk(cr4[1], -ci4[1]); w.z = cvtpk(cr4[2], -ci4[2]); w.w = cvtpk(cr4[3], -ci4[3]);
            Cf[kk] = __builtin_bit_cast(bf16x8, w);
        }
        { const float dv = dsk[g * 16 + l15]; float e[8];
#pragma unroll
          for (int j = 0; j < 8; ++j) e[j] = (kq < 2 && 8 * kq + j == l15) ? dv : 0.f;
          u32x4 w; w.x = cvtpk(e[0], e[1]); w.y = cvtpk(e[2], e[3]); w.z = cvtpk(e[4], e[5]); w.w = cvtpk(e[6], e[7]); Df = __builtin_bit_cast(bf16x8, w); }
        const bf16_t* ugb = ug + (size_t)bg * SEQ * 16;
        bf16_t* y1b = y1 + (size_t)b * SEQ * DM + g * 16;
        const int sm = (n >> 2) & 1, jm = (n & 3) + 4 * (n >> 3);
        float Hr[2] = {0.f, 0.f}, Hi[2] = {0.f, 0.f};
        for (int pass = 0; pass < 2; ++pass) {
            float hr[2] = {Hr[0], Hr[1]}, hi_[2] = {Hi[0], Hi[1]};
            const char* ugc = (const char*)ugb;
            const unsigned offA = (unsigned)(((wv * 2 + sm) * 256 + jm) * 16 + 8 * hi) * 2u;
            const unsigned offU = (unsigned)((wv * 2 * 256 + l15) * 16 + 8 * (kq & 1)) * 2u;
            bf16x8 Afn = *(const bf16x8*)(ugc + offA);
            for (int step = 0; step < 16; ++step) {
                const bf16x8 Af = Afn;
                if (step < 15) Afn = *(const bf16x8*)(ugc + (offA + (unsigned)(step + 1) * 512u));
#if SSM_PF_U
                bf16x8 Au0 = {0, 0, 0, 0, 0, 0, 0, 0}, Au1 = {0, 0, 0, 0, 0, 0, 0, 0};
                if (pass == 1 && kq < 2) { Au0 = *(const bf16x8*)(ugc + (offU + (unsigned)step * 512u)); Au1 = *(const bf16x8*)(ugc + (offU + 8192u + (unsigned)step * 512u)); }
#endif
                f32x16 x[4];
#pragma unroll
                for (int f = 0; f < 4; ++f) { f32x16 z16 = {}; x[f] = __builtin_amdgcn_mfma_f32_32x32x16_bf16(Af, Bf[f], z16, 0, 0, 0); }
                __builtin_amdgcn_sched_barrier(0);
#pragma unroll
                for (int r = 0; r < 16; ++r)
#pragma unroll
                    for (int ph = 0; ph < 2; ++ph) {
                        float t0 = fmaf(-abi[ph], hi_[ph], x[2 * ph][r]), t1 = fmaf(abi[ph], hr[ph], x[2 * ph + 1][r]);
                        asm("" : "+v"(t0)); asm("" : "+v"(t1));
                        float nr_ = fmaf(abr[ph], hr[ph], t0), ni_ = fmaf(abr[ph], hi_[ph], t1);
                        asm("" : "+v"(nr_)); asm("" : "+v"(ni_));
                        hr[ph] = nr_; hi_[ph] = ni_; x[2 * ph][r] = nr_; x[2 * ph + 1][r] = ni_;
                    }
                __builtin_amdgcn_sched_barrier(0);
                if (pass == 1) {
#pragma unroll
                    for (int ph = 0; ph < 2; ++ph)
#pragma unroll
                        for (int r = 0; r < 16; ++r) *(LAS unsigned*)(img + (hi * 16 + r) * 272 + (ph * 32 + n) * 4) = cvtpk(x[2 * ph][r], x[2 * ph + 1][r]);
                    asm volatile("s_waitcnt lgkmcnt(0)" ::: "memory");
#pragma unroll
                    for (int s2 = 0; s2 < 2; ++s2) {
                        __builtin_amdgcn_sched_barrier(0);
                        f32x4 acc = {0.f, 0.f, 0.f, 0.f};
#pragma unroll
                        for (int kk = 0; kk < 4; ++kk) { const bf16x8 Ah = *(const LAS bf16x8*)(img + (s2 * 16 + l15) * 272 + kk * 64 + kq * 16);
                            acc = __builtin_amdgcn_mfma_f32_16x16x32_bf16(Ah, Cf[kk], acc, 0, 0, 0); }
                        const int tokb = (wv * 2 + s2) * 256 + step * 16;
#if SSM_PF_U
                        acc = __builtin_amdgcn_mfma_f32_16x16x32_bf16(s2 ? Au1 : Au0, Df, acc, 0, 0, 0);
#else
                        { bf16x8 Au = {0, 0, 0, 0, 0, 0, 0, 0}; if (kq < 2) Au = *(const bf16x8*)(ugc + (offU + (unsigned)s2 * 8192u + (unsigned)step * 512u));
                          acc = __builtin_amdgcn_mfma_f32_16x16x32_bf16(Au, Df, acc, 0, 0, 0); }
#endif
#pragma unroll
                        for (int i = 0; i < 4; ++i) { const float yv = gelu_tanh(acc[i]); const int t = tokb + 4 * kq + i;
                            *(bf16_t*)((char*)y1b + ((unsigned)t * (unsigned)DM + (unsigned)l15) * 2u) = (bf16_t)(cvtpk(yv, yv) & 0xffffu); }
                    }
                    asm volatile("s_waitcnt lgkmcnt(0)" ::: "memory");
                }
            }
            if (pass == 0) {
                const int seg = wv * 2 + hi;
#pragma unroll
                for (int ph = 0; ph < 2; ++ph) { Sst[(seg * 64 + ph * 32 + n) * 2 + 0] = hr[ph]; Sst[(seg * 64 + ph * 32 + n) * 2 + 1] = hi_[ph]; }
                __syncthreads();
#pragma unroll
                for (int ph = 0; ph < 2; ++ph) { float cr_ = 0.f, ci_ = 0.f;
#pragma nounroll
                    for (int v = 0; v < 15; ++v) { if (v < seg) { const float sr = Sst[(v * 64 + ph * 32 + n) * 2 + 0], si = Sst[(v * 64 + ph * 32 + n) * 2 + 1];
                        const float t2 = qr_[ph] * cr_ - qi_[ph] * ci_ + sr; ci_ = qr_[ph] * ci_ + qi_[ph] * cr_ + si; cr_ = t2; } }
                    Hr[ph] = cr_; Hi[ph] = ci_; }
                __syncthreads();
            }
        }
    }
}

template <bool FIRST> __device__ __forceinline__ void row_phase(const Params& P, const int tid) {
    const int lane = tid & 63, wave = tid >> 6;
    const int gw = blockIdx.x * 8 + wave, NGW = gridDim.x * 8;
    const bf16_t* O = (const bf16_t*)(P.ws + WS_S3); const float* X = FIRST ? P.in[0] : P.out; float* OUT = P.out;
    const float* gp = P.in[2] + (FIRST ? 0 : DM);
    float* rstd1 = (float*)(P.ws + WS_MISC + MISC_RSTD1); bf16_t* h1b = (bf16_t*)(P.ws + WS_S0);
    for (int m = gw; m < T; m += NGW) {
        const u32x2* orow = (const u32x2*)(O + (size_t)m * DM) + lane; const f32x4* xrow = (const f32x4*)(X + (size_t)m * DM) + lane; f32x4* outr = (f32x4*)(OUT + (size_t)m * DM) + lane;
        f32x4 o[8]; float ss = 0.f;
#pragma unroll
        for (int j = 0; j < 8; ++j) { const u32x2 w = orow[64 * j]; o[j] = (f32x4){bflo(w.x), bfhi(w.x), bflo(w.y), bfhi(w.y)}; ss += (o[j][0] * o[j][0] + o[j][1] * o[j][1]) + (o[j][2] * o[j][2] + o[j][3] * o[j][3]); }
        const float rs = rsqrtf(wave_sum(ss) * (1.f / DM) + EPS);
        float ss1 = 0.f;
#pragma unroll
        for (int j = 0; j < 8; ++j) { const f32x4 g4 = ((const f32x4*)gp)[lane + 64 * j]; const f32x4 xv = xrow[64 * j]; o[j] = xv + o[j] * rs * g4; outr[64 * j] = o[j];
            ss1 += (o[j][0] * o[j][0] + o[j][1] * o[j][1]) + (o[j][2] * o[j][2] + o[j][3] * o[j][3]); }
        if (FIRST) {
            const float r1 = rsqrtf(wave_sum(ss1) * (1.f / DM) + EPS);
            if (lane == 0) rstd1[m] = r1;
            u32x2* o8 = (u32x2*)(h1b + (size_t)m * DM) + lane;
#pragma unroll
            for (int j = 0; j < 8; ++j) { u32x2 w; w.x = cvtpk(o[j][0], o[j][1]); w.y = cvtpk(o[j][2], o[j][3]); o8[64 * j] = w; }
        }
    }
}

__device__ __forceinline__ void logf_phase(const Params& P, LAS unsigned char* lds, const int tid) {
    const int lane = tid & 63, wv = __builtin_amdgcn_readfirstlane(tid >> 6), l15 = lane & 15, kq = lane >> 4;
    const bf16_t* h1b = (const bf16_t*)(P.ws + WS_S0); const bf16_t* wfT = (const bf16_t*)(P.ws + WS_MISC + MISC_WFT);
    const float* rstd1 = (const float*)(P.ws + WS_MISC + MISC_RSTD1); const float* bfv = P.in[17]; float* logf = (float*)(P.ws + WS_MISC + MISC_LOGF);
    LAS float* part = (LAS float*)lds;
    for (int rt = blockIdx.x; rt < T / 16; rt += 2 * gridDim.x) {
        const int rt1 = (rt + (int)gridDim.x < T / 16) ? rt + (int)gridDim.x : rt;
        f32x4 acc0 = {0.f, 0.f, 0.f, 0.f}, acc1 = {0.f, 0.f, 0.f, 0.f};
#pragma unroll
        for (int ks = 0; ks < 8; ++ks) { const int k = wv * 256 + ks * 32 + 8 * kq;
            const bf16x8 Bfr = *(const bf16x8*)(wfT + (size_t)l15 * DM + k);
            const bf16x8 A0 = *(const bf16x8*)(h1b + (size_t)(rt * 16 + l15) * DM + k), A1 = *(const bf16x8*)(h1b + (size_t)(rt1 * 16 + l15) * DM + k);
            acc0 = __builtin_amdgcn_mfma_f32_16x16x32_bf16(A0, Bfr, acc0, 0, 0, 0); acc1 = __builtin_amdgcn_mfma_f32_16x16x32_bf16(A1, Bfr, acc1, 0, 0, 0); }
#pragma unroll
        for (int i = 0; i < 4; ++i) { part[(wv * 16 + 4 * kq + i) * 16 + l15] = acc0[i]; part[2048 + (wv * 16 + 4 * kq + i) * 16 + l15] = acc1[i]; }
        __syncthreads();
        { const int tl = tid >> 8, row = (tid >> 4) & 15, c = tid & 15; float s = 0.f;
#pragma unroll
          for (int w = 0; w < 8; ++w) s += part[tl * 2048 + (w * 16 + row) * 16 + c];
          const int grow = (tl ? rt1 : rt) * 16 + row; const float f = s + bfv[c]; (void)rstd1;
          const float lf = fminf(f, 0.f) - log1pf(expf(-fabsf(f)));
          logf[((size_t)((grow >> 12) * NH + c)) * SEQ + (grow & 4095)] = lf; }
        __syncthreads();
    }
}

__device__ __forceinline__ void attn_bias_fill(const f32x4 a, const f32x4 c, char* ldsg, const int tid) {
    const int lane = tid & 63, wv = tid >> 6;
    float* bias = (float*)(ldsg + ATT_BIAS_OFF); float* wtot = (float*)(ldsg + ATT_WTOT_OFF);
    float v[8]; v[0] = a[0]; v[1] = v[0] + a[1]; v[2] = v[1] + a[2]; v[3] = v[2] + a[3]; v[4] = v[3] + c[0]; v[5] = v[4] + c[1]; v[6] = v[5] + c[2]; v[7] = v[6] + c[3];
    float sc = v[7];
#pragma unroll
    for (int off = 1; off < 64; off <<= 1) { const float t = __shfl_up(sc, off); if (lane >= off) sc += t; }
    if (lane == 63) wtot[wv] = sc;
    __syncthreads();
    float base = sc - v[7];
    for (int w = 0; w < wv; ++w) base += wtot[w];
    constexpr float INV = -1.f / attn::SCALE;
    f32x4 o0, o1;
    o0[0] = (base + v[0]) * INV; o0[1] = (base + v[1]) * INV; o0[2] = (base + v[2]) * INV; o0[3] = (base + v[3]) * INV;
    o1[0] = (base + v[4]) * INV; o1[1] = (base + v[5]) * INV; o1[2] = (base + v[6]) * INV; o1[3] = (base + v[7]) * INV;
    *(f32x4*)(bias + tid * 8) = o0; *(f32x4*)(bias + tid * 8 + 4) = o1;
    __syncthreads();
}
__device__ __forceinline__ void attn_phase(const Params& P, char* ldsg, const int wv_s) {
    typedef attn::bf16 abf; typedef attn::BlockRef<abf, abf> Ref;
    const abf* Q = (const abf*)(P.ws + WS_S3); const abf* K = (const abf*)(P.ws + WS_S1); const abf* V = (const abf*)(P.ws + WS_S2);
    const bf16_t* Z = (const bf16_t*)(P.ws + WS_S4); abf* AO = (abf*)(P.ws + WS_WIN);
    const float* logf = (const float*)(P.ws + WS_MISC + MISC_LOGF);
    constexpr int NQB = SEQ / 256, NX = NQB / 2, TOTAL = NX * NB * NH;
    const int G = gridDim.x;
    const int L = blockIdx.x;
    if (L >= TOTAL) return;
#define MKREF(r, L_, pass_) do { const int bh_ = (L_) / NX, x_ = (L_) % NX, qb_ = (pass_) ? NQB - 1 - x_ : x_, b_ = bh_ / NH, h_ = bh_ % NH; \
        (r).Q = Q + ((size_t)bh_ * SEQ + (size_t)qb_ * 256) * HD; (r).K = K + (size_t)bh_ * SEQ * HD; (r).V = V + (size_t)bh_ * SEQ * HD; \
        (r).O = AO + ((size_t)b_ * SEQ + (size_t)qb_ * 256) * DM + h_ * HD; (r).Z = Z + ((size_t)bh_ * SEQ + (size_t)qb_ * 256) * HD; (r).P0 = qb_ * 256; } while (0)
    {
        const int tid0 = mk_tid(wv_s); const float* lf = logf + (size_t)(L / NX) * SEQ;
        const f32x4 lfa = *(const f32x4*)(lf + tid0 * 8), lfc = *(const f32x4*)(lf + tid0 * 8 + 4);
        Ref lightb, heavyb; MKREF(lightb, L, 0); MKREF(heavyb, L, 1);
        attn::Seam<abf> S;
        attn::causal_swa_prime<abf, abf>(lightb, SEQ, ldsg, S, mk_tid(wv_s));
        attn_bias_fill(lfa, lfc, ldsg, mk_tid(wv_s));
        for (int pass = 0; pass < 2; ++pass) {
            Ref cur = heavyb; if (pass == 0) cur = lightb;
            attn::causal_swa_block<abf, abf>(cur, heavyb, SEQ, SEQ, ldsg, S, mk_tid(wv_s));
        }
    }
#undef MKREF
}

#define XB_TMO      128
#define XB_XCNT(j)  (256  + 64 * (j))
#define XB_XSUB(j)  (1280 + 64 * (j))
#define XB_XGEN(j)  (2304 + 64 * (j))
#define XB_TOP      3328
#define XB_TOPGEN   3392
#define XCD_BAR_WORDS 3456
#define XB_SPIN_CAP (1u << 18)

__device__ __forceinline__ unsigned xb_ld(unsigned* p)              { return __hip_atomic_load(p, __ATOMIC_RELAXED, __HIP_MEMORY_SCOPE_AGENT); }
__device__ __forceinline__ unsigned xb_add(unsigned* p, unsigned v) { return __hip_atomic_fetch_add(p, v, __ATOMIC_RELAXED, __HIP_MEMORY_SCOPE_AGENT); }
__device__ __forceinline__ unsigned xb_xcc_id() { return (unsigned)__builtin_amdgcn_s_getreg((3 << 11) | 20) & 0xFu; }
#define XB_SPIN(cond, bar) do { unsigned _sp = 0; while (cond) { __builtin_amdgcn_s_sleep(1); \
    if ((++_sp & 255u) == 0u) { if (xb_ld(&(bar)[XB_TMO])) break; if (_sp > XB_SPIN_CAP) { atomicAdd(&(bar)[XB_TMO], 1u); break; } } } } while (0)

struct XcdBarrier {
    unsigned* bar; unsigned x;
    volatile LAS unsigned* st;
};

__device__ __forceinline__ XcdBarrier xcd_barrier_post(unsigned* bar, volatile LAS unsigned* st, int tid) {
    XcdBarrier b; b.bar = bar; b.x = xb_xcc_id(); b.st = st;
    if (tid == 0) (void)xb_add(&bar[XB_XCNT(b.x)], 1u);
    return b;
}
__device__ __forceinline__ void xcd_barrier_complete(unsigned* bar, unsigned x, unsigned& nloc, unsigned& nx) {
    const unsigned G = gridDim.x * gridDim.y * gridDim.z;
    unsigned sum, cnt, mine, sp = 0u;
    for (;;) {
        sum = 0u; cnt = 0u; mine = 0u;
#pragma unroll
        for (unsigned j = 0; j < 16; ++j) { const unsigned c = xb_ld(&bar[XB_XCNT(j)]); sum += c; cnt += (c > 0u) ? 1u : 0u; mine = (j == x) ? c : mine; }
        if (sum == G) break;
        __builtin_amdgcn_s_sleep(1);
        if ((++sp & 255u) == 0u) { if (xb_ld(&bar[XB_TMO])) break; if (sp > XB_SPIN_CAP) { atomicAdd(&bar[XB_TMO], 1u); break; } }
    }
    nloc = mine > 0u ? mine : 1u; nx = cnt > 0u ? cnt : 1u;
}

__device__ __forceinline__ void xcd_barrier(const XcdBarrier& b, int tid) {
    asm volatile("s_waitcnt vmcnt(0)" ::: "memory");
    __syncthreads();
    if (tid == 0) {
        unsigned* bar = b.bar;
        __builtin_amdgcn_s_waitcnt(0);
        unsigned nloc = b.st[0], nx = b.st[1];
        if (nloc == 0u) { xcd_barrier_complete(bar, b.x, nloc, nx); b.st[0] = nloc; b.st[1] = nx; }
        const unsigned old = xb_add(&bar[XB_XSUB(b.x)], 1u);
        const unsigned gen = old / nloc;
        if (old + 1u == (gen + 1u) * nloc) {
            __builtin_amdgcn_fence(__ATOMIC_RELEASE, "agent");
            asm volatile("s_waitcnt vmcnt(0)" ::: "memory");
            const unsigned og = xb_add(&bar[XB_TOP], 1u);
            const unsigned tg = og / nx;
            if (og + 1u == (tg + 1u) * nx) xb_add(&bar[XB_TOPGEN], 1u);
            else XB_SPIN(xb_ld(&bar[XB_TOPGEN]) == tg, bar);
            __builtin_amdgcn_fence(__ATOMIC_ACQUIRE, "agent");
            asm volatile("s_waitcnt vmcnt(0)" ::: "memory");
        } else {
            XB_SPIN(xb_ld(&bar[XB_TOPGEN]) == gen, bar);
            __builtin_amdgcn_fence(__ATOMIC_ACQUIRE, "agent");
            asm volatile("s_waitcnt vmcnt(0)" ::: "memory");
        }
    }
    __syncthreads();
}

__global__ void __launch_bounds__(512, 2) yoco_fwd(Params P) {
    extern __shared__ __attribute__((aligned(16))) unsigned char lds_raw[];
    LAS unsigned char* lds = (LAS unsigned char*)lds_raw;
    cg::grid_group grid = cg::this_grid();
    const int lo = P.ph_lo, hi = P.ph_hi;
    typedef const __attribute__((address_space(4))) Params* KPtr;
    const KPtr kp0 = (KPtr)__builtin_amdgcn_kernarg_segment_ptr();
    const int wv_s = __builtin_amdgcn_readfirstlane((int)threadIdx.x >> 6);
    volatile LAS unsigned* bst = (volatile LAS unsigned*)(lds + LDS_TOTAL - 64);
    if (threadIdx.x < 2) bst[threadIdx.x] = 0u;
    __syncthreads();
    XcdBarrier bar;
    { KPtr kq_ = kp0; asm volatile("" : "+s"(kq_)); bar = xcd_barrier_post((unsigned*)(kq_->ws + WS_MISC + MISC_CTL), bst, threadIdx.x); }
    if (P.ph_hi == 0x7fffffff) grid.sync();
#define LOADP() KPtr kp_ = kp0; asm volatile("" : "+s"(kp_)); Params Q; _Pragma("unroll") for (int i_ = 0; i_ < 20; ++i_) Q.in[i_] = kp_->in[i_]; Q.out = kp_->out; Q.ws = kp_->ws; Q.ph_lo = 0; Q.ph_hi = 0; unsigned char* ws = Q.ws
#ifndef PHMASK
#define PHMASK 0x3ff
#endif
#define IN(k) (((PHMASK >> (k)) & 1) && lo <= (k) && (k) < hi)
#ifndef DUPMASK
#define DUPMASK 0
#endif
#define DUP(k) for (int rep_ = 0; rep_ < 1 + ((DUPMASK >> (k)) & 1); ++rep_)
#define SEAM(k) do { if (IN(k) && IN((k) + 1)) xcd_barrier(bar, mk_tid(wv_s)); } while (0)
    if (IN(0)) { LOADP(); (void)ws; p0_phase(Q, lds, mk_tid(wv_s)); __syncthreads(); if (DUPMASK & 1) { p0_phase(Q, lds, mk_tid(wv_s)); __syncthreads(); } } SEAM(0);
    if (IN(1)) DUP(1) { LOADP(); pg8::Gemm g{(const bf16_t*)(ws + WS_S3), (const bf16_t*)(ws + WS_WIN), T, 2 * DM, DM}; pg8::StaticOrder S; S.init(T, 2 * DM, gridDim.x, blockIdx.x);
        pg8::EpiRow8<F1> E{F1{(const float*)(ws + WS_MISC + MISC_RSTD0), (bf16_t*)(ws + WS_S1), (bf16_t*)(ws + WS_S2)}};
        pg8::gemm_phase<pg8::EpiRow8<F1>, pg8::StaticOrder, true, true>(lds, g, S, E, mk_tid(wv_s)); } SEAM(1);
    if (IN(2)) DUP(2) { LOADP(); (void)ws; ssm_phase(Q, lds, mk_tid(wv_s)); __syncthreads(); } SEAM(2);
    if (IN(3)) DUP(3) { LOADP(); pg8::Gemm g{(const bf16_t*)(ws + WS_S0), (const bf16_t*)(ws + WS_WGLU), T, DM, DM}; pg8::StaticOrder S; S.init(T, DM, gridDim.x, blockIdx.x);
        pg8::EpiRow8<F2> E{F2{Q.in[13], (const bf16_t*)(ws + WS_S0), (const bf16_t*)(ws + WS_S2), (bf16_t*)(ws + WS_S1)}};
        pg8::gemm_phase<pg8::EpiRow8<F2>, pg8::StaticOrder, true, true>(lds, g, S, E, mk_tid(wv_s)); } SEAM(3);
    if (IN(4)) DUP(4) { LOADP(); pg8::Gemm g{(const bf16_t*)(ws + WS_S1), (const bf16_t*)(ws + WS_WOUT), T, DM, DM}; pg8::StaticOrder S; S.init(T, DM, gridDim.x, blockIdx.x);
        unsigned* cnts = (unsigned*)(ws + WS_MISC + MISC_CTL + 16384); float* slots = (float*)(ws + WS_MISC + MISC_SLOTS);
        pg8::EpiNormRes<true> E{(const float*)(ws + WS_MISC + MISC_RSTD0), (const bf16_t*)(ws + WS_S3), nullptr, Q.in[2], (bf16_t*)(ws + WS_S0), pg8::RowStat{slots, cnts, nullptr}, pg8::RowStat{slots + 65536, cnts + 2048, (float*)(ws + WS_MISC + MISC_RSTD1)}};
        pg8::gemm_phase<pg8::EpiNormRes<true>, pg8::StaticOrder, false, true>(lds, g, S, E, mk_tid(wv_s)); }
    if (IN(4) && IN(6)) xcd_barrier(bar, mk_tid(wv_s));
    if (IN(6)) DUP(6) { LOADP(); logf_phase(Q, lds, mk_tid(wv_s));
        pg8::Gemm g{(const bf16_t*)(ws + WS_S0), (const bf16_t*)(ws + WS_WCAT), T, 4 * DM, DM}; pg8::StaticOrder S; S.init(T, 4 * DM, gridDim.x, blockIdx.x);
        pg8::EpiRow8<F4> E{F4{(const float*)(ws + WS_MISC + MISC_RSTD1), (bf16_t*)(ws + WS_S1), (bf16_t*)(ws + WS_S2), (bf16_t*)(ws + WS_S3), (bf16_t*)(ws + WS_S4)}};
        pg8::gemm_phase<pg8::EpiRow8<F4>, pg8::StaticOrder, true, true>(lds, g, S, E, mk_tid(wv_s)); } SEAM(6);
    if (IN(7)) { LOADP(); (void)ws; attn_phase(Q, (char*)lds_raw, wv_s); }

    if (IN(7) && IN(8)) xcd_barrier(bar, mk_tid(wv_s));
    if (IN(8)) DUP(8) { LOADP(); pg8::Gemm g{(const bf16_t*)(ws + WS_WIN), (const bf16_t*)(ws + WS_WFO), T, DM, DM}; pg8::StaticOrder S; S.init(T, DM, gridDim.x, blockIdx.x);
        unsigned* cnts = (unsigned*)(ws + WS_MISC + MISC_CTL + 16384); float* slots = (float*)(ws + WS_MISC + MISC_SLOTS);
        pg8::EpiNormRes<false> E{(const float*)(ws + WS_MISC + MISC_RSTD1), (const bf16_t*)(ws + WS_S0), Q.out, Q.in[2] + DM, nullptr, pg8::RowStat{slots + 131072, cnts + 4096, nullptr}, pg8::RowStat{nullptr, nullptr, nullptr}};
        pg8::gemm_phase<pg8::EpiNormRes<false>, pg8::StaticOrder, false, true>(lds, g, S, E, mk_tid(wv_s)); }
#undef IN
#undef SEAM
#undef LOADP
}

#ifndef N_LAUNCHES
#define N_LAUNCHES 1
#endif
extern "C" void kernel_launch(void* const* d_in, const int* in_sizes, int n_in, void* d_out, int out_size, void* d_ws, size_t ws_size, hipStream_t stream) {
    static int grid = 0;
    if (grid == 0) {
        if (n_in != 20 || out_size != T * DM || ws_size < 256 * MiB) { fprintf(stderr, "kernel_launch: unexpected shapes (n_in %d out %d ws %zu)\n", n_in, out_size, ws_size); grid = -1; return; }
        int dev = 0, cus = 0, per_cu = 0;
        (void)hipGetDevice(&dev); (void)hipDeviceGetAttribute(&cus, hipDeviceAttributeMultiprocessorCount, dev);
        if (hipFuncSetAttribute((const void*)yoco_fwd, hipFuncAttributeMaxDynamicSharedMemorySize, LDS_TOTAL) != hipSuccess) { fprintf(stderr, "kernel_launch: hipFuncSetAttribute failed\n"); grid = -1; return; }
        if (hipOccupancyMaxActiveBlocksPerMultiprocessor(&per_cu, (const void*)yoco_fwd, 512, LDS_TOTAL) != hipSuccess || per_cu < 1) { fprintf(stderr, "kernel_launch: occupancy query says %d\n", per_cu); per_cu = 1; }
        (void)hipGetLastError();
        if (cus <= 0) cus = 256;
        grid = cus * (per_cu > 1 ? 1 : per_cu);
        if (grid != 256) { fprintf(stderr, "kernel_launch: this kernel needs exactly 256 workgroups (one per CU of a 256-CU device), got %d; nothing launched\n", grid); grid = -1; return; }
    }
    if (grid < 0) return;
    if (hipMemsetAsync((char*)d_ws + WS_MISC + MISC_CTL, 0, 65536, stream) != hipSuccess) { fprintf(stderr, "kernel_launch: memset failed\n"); return; }
    Params p{};
    for (int i = 0; i < 20; ++i) p.in[i] = (const float*)d_in[i];
    p.out = (float*)d_out; p.ws = (unsigned char*)d_ws;
#if N_LAUNCHES == 1
    p.ph_lo = 0; p.ph_hi = 10;
    void* args[] = {&p};
    hipError_t e = hipLaunchCooperativeKernel((const void*)yoco_fwd, dim3(grid), dim3(512), args, LDS_TOTAL, stream);
    if (e != hipSuccess) fprintf(stderr, "cooperative launch failed: %s (grid %d)\n", hipGetErrorString(e), grid);
#else
    for (int k = 0; k < 10; ++k) { p.ph_lo = k; p.ph_hi = k + 1; hipLaunchKernelGGL(yoco_fwd, dim3(grid), dim3(512), LDS_TOTAL, stream, p); }
#endif
}
```

```cpp
#include <hip/hip_runtime.h>
#include <hip/hip_bf16.h>
#include <hip/hip_cooperative_groups.h>
#include <cstdio>
#include <cstdint>
namespace cg = cooperative_groups;
namespace pg8 {
#define PG8_LAS __attribute__((address_space(3)))
typedef unsigned short bf16_t;
typedef short bf16x8 __attribute__((ext_vector_type(8)));
typedef float f32x4 __attribute__((ext_vector_type(4)));
typedef unsigned u32x4 __attribute__((ext_vector_type(4)));
constexpr int BM = 256, BK = 64, HALF = 128, HTB = HALF * BK * 2  , STAGE_BYTES = 8 * HTB, NXCD = 8, WGM = 8;

__host__ __device__ __forceinline__ int lds_byte(int r, int c) { const int st = (r >> 4) * 2 + (c >> 5), rr = r & 15, cc = c & 31, ob = rr * 64 + cc * 2; return st * 1024 + (ob ^ (((ob >> 9) & 1) << 5)); }
__host__ __device__ __forceinline__ void stage_rc(int b, int& R, int& C) { const int st = b / 1024, sb = b % 1024, swz = sb ^ (((sb >> 9) & 1) << 5); R = (st >> 1) * 16 + swz / 64; C = (st & 1) * 32 + (swz % 64) / 2; }
__host__ __device__ __forceinline__ int perm32(int rho) { const int n = rho >> 4, i = rho & 15; return 8 * (i >> 2) + 4 * n + (i & 3); }

struct Unit { int pm, pn; };
struct Gemm { const bf16_t* A; const bf16_t* Bt; int M, N, K; };

struct StaticOrder {
    int nM, nN, nwg, G, c;
    __host__ __device__ void init(int M, int N, int G_, int c_) { nM = M / BM; nN = N / BM; nwg = nM * nN; G = G_; c = c_; }
    __host__ __device__ bool next(int i, Unit& u) const {
        const long L = (long)i * G + c; if (L >= nwg) return false;
        int wgid = (int)L; { const int q = nwg / NXCD, r = nwg % NXCD, xcd = wgid % NXCD, off = wgid / NXCD; wgid = (xcd < r ? xcd * (q + 1) : r * (q + 1) + (xcd - r) * q) + off; }
        const int nig = WGM * nN, gid = wgid / nig, fm = gid * WGM, gsz = (nM - fm) < WGM ? (nM - fm) : WGM;
        u.pm = fm + ((wgid % nig) % gsz); u.pn = (wgid % nig) / gsz; return true;
    }
    __device__ __forceinline__ void a_ready(const Unit&) const {}
    __device__ __forceinline__ void done(const Unit&) const {}
};

__device__ __forceinline__ unsigned cvt_pk_bf16(float lo, float hi) { unsigned r; asm volatile("v_cvt_pk_bf16_f32 %0, %1, %2" : "=v"(r) : "v"(lo), "v"(hi)); return r; }
typedef float f32x2 __attribute__((ext_vector_type(2)));
template <class F> struct EpiRow8 {
    static constexpr bool PERM = true, AFTER_DRAIN = false;
    F f;
    __device__ __forceinline__ void operator()(const f32x4 (&acc)[2][2][4][2], const Unit& u, int wr, int wc, int fr, int fq) const {
        const int row0 = u.pm * BM + wr * 64 + fr, col0 = u.pn * BM + wc * 32 + 8 * fq;
#pragma unroll
        for (int ai = 0; ai < 2; ++ai)
#pragma unroll
            for (int m = 0; m < 4; ++m)
#pragma unroll
                for (int bj = 0; bj < 2; ++bj) f(row0 + ai * HALF + m * 16, col0 + bj * HALF, acc[ai][bj][m][0], acc[ai][bj][m][1]);
    }
    __device__ __forceinline__ void fused(f32x4 (&)[2][2][4][2], const Unit&, int, int, int, int, PG8_LAS unsigned char*, int, int) const {}
};
struct RowStat {
    float* slots;
    unsigned* cnt;
    float* rstd_out;
    __device__ __forceinline__ void run(const f32x4 (&v)[2][2][4][2], const Unit& u, int wr, int wc, int fr, int fq, PG8_LAS unsigned char* lds, int wid, int lane) const {
        PG8_LAS float* Pp = (PG8_LAS float*)lds;
        PG8_LAS float* S = (PG8_LAS float*)(lds + 4096);
#pragma unroll
        for (int ai = 0; ai < 2; ++ai)
#pragma unroll
            for (int m = 0; m < 4; ++m) {
                float s = 0.f;
#pragma unroll
                for (int bj = 0; bj < 2; ++bj)
#pragma unroll
                    for (int n = 0; n < 2; ++n) { const f32x4 x = v[ai][bj][m][n]; s += (x[0] * x[0] + x[1] * x[1]) + (x[2] * x[2] + x[3] * x[3]); }
                s += __shfl_xor(s, 16); s += __shfl_xor(s, 32);
                if (fq == 0) Pp[(ai * HALF + wr * 64 + m * 16 + fr) * 4 + wc] = s;
            }
        asm volatile("s_waitcnt lgkmcnt(0)" ::: "memory"); __builtin_amdgcn_s_barrier(); asm volatile("" ::: "memory");
        const int row = wid * 32 + (lane & 31);
        if (lane < 32) {
            const float t = (Pp[row * 4 + 0] + Pp[row * 4 + 1]) + (Pp[row * 4 + 2] + Pp[row * 4 + 3]);
            __hip_atomic_store(slots + (size_t)(u.pm * BM + row) * 8 + u.pn, t, __ATOMIC_RELAXED, __HIP_MEMORY_SCOPE_AGENT);
        }
        asm volatile("s_waitcnt vmcnt(0)" ::: "memory");
        if (lane == 0) __hip_atomic_fetch_add(cnt + 64 * u.pm, 1u, __ATOMIC_RELAXED, __HIP_MEMORY_SCOPE_AGENT);
        if (wid == 0) {
            unsigned spins = 0;
            while ((unsigned)__builtin_amdgcn_readfirstlane(__hip_atomic_load(cnt + 64 * u.pm, __ATOMIC_RELAXED, __HIP_MEMORY_SCOPE_AGENT)) < 64u) { __builtin_amdgcn_s_sleep(2); if (++spins > (1u << 22)) break; }
            __builtin_amdgcn_fence(__ATOMIC_ACQUIRE, "agent");
        }
        asm volatile("s_waitcnt vmcnt(0) lgkmcnt(0)" ::: "memory"); __builtin_amdgcn_s_barrier(); asm volatile("" ::: "memory");
        if (lane < 32) {
            const float* sl = slots + (size_t)(u.pm * BM + row) * 8; float t = 0.f;
#pragma unroll
            for (int k = 0; k < 8; ++k) t += __hip_atomic_load(sl + k, __ATOMIC_RELAXED, __HIP_MEMORY_SCOPE_AGENT);
            const float rs = rsqrtf(t * (1.f / 2048.f) + 1e-6f);
            S[row] = rs;
            if (rstd_out && u.pn == 0) rstd_out[u.pm * BM + row] = rs;
        }
        asm volatile("s_waitcnt lgkmcnt(0)" ::: "memory"); __builtin_amdgcn_s_barrier(); asm volatile("" ::: "memory");
    }
};
template <bool SECOND> struct EpiNormRes {
    static constexpr bool PERM = true, AFTER_DRAIN = true;
    const float* base  ; const bf16_t* base16; float* out; const float* gain; bf16_t* outb; RowStat st1, st2;
    __device__ __forceinline__ void operator()(const f32x4 (&)[2][2][4][2], const Unit&, int, int, int, int) const {}
    __device__ __forceinline__ void fused(f32x4 (&acc)[2][2][4][2], const Unit& u, int wr, int wc, int fr, int fq, PG8_LAS unsigned char* lds, int wid, int lane) const {
        const PG8_LAS float* S = (const PG8_LAS float*)(lds + 4096);
        st1.run(acc, u, wr, wc, fr, fq, lds, wid, lane);
        const int col0 = u.pn * BM + wc * 32 + 8 * fq;
        f32x4 g[2][2];
#pragma unroll
        for (int bj = 0; bj < 2; ++bj) { g[bj][0] = *(const f32x4*)(gain + col0 + bj * HALF); g[bj][1] = *(const f32x4*)(gain + col0 + bj * HALF + 4); }
#pragma unroll
        for (int ai = 0; ai < 2; ++ai)
#pragma unroll
            for (int m = 0; m < 4; ++m) { const int r = ai * HALF + wr * 64 + m * 16 + fr; const float rs = S[r]; const size_t off = (size_t)(u.pm * BM + r) * 2048 + col0; const float bs = SECOND ? base[u.pm * BM + r] : __builtin_amdgcn_rcpf(base[u.pm * BM + r]);
#pragma unroll
                for (int bj = 0; bj < 2; ++bj) {
                    f32x4 b0, b1;
                    { const u32x4 w = *(const u32x4*)(base16 + off + bj * HALF);
                        b0 = (f32x4){__uint_as_float(w.x << 16), __uint_as_float(w.x & 0xffff0000u), __uint_as_float(w.y << 16), __uint_as_float(w.y & 0xffff0000u)};
                        b1 = (f32x4){__uint_as_float(w.z << 16), __uint_as_float(w.z & 0xffff0000u), __uint_as_float(w.w << 16), __uint_as_float(w.w & 0xffff0000u)}; }
                    const f32x4 h0 = b0 * bs + acc[ai][bj][m][0] * rs * g[bj][0], h1 = b1 * bs + acc[ai][bj][m][1] * rs * g[bj][1];
                    if (!SECOND) { *(f32x4*)(out + off + bj * HALF) = h0; *(f32x4*)(out + off + bj * HALF + 4) = h1; }
                    else { acc[ai][bj][m][0] = h0; acc[ai][bj][m][1] = h1; }
                }
                if (m & 1) asm volatile("" ::: "memory"); }
        if (SECOND) { st2.run(acc, u, wr, wc, fr, fq, lds, wid, lane);
#pragma unroll
            for (int ai = 0; ai < 2; ++ai)
#pragma unroll
                for (int m = 0; m < 4; ++m) { const int r = ai * HALF + wr * 64 + m * 16 + fr; const float r1 = S[r]; const size_t off = (size_t)(u.pm * BM + r) * 2048 + col0;
#pragma unroll
                    for (int bj = 0; bj < 2; ++bj) { const f32x4 h0 = acc[ai][bj][m][0] * r1, h1 = acc[ai][bj][m][1] * r1;
                        u32x4 w; w.x = cvt_pk_bf16(h0[0], h0[1]); w.y = cvt_pk_bf16(h0[2], h0[3]); w.z = cvt_pk_bf16(h1[0], h1[1]); w.w = cvt_pk_bf16(h1[2], h1[3]);
                        *(u32x4*)(outb + off + bj * HALF) = w; } } }
    }
};
template <class Epi, class Sched, bool ALIGN_EPI = false, bool SP2 = false>
__device__ __forceinline__ void gemm_phase(PG8_LAS unsigned char* lds, const Gemm g, const Sched& S, const Epi& E, const int tid_in) {
    const int tid = tid_in, wid = __builtin_amdgcn_readfirstlane(tid >> 6), lane = tid & 63, wr = wid >> 2, wc = wid & 3, fr = lane & 15, fq = lane >> 4;
    const int K = g.K, nt = K / BK;
    unsigned voffA[2], voffB[2];
#pragma unroll
    for (int i = 0; i < 2; ++i) { int R, C; stage_rc(tid * 16 + i * 8192, R, C); const int Rb = Epi::PERM ? ((R & ~31) + perm32(R & 31)) : R;
        voffA[i] = (unsigned)(R * K + C) * 2u; voffB[i] = (unsigned)(Rb * K + C) * 2u; }
    const size_t kstep = (size_t)(BK * 2);
    const size_t hstep = (size_t)HALF * K * 2;
    const size_t tstep = 2 * hstep;
    const unsigned ldsw = (unsigned)wid * 1024u;
    const int aoff = lds_byte(wr * 64 + fr, fq * 8), boff = lds_byte(wc * 32 + fr, fq * 8);
#define PG8_SA(b, h) (((b) * 2 + (h)) * HTB)
#define PG8_SB(b, h) ((4 + (b) * 2 + (h)) * HTB)
#define PG8_STAGE(bufoff, gbase, voff) do { _Pragma("unroll") for (int _i = 0; _i < 2; ++_i) \
        __builtin_amdgcn_global_load_lds((const unsigned*)((const char*)(gbase) + (voff)[_i]), (PG8_LAS unsigned*)(lds + (bufoff) + ldsw + _i * 8192), 16, 0, 0); } while (0)
#define PG8_LDA(dst, b, h) do { _Pragma("unroll") for (int m = 0; m < 4; ++m) _Pragma("unroll") for (int k = 0; k < 2; ++k) dst[m][k] = *(const PG8_LAS bf16x8*)(lds + PG8_SA(b, h) + aoff + m * 2048 + k * 1024); } while (0)
#define PG8_LDB(dst, b, h) do { _Pragma("unroll") for (int n = 0; n < 2; ++n) _Pragma("unroll") for (int k = 0; k < 2; ++k) dst[n][k] = *(const PG8_LAS bf16x8*)(lds + PG8_SB(b, h) + boff + n * 2048 + k * 1024); } while (0)
#define PG8_MMA(ai, bj, At, Bt) do { __builtin_amdgcn_s_setprio(1); _Pragma("unroll") for (int m = 0; m < 4; ++m) _Pragma("unroll") for (int n = 0; n < 2; ++n) _Pragma("unroll") for (int k = 0; k < 2; ++k) \
        acc[ai][bj][m][n] = __builtin_amdgcn_mfma_f32_16x16x32_bf16(Bt[n][k], At[m][k], acc[ai][bj][m][n], 0, 0, 0); __builtin_amdgcn_s_setprio(0); } while (0)
#define PG8_WAIT_V(n) asm volatile("s_waitcnt vmcnt(" #n ")" ::: "memory")
#define PG8_WAIT_L(n) asm volatile("s_waitcnt lgkmcnt(" #n ")" ::: "memory")
#define PG8_BAR __builtin_amdgcn_s_barrier()
#define PG8_SCHED __builtin_amdgcn_sched_barrier(0)
    Unit cur, nxt; int ui = 0;
    if (!S.next(0, cur)) return;
    f32x4 acc[2][2][4][2];
#pragma unroll
    for (int a = 0; a < 2; ++a)
#pragma unroll
        for (int b = 0; b < 2; ++b)
#pragma unroll
            for (int m = 0; m < 4; ++m)
#pragma unroll
                for (int n = 0; n < 2; ++n) acc[a][b][m][n] = (f32x4){0.f, 0.f, 0.f, 0.f};
    bf16x8 At[4][2], B0[2][2], B1[2][2];
    const char* cA = (const char*)g.A + (size_t)cur.pm * tstep; const char* cB = (const char*)g.Bt + (size_t)cur.pn * tstep;
    S.a_ready(cur);
    if constexpr (SP2) {
        PG8_STAGE(PG8_SB(0, 0), cB, voffB); PG8_STAGE(PG8_SB(0, 1), cB + hstep, voffB); PG8_STAGE(PG8_SA(0, 0), cA, voffA); PG8_STAGE(PG8_SA(0, 1), cA + hstep, voffA);
        if (wr == 1) PG8_BAR;
        PG8_WAIT_V(2); PG8_BAR;
        PG8_STAGE(PG8_SB(1, 0), cB + kstep, voffB); PG8_STAGE(PG8_SA(1, 0), cA + kstep, voffA); PG8_STAGE(PG8_SB(1, 1), cB + hstep + kstep, voffB);
        PG8_WAIT_V(6); PG8_BAR;
    } else {
        PG8_STAGE(PG8_SB(0, 0), cB, voffB); PG8_STAGE(PG8_SA(0, 0), cA, voffA); PG8_STAGE(PG8_SB(0, 1), cB + hstep, voffB); PG8_STAGE(PG8_SA(0, 1), cA + hstep, voffA);
        if (wr == 1) PG8_BAR;
        PG8_WAIT_V(4); PG8_BAR;
        PG8_STAGE(PG8_SB(1, 0), cB + kstep, voffB); PG8_STAGE(PG8_SA(1, 0), cA + kstep, voffA); PG8_STAGE(PG8_SB(1, 1), cB + hstep + kstep, voffB);
        PG8_WAIT_V(6); PG8_BAR;
    }
    for (;;) {
        const bool has_next = S.next(ui + 1, nxt);
        const char* nA = has_next ? (const char*)g.A + (size_t)nxt.pm * tstep : cA; const char* nB = has_next ? (const char*)g.Bt + (size_t)nxt.pn * tstep : cB;
        for (int t = 0; t < nt; t += 2) {
            const bool last = (t == nt - 2);
            const char* a1 = cA + (size_t)(t + 1) * kstep;
            const char* a2 = last ? nA : cA + (size_t)(t + 2) * kstep; const char* b2 = last ? nB : cB + (size_t)(t + 2) * kstep;
            const char* a3 = a2 + kstep; const char* b3 = b2 + kstep;
            if (last && has_next) S.a_ready(nxt);
            if constexpr (SP2) {
            PG8_LDB(B0, 0, 0); PG8_LDB(B1, 0, 1); PG8_SCHED; PG8_LDA(At, 0, 0); PG8_STAGE(PG8_SA(1, 1), a1 + hstep, voffA);
            PG8_WAIT_V(8); PG8_WAIT_L(0); PG8_BAR; PG8_MMA(0, 0, At, B0); PG8_MMA(0, 1, At, B1); PG8_BAR; PG8_SCHED;
            PG8_LDA(At, 0, 1); PG8_STAGE(PG8_SB(0, 0), b2, voffB); PG8_STAGE(PG8_SB(0, 1), b2 + hstep, voffB); PG8_STAGE(PG8_SA(0, 0), a2, voffA);
            PG8_WAIT_V(8); PG8_WAIT_L(0); PG8_BAR; PG8_MMA(1, 0, At, B0); PG8_MMA(1, 1, At, B1); PG8_BAR; PG8_SCHED;
            PG8_LDB(B0, 1, 0); PG8_LDB(B1, 1, 1); PG8_SCHED; PG8_LDA(At, 1, 0); PG8_STAGE(PG8_SA(0, 1), a2 + hstep, voffA);
            PG8_WAIT_V(8); PG8_WAIT_L(0); PG8_BAR; PG8_MMA(0, 0, At, B0); PG8_MMA(0, 1, At, B1); PG8_BAR; PG8_SCHED;
            PG8_LDA(At, 1, 1); PG8_STAGE(PG8_SB(1, 0), b3, voffB); PG8_STAGE(PG8_SB(1, 1), b3 + hstep, voffB); PG8_STAGE(PG8_SA(1, 0), a3, voffA);
            PG8_WAIT_V(8); PG8_WAIT_L(0); PG8_BAR; PG8_MMA(1, 0, At, B0); PG8_MMA(1, 1, At, B1); PG8_BAR; PG8_SCHED;
            } else {
            PG8_LDB(B0, 0, 0); PG8_SCHED; PG8_LDA(At, 0, 0); PG8_STAGE(PG8_SA(1, 1), a1 + hstep, voffA);
            PG8_WAIT_L(8); PG8_BAR; PG8_WAIT_L(0); PG8_MMA(0, 0, At, B0); PG8_BAR; PG8_SCHED;
            PG8_LDB(B1, 0, 1); PG8_STAGE(PG8_SB(0, 0), b2, voffB);
            PG8_BAR; PG8_WAIT_L(0); PG8_MMA(0, 1, At, B1); PG8_BAR;
            PG8_LDA(At, 0, 1); PG8_STAGE(PG8_SA(0, 0), a2, voffA);
            PG8_BAR; PG8_WAIT_L(0); PG8_MMA(1, 0, At, B0); PG8_BAR; PG8_SCHED;
            PG8_STAGE(PG8_SB(0, 1), b2 + hstep, voffB);
            PG8_WAIT_V(6); PG8_BAR; PG8_MMA(1, 1, At, B1); PG8_BAR;
            PG8_LDB(B0, 1, 0); PG8_SCHED; PG8_LDA(At, 1, 0); PG8_STAGE(PG8_SA(0, 1), a2 + hstep, voffA);
            PG8_WAIT_L(8); PG8_BAR; PG8_WAIT_L(0); PG8_MMA(0, 0, At, B0); PG8_BAR; PG8_SCHED;
            PG8_LDB(B1, 1, 1); PG8_STAGE(PG8_SB(1, 0), b3, voffB);
            PG8_BAR; PG8_WAIT_L(0); PG8_MMA(0, 1, At, B1); PG8_BAR;
            PG8_LDA(At, 1, 1); PG8_STAGE(PG8_SA(1, 0), a3, voffA);
            PG8_BAR; PG8_WAIT_L(0); PG8_MMA(1, 0, At, B0); PG8_BAR; PG8_SCHED;
            PG8_STAGE(PG8_SB(1, 1), b3 + hstep, voffB);
            PG8_WAIT_V(6); PG8_BAR; PG8_MMA(1, 1, At, B1); PG8_BAR;
            }
        }
        if constexpr (ALIGN_EPI) { if (wr == 0) PG8_BAR; }
        if constexpr (!Epi::AFTER_DRAIN) { E(acc, cur, wr, wc, fr, fq); S.done(cur); }
        if (!has_next) break;
#pragma unroll
        for (int a = 0; a < 2; ++a)
#pragma unroll
            for (int b = 0; b < 2; ++b)
#pragma unroll
                for (int m = 0; m < 4; ++m)
#pragma unroll
                    for (int n = 0; n < 2; ++n) acc[a][b][m][n] = (f32x4){0.f, 0.f, 0.f, 0.f};
        cur = nxt; cA = nA; cB = nB; ++ui;
        if constexpr (ALIGN_EPI) { if (wr == 1) PG8_BAR; }
    }
    PG8_WAIT_V(0);
    if constexpr (!ALIGN_EPI) { if (wr == 0) PG8_BAR; }
    PG8_BAR;
    if constexpr (Epi::AFTER_DRAIN) { E.fused(acc, cur, wr, wc, fr, fq, lds, wid, lane); S.done(cur); }
#undef PG8_SA
#undef PG8_SB
#undef PG8_STAGE
#undef PG8_LDA
#undef PG8_LDB
#undef PG8_MMA
#undef PG8_WAIT_V
#undef PG8_WAIT_L
#undef PG8_BAR
#undef PG8_SCHED
}
}
namespace attn {
constexpr int D = 128; constexpr float THR = 8.f; constexpr bool WSKIP = false; constexpr int OSTR = 2048, BIAS_OFF = 69632, OST_OFF = 90112;
constexpr float SCALE = 0.08838834764831845f;
constexpr int NW = 8, QBLK = 32, KVBLK = 64, QB = NW * QBLK;
constexpr int SHM_V = KVBLK * D * 2, SHM_K = KVBLK * D * 2;
constexpr int LDS_BYTES = 2 * SHM_V + 2 * SHM_K + NW * 64 * 4;
using bf16 = __hip_bfloat16;
typedef short bf16x8 __attribute__((ext_vector_type(8)));
typedef short s16x4 __attribute__((ext_vector_type(4)));
typedef float f32x16 __attribute__((ext_vector_type(16)));
typedef float f32x4 __attribute__((ext_vector_type(4)));
typedef unsigned u32x4 __attribute__((ext_vector_type(4)));
template <class A, class Bt> struct same_t { static constexpr bool v = false; };
template <class A> struct same_t<A, A> { static constexpr bool v = true; };

#define KSWZ(row, colB) ((row) * 256 + ((colB) ^ (((row) & 7) << 4)))
#define SBAR() __builtin_amdgcn_sched_barrier(0)
__device__ __forceinline__ int v_st(int k, int c) { const int kk = (k & ~0xC) | ((k & 4) << 1) | ((k & 8) >> 1); return ((kk >> 3) * 4 + (c >> 5)) * 512 + ((kk & 7) * 32 + (c & 31)) * 2; }
__device__ __forceinline__ int v_rd_base(int lane) { return ((lane & 3) << 3) | (((lane >> 2) & 3) << 6) | (((lane >> 4) & 1) << 5) | (((lane >> 5) & 1) << 8); }
constexpr int v_rd_off(int d0, int ks, int half) { return d0 * 512 + ks * 4096 + half * 2048; }
__device__ __forceinline__ int crow(int r, int hi) { return (r & 3) + 8 * (r >> 2) + 4 * hi; }
__device__ __forceinline__ unsigned cvtpk(float lo, float hi) {
    unsigned r; asm volatile("v_cvt_pk_bf16_f32 %0, %1, %2" : "=v"(r) : "v"(lo), "v"(hi)); return r;
}
__device__ __forceinline__ bf16x8 pack8(f32x4 a, f32x4 b) {
    u32x4 w = {cvtpk(a[0], a[1]), cvtpk(a[2], a[3]), cvtpk(b[0], b[1]), cvtpk(b[2], b[3])};
    return *reinterpret_cast<bf16x8*>(&w);
}
template <class T> __device__ __forceinline__ bf16x8 load8(const T* p) {
    if constexpr (same_t<T, float>::v) { return pack8(*(const f32x4*)p, *(const f32x4*)(p + 4)); }
    else { return *reinterpret_cast<const bf16x8*>(p); }
}
__device__ __forceinline__ void mask_tile(f32x16& p0, f32x16& p1, int dq, unsigned W) {
    const float NEG = -__builtin_inff();
#pragma unroll
    for (int r = 0; r < 16; ++r) {
        const int c = (r & 3) + 8 * (r >> 2);
        if ((unsigned)(dq - c) >= W) p0[r] = NEG;
        if ((unsigned)(dq - c - 32) >= W) p1[r] = NEG;
    }
}
__device__ __forceinline__ void partialSM(f32x16& p0, f32x16& p1, float& m_reg, float& mn, float& alpha) {
    float pmax = p0[0]; for (int r = 1; r < 16; ++r) pmax = fmaxf(pmax, p0[r]); for (int r = 0; r < 16; ++r) pmax = fmaxf(pmax, p1[r]);
    { auto rr = __builtin_amdgcn_permlane32_swap(__float_as_uint(pmax), __float_as_uint(pmax), false, false);
      pmax = fmaxf(__uint_as_float(rr[0]), __uint_as_float(rr[1])); }
    constexpr float C2 = 1.4426950408889634f * SCALE;
    if (__builtin_expect(__all((pmax - m_reg) * SCALE <= THR), 1)) { mn = m_reg; alpha = 1.f; }
    else { mn = fmaxf(m_reg, pmax); alpha = __builtin_amdgcn_exp2f((m_reg - mn) * C2); m_reg = mn; }
    const float mnL = -mn * C2;
    for (int r = 0; r < 16; ++r) p0[r] = fmaf(p0[r], C2, mnL); for (int r = 0; r < 16; ++r) p1[r] = fmaf(p1[r], C2, mnL);
    for (int r = 0; r < 16; ++r) p0[r] = __builtin_amdgcn_exp2f(p0[r]);
}
__device__ __forceinline__ void finishSM(f32x16& p0, f32x16& p1, float alpha, float& l_reg, bf16x8& pa0, bf16x8& pa1, bf16x8& pa2, bf16x8& pa3) {
    for (int r = 0; r < 16; ++r) p1[r] = __builtin_amdgcn_exp2f(p1[r]);
    float ps = 0; for (int r = 0; r < 16; ++r) ps += p0[r]; for (int r = 0; r < 16; ++r) ps += p1[r];
    { auto rr = __builtin_amdgcn_permlane32_swap(__float_as_uint(ps), __float_as_uint(ps), false, false);
      ps = __uint_as_float(rr[0]) + __uint_as_float(rr[1]); }
    l_reg = l_reg * alpha + ps;
#define PK4(P, B_, OUT) do { unsigned a0 = cvtpk(P[B_+0], P[B_+1]), a1 = cvtpk(P[B_+2], P[B_+3]);                          \
        unsigned b0 = cvtpk(P[B_+4], P[B_+5]), b1 = cvtpk(P[B_+6], P[B_+7]);                                             \
        auto r0 = __builtin_amdgcn_permlane32_swap(a0, b0, false, false); auto r1 = __builtin_amdgcn_permlane32_swap(a1, b1, false, false); \
        u32x4 w = {r0[0], r1[0], r0[1], r1[1]}; OUT = *reinterpret_cast<bf16x8*>(&w); } while (0)
    PK4(p0, 0, pa0); PK4(p0, 8, pa1); PK4(p1, 0, pa2); PK4(p1, 8, pa3);
#undef PK4
}
__device__ __forceinline__ const float* bl_addr(const char* lds, int hi, int kbase) { int h = hi; asm volatile("" : "+v"(h)); return (const float*)(lds + BIAS_OFF) + 4 * h + kbase; }
template <int KB, bool SK>
__device__ __forceinline__ void qkt(f32x16& p0, f32x16& p1, const char* K_lds, int r32, int hi, const bf16x8* qr, bool act, const float* bl) {
    if (SK && !act) { const float NEG = -__builtin_inff();
#pragma unroll
        for (int r = 0; r < 16; ++r) { p0[r] = NEG; p1[r] = NEG; } return; }
    { const f32x4 c0 = *(const f32x4*)(bl), c1 = *(const f32x4*)(bl + 8), c2 = *(const f32x4*)(bl + 16), c3 = *(const f32x4*)(bl + 24);
      const f32x4 e0 = *(const f32x4*)(bl + 32), e1 = *(const f32x4*)(bl + 40), e2 = *(const f32x4*)(bl + 48), e3 = *(const f32x4*)(bl + 56);
      p0 = (f32x16){c0[0], c0[1], c0[2], c0[3], c1[0], c1[1], c1[2], c1[3], c2[0], c2[1], c2[2], c2[3], c3[0], c3[1], c3[2], c3[3]};
      p1 = (f32x16){e0[0], e0[1], e0[2], e0[3], e1[0], e1[1], e1[2], e1[3], e2[0], e2[1], e2[2], e2[3], e3[0], e3[1], e3[2], e3[3]}; }
    const char* kb[4];
#pragma unroll
    for (int dd = 0; dd < 4; ++dd) kb[dd] = K_lds + KB * SHM_K + KSWZ(r32, (dd * 16 + hi * 8) * 2);
#pragma unroll
    for (int d0 = 0; d0 < 8; ++d0) { const char* a = kb[d0 & 3] + (d0 >> 2) * 128;
        bf16x8 b0 = *reinterpret_cast<const bf16x8*>(a);
        bf16x8 b1 = *reinterpret_cast<const bf16x8*>(a + 32 * 256);
        p0 = __builtin_amdgcn_mfma_f32_32x32x16_bf16(b0, qr[d0], p0, 0, 0, 0);
        p1 = __builtin_amdgcn_mfma_f32_32x32x16_bf16(b1, qr[d0], p1, 0, 0, 0); }
}
template <int VB, bool SK>
__device__ __forceinline__ void pv_tile(f32x16* o, int vb0, bf16x8 pa0, bf16x8 pa1, bf16x8 pa2, bf16x8 pa3, bool act) {
    if (SK && !act) return;
#define TRRD(dst, off) asm volatile("ds_read_b64_tr_b16 %0, %1 offset:%2" : "=&v"(dst) : "v"(vb0), "i"(off) : "memory")
#define PV_D0(d0) do { s16x4 l0, l1, l2, l3, h0, h1, h2, h3; constexpr int b_ = VB * SHM_V + v_rd_off(d0, 0, 0);     \
        TRRD(l0, b_); TRRD(h0, b_ + 2048); TRRD(l1, b_ + 4096); TRRD(h1, b_ + 6144); TRRD(l2, b_ + 8192); TRRD(h2, b_ + 10240); TRRD(l3, b_ + 12288); TRRD(h3, b_ + 14336); \
        asm volatile("s_waitcnt lgkmcnt(0)" ::: "memory"); SBAR();                 \
        o[d0] = __builtin_amdgcn_mfma_f32_32x32x16_bf16(pa0, (bf16x8){l0[0], l0[1], l0[2], l0[3], h0[0], h0[1], h0[2], h0[3]}, o[d0], 0, 0, 0);   \
        o[d0] = __builtin_amdgcn_mfma_f32_32x32x16_bf16(pa1, (bf16x8){l1[0], l1[1], l1[2], l1[3], h1[0], h1[1], h1[2], h1[3]}, o[d0], 0, 0, 0);   \
        o[d0] = __builtin_amdgcn_mfma_f32_32x32x16_bf16(pa2, (bf16x8){l2[0], l2[1], l2[2], l2[3], h2[0], h2[1], h2[2], h2[3]}, o[d0], 0, 0, 0);   \
        o[d0] = __builtin_amdgcn_mfma_f32_32x32x16_bf16(pa3, (bf16x8){l3[0], l3[1], l3[2], l3[3], h3[0], h3[1], h3[2], h3[3]}, o[d0], 0, 0, 0); } while (0)
    PV_D0(0); PV_D0(1); PV_D0(2); PV_D0(3);
#undef PV_D0
#undef TRRD
}

template <class TIn, class TOut> struct BlockRef { const TIn* Q; const TIn* K; const TIn* V; TOut* O; const unsigned short* Z; int P0; };
template <class TIn> struct Seam {
    bf16x8 qr[8];
    bf16x8 st_v0, st_v1, st_k0, st_k1; f32x4 sf0, sf1, sf2, sf3;
    f32x4 tq[16];
};
__device__ __forceinline__ int swa_jlo(int P0, int W) { const int lowk = P0 - W + 1; return lowk > 0 ? lowk / KVBLK : 0; }
__device__ __forceinline__ int hm16(int r, int d) { return (r & ~15) * 128 + ((((d >> 5) * 16 + (r & 15)) * 4 + ((d >> 3) & 3)) << 3); }
#define ROW(p, k0, rr) ((p) + (size_t)(k0) * D + hm16((rr), sc))
#define VMW() asm volatile("s_waitcnt vmcnt(0)" ::: "memory")
#define VMWN(n) asm volatile("s_waitcnt vmcnt(%0)" :: "i"(n) : "memory")
#define SLOAD_H(Kp, Vp, k0) do { S.st_v0 = load8<TIn>(ROW(Vp, k0, sr)); S.st_v1 = load8<TIn>(ROW(Vp, k0, 32 + sr));              \
                         S.st_k0 = load8<TIn>(ROW(Kp, k0, sr)); S.st_k1 = load8<TIn>(ROW(Kp, k0, 32 + sr)); } while (0)
#define SWRITE_HK(bf) do { *(bf16x8*)(K_lds + (bf) * SHM_K + kws) = S.st_k0; *(bf16x8*)(K_lds + (bf) * SHM_K + kws + 32 * 256) = S.st_k1; } while (0)
#define SWRITE_HV(bf) do { *(bf16x8*)(V_lds + (bf) * SHM_V + vst0) = S.st_v0; *(bf16x8*)(V_lds + (bf) * SHM_V + vst1) = S.st_v1; } while (0)
#define SWRITE_H(bf) do { SWRITE_HV(bf); SWRITE_HK(bf); } while (0)
#define SLOAD_F(p, k0) do { S.sf0 = *(const f32x4*)ROW(p, k0, sr); S.sf1 = *(const f32x4*)(ROW(p, k0, sr) + 4);                \
                            S.sf2 = *(const f32x4*)ROW(p, k0, 32 + sr); S.sf3 = *(const f32x4*)(ROW(p, k0, 32 + sr) + 4); } while (0)
#define SWRITE_KF(bf) do { *(bf16x8*)(K_lds + (bf) * SHM_K + kws) = pack8(S.sf0, S.sf1); *(bf16x8*)(K_lds + (bf) * SHM_K + kws + 32 * 256) = pack8(S.sf2, S.sf3); } while (0)
#define SWRITE_VF(bf) do { *(bf16x8*)(V_lds + (bf) * SHM_V + vst0) = pack8(S.sf0, S.sf1); *(bf16x8*)(V_lds + (bf) * SHM_V + vst1) = pack8(S.sf2, S.sf3); } while (0)
template <class TIn, class TOut>
__device__ __forceinline__ void causal_swa_prime(const BlockRef<TIn, TOut>& cur, int W, char* lds, Seam<TIn>& S, const int tid_in) {
    constexpr bool F32 = same_t<TIn, float>::v;
    const int tid = tid_in, wid = __builtin_amdgcn_readfirstlane(tid >> 6), lane = tid & 63, r32 = lane & 31, hi = lane >> 5;
    const int sr = tid >> 4, sc = (tid & 15) * 8, kws = KSWZ(sr, sc * 2); char* K_lds = lds + 2 * SHM_V;
    const int kb0 = swa_jlo(cur.P0, W) * KVBLK;
    for (int d0 = 0; d0 < 8; ++d0) S.qr[d0] = load8<TIn>(cur.Q + hm16(wid * QBLK + r32, d0 * 16 + hi * 8));
    if constexpr (F32) { SLOAD_F((const float*)cur.K, kb0); VMW(); SWRITE_KF(0); SBAR(); SLOAD_F((const float*)cur.V, kb0); }
    else { SLOAD_H(cur.K, cur.V, kb0); VMW(); SWRITE_HK(0); }
    __syncthreads();
}
template <class TIn, class TOut>
__device__ __forceinline__ void causal_swa_block(const BlockRef<TIn, TOut>& cur, const BlockRef<TIn, TOut>& nxt, int skv, int W, char* lds, Seam<TIn>& S, const int tid_in) {
    constexpr bool F32 = same_t<TIn, float>::v;
    const int tid = tid_in, wid = __builtin_amdgcn_readfirstlane(tid >> 6), lane = tid & 63, r32 = lane & 31, hi = lane >> 5;
    const int j_lo = swa_jlo(cur.P0, W);
    int j_hi = (cur.P0 + QB - 1) / KVBLK + 1; if (j_hi > skv / KVBLK) j_hi = skv / KVBLK;
    const int NT = j_hi - j_lo;
    const int kbn = swa_jlo(nxt.P0, W) * KVBLK;
    const int qlo = cur.P0 + wid * QBLK, qm = qlo + r32 - 4 * hi;
    char* V_lds = lds; char* K_lds = lds + 2 * SHM_V;
    float* ws = (float*)(lds + 2 * SHM_V + 2 * SHM_K) + wid * 64; float* li_l = ws, * al_l = ws + 32;
    float m_reg = ((const float*)(lds + BIAS_OFF))[cur.P0 + wid * QBLK + r32], l_reg = 0; f32x16 o[4] = {};
    const int sr = tid >> 4, sc = (tid & 15) * 8, vst0 = v_st(sr, sc), vst1 = v_st(32 + sr, sc), kws = KSWZ(sr, sc * 2);
    const int vb0 = (int)(uintptr_t)V_lds + v_rd_base(lane);
    const TIn* Kh = cur.K; const TIn* Vh = cur.V;
#define RESC(a) do { if (__any((a) < 1.f)) { if (hi == 0) al_l[r32] = (a); asm volatile("s_waitcnt lgkmcnt(0)" ::: "memory");              \
                     for (int d_ = 0; d_ < 4; ++d_) for (int r = 0; r < 16; ++r) o[d_][r] *= al_l[crow(r, hi)]; } } while (0)
#define KBASE(t) ((j_lo + (t)) * KVBLK)
#define BL(t) bl_addr(lds, hi, KBASE(t))
#define ACT(t) (KBASE(t) <= qlo + QBLK - 1 && KBASE(t) + KVBLK - 1 >= qlo - W + 1)
#define MASKT(P0_, P1_, t) do { const int kb_ = KBASE(t); if ((!SK || ACT(t)) && (kb_ + KVBLK - 1 > qlo || kb_ <= qlo + QBLK - 1 - W)) mask_tile(P0_, P1_, qm - kb_, (unsigned)W); } while (0)
    constexpr int NQL = F32 ? 16 : 8;
    constexpr bool SK = WSKIP && !F32;
#define SEAM_K0() do { VMWN(NQL); if constexpr (F32) { SWRITE_KF(0); SBAR(); SLOAD_F((const float*)nxt.V, kbn); } else { SWRITE_HK(0); } SBAR(); } while (0)
    f32x16 pA0, pA1, pB0, pB1; float mnA, mnB, alA, alB; bf16x8 pa0, pa1, pa2, pa3;
    if constexpr (F32) { VMW(); SWRITE_VF(0); SBAR(); } else { SWRITE_HV(0); SBAR(); }
    if (NT > 1) { if constexpr (F32) SLOAD_F((const float*)Kh, KBASE(1)); else SLOAD_H(Kh, Vh, KBASE(1)); }
    SBAR(); qkt<0, SK>(pA0, pA1, K_lds, r32, hi, S.qr, ACT(0), BL(0));
    if constexpr (F32) { if (NT > 1) { VMW(); SWRITE_KF(1); SBAR(); SLOAD_F((const float*)Vh, KBASE(1)); } }
    MASKT(pA0, pA1, 0); partialSM(pA0, pA1, m_reg, mnA, alA);
    if (NT > 1) { VMW(); if constexpr (F32) { SWRITE_VF(1); SBAR(); if (NT > 2) SLOAD_F((const float*)Kh, KBASE(2)); } else SWRITE_H(1); }
    __syncthreads();
#define HALF_STEP(PX0, PX1, mnX, alX, PY0, PY1, alY, t, KB, VB, SB) do {                                                      \
        SBAR(); qkt<KB, SK>(PX0, PX1, K_lds, r32, hi, S.qr, ACT(t), BL(t));                                             \
        finishSM(PY0, PY1, alY, l_reg, pa0, pa1, pa2, pa3); SBAR();                                                           \
        if ((t) + 1 < NT) { if constexpr (F32) { VMW(); SWRITE_KF(SB); SBAR(); SLOAD_F((const float*)Vh, KBASE((t) + 1)); }  \
                            else { SLOAD_H(Kh, Vh, KBASE((t) + 1)); } SBAR(); }                                               \
        pv_tile<VB, SK>(o, vb0, pa0, pa1, pa2, pa3, ACT((t) - 1)); MASKT(PX0, PX1, (t)); partialSM(PX0, PX1, m_reg, mnX, alX);                                        \
        __syncthreads();                                                                                                      \
        if ((t) + 1 < NT) { VMW(); if constexpr (F32) { SWRITE_VF(SB); SBAR(); if ((t) + 2 < NT) SLOAD_F((const float*)Kh, KBASE((t) + 2)); } \
                            else { SWRITE_H(SB); } }                                                                          \
        RESC(alX); __syncthreads(); } while (0)
    for (int t = 1; t + 1 < NT; t += 2) {
        HALF_STEP(pB0, pB1, mnB, alB, pA0, pA1, alA, t, 1, 0, 0);
        HALF_STEP(pA0, pA1, mnA, alA, pB0, pB1, alB, t + 1, 0, 1, 1);
    }
    const bool even = (NT & 1) == 0;
    if (even) { SBAR(); qkt<1, SK>(pB0, pB1, K_lds, r32, hi, S.qr, ACT(NT - 1), BL(NT - 1)); SBAR(); }
#define QROW(e) (nxt.Q + (size_t)(wid * QBLK + r32) * D + ((e) >> 1) * 16 + hi * 8 + ((e) & 1) * 4)
    if constexpr (F32) { SLOAD_F((const float*)nxt.K, kbn); SBAR();
#pragma unroll
        for (int e = 0; e < 8; ++e) S.tq[e] = *(const f32x4*)QROW(e); }
    else { SLOAD_H(nxt.K, nxt.V, kbn); SBAR();
#pragma unroll
        for (int d0 = 0; d0 < 8; ++d0) S.qr[d0] = load8<TIn>(nxt.Q + hm16(wid * QBLK + r32, d0 * 16 + hi * 8)); }
    SBAR();
    finishSM(pA0, pA1, alA, l_reg, pa0, pa1, pa2, pa3); SBAR();
    if constexpr (F32) {
#pragma unroll
        for (int e = 8; e < 16; ++e) S.tq[e] = *(const f32x4*)QROW(e); SBAR(); }
#undef QROW
    pv_tile<0, SK>(o, vb0, pa0, pa1, pa2, pa3, ACT(even ? NT - 2 : NT - 1));
    if (even) { MASKT(pB0, pB1, NT - 1); partialSM(pB0, pB1, m_reg, mnB, alB); __syncthreads(); RESC(alB);
        finishSM(pB0, pB1, alB, l_reg, pa0, pa1, pa2, pa3); SBAR(); pv_tile<1, SK>(o, vb0, pa0, pa1, pa2, pa3, ACT(NT - 1)); }
    SBAR(); SEAM_K0();
    if (hi == 0) li_l[r32] = l_reg; asm volatile("s_waitcnt lgkmcnt(0)" ::: "memory");
    float rli[16];
#pragma unroll
    for (int r = 0; r < 16; ++r) rli[r] = __builtin_amdgcn_rcpf(li_l[crow(r, hi)]);
    { unsigned short* stg = (unsigned short*)(lds + OST_OFF) + wid * 2048;
      size_t obase = (size_t)cur.O, zbase = (size_t)cur.Z; int ln = lane; asm volatile("" : "+s"(obase), "+s"(zbase), "+v"(ln));
#pragma unroll
      for (int half = 0; half < 2; ++half) {
#pragma unroll
        for (int r = 0; r < 16; ++r) { const int orow = crow(r, hi);
#pragma unroll
          for (int dl = 0; dl < 2; ++dl) { const float v = o[half * 2 + dl][r] * rli[r]; stg[orow * 64 + dl * 32 + r32] = (unsigned short)(cvtpk(v, v) & 0xffffu); } }
        asm volatile("s_waitcnt lgkmcnt(0)" ::: "memory");
#pragma unroll
        for (int i = 0; i < 4; ++i) { const int row = i * 8 + (ln >> 3), ch = ln & 7;
          const u32x4 v = *(const u32x4*)(stg + row * 64 + ch * 8);
          const size_t off = ((size_t)(wid * QBLK + row) * OSTR + half * 64 + ch * 8) * 2;
          const u32x4 z = *(const u32x4*)(zbase + (size_t)hm16(wid * QBLK + row, half * 64 + ch * 8) * 2); u32x4 w;
#define MUL2(a_, b_) cvtpk(__uint_as_float((a_) << 16) * __uint_as_float((b_) << 16), __uint_as_float((a_) & 0xffff0000u) * __uint_as_float((b_) & 0xffff0000u))
          w.x = MUL2(v.x, z.x); w.y = MUL2(v.y, z.y); w.z = MUL2(v.z, z.z); w.w = MUL2(v.w, z.w);
#undef MUL2
          *(u32x4*)(obase + off) = w; }
        asm volatile("s_waitcnt lgkmcnt(0)" ::: "memory");
      } }
    if constexpr (F32) {
#pragma unroll
        for (int d0 = 0; d0 < 8; ++d0) S.qr[d0] = pack8(S.tq[2 * d0], S.tq[2 * d0 + 1]); }
    __syncthreads();
#undef RESC
#undef KBASE
#undef BL
#undef ACT
#undef MASKT
#undef SEAM_K0
#undef HALF_STEP
}
#undef ROW
#undef VMW
#undef VMWN
#undef SLOAD_H
#undef SWRITE_HK
#undef SWRITE_HV
#undef SWRITE_H
#undef SLOAD_F
#undef SWRITE_KF
#undef SWRITE_VF

}
#define LAS __attribute__((address_space(3)))
typedef unsigned short bf16_t;
typedef short bf16x8 __attribute__((ext_vector_type(8)));
typedef float f32x4 __attribute__((ext_vector_type(4)));
typedef float f32x16 __attribute__((ext_vector_type(16)));
typedef unsigned u32x4 __attribute__((ext_vector_type(4)));
typedef unsigned u32x2 __attribute__((ext_vector_type(2)));

constexpr int DM = 2048, NB = 2, SEQ = 4096, T = NB * SEQ, NH = 16, HD = 128, NG = 128;
constexpr float EPS = 1e-6f;
constexpr size_t MiB = 1u << 20;
constexpr size_t WS_WIN = 0, WS_WGLU = 16 * MiB, WS_WOUT = 24 * MiB, WS_WCAT = 32 * MiB, WS_WFO = 64 * MiB;
constexpr size_t WS_S0 = 72 * MiB;
constexpr size_t WS_S1 = 104 * MiB;
constexpr size_t WS_S2 = 136 * MiB;
constexpr size_t WS_S3 = 168 * MiB;
constexpr size_t WS_S4 = 200 * MiB;
constexpr size_t WS_MISC = 232 * MiB;
constexpr size_t MISC_RSTD0 = 0, MISC_RSTD1 = 32768, MISC_LOGF = 65536, MISC_WFT = 65536 + 524288, MISC_CTL = 65536 + 524288 + 65536  , MISC_SLOTS = MISC_CTL + 65536  ;
constexpr int LDS_TOTAL = 147456;
constexpr int ATT_BIAS_OFF = 69632;
constexpr int ATT_WTOT_OFF = ATT_BIAS_OFF + 16384;

struct Params { const float* in[20]; float* out; unsigned char* ws; int ph_lo, ph_hi; };

__device__ __forceinline__ int mk_tid(int wv_s) { int t = wv_s * 64 + (int)__lane_id(); asm volatile("" : "+v"(t)); return t; }
__device__ __forceinline__ unsigned cvtpk(float lo, float hi) { unsigned r; asm volatile("v_cvt_pk_bf16_f32 %0, %1, %2" : "=v"(r) : "v"(lo), "v"(hi)); return r; }
__device__ __forceinline__ float bflo(unsigned w) { return __uint_as_float(w << 16); }
__device__ __forceinline__ float bfhi(unsigned w) { return __uint_as_float(w & 0xffff0000u); }
__device__ __forceinline__ float sigmoidf_(float v) { return __builtin_amdgcn_rcpf(1.f + __expf(-v)); }
__device__ __forceinline__ float wave_sum(float v) {
#pragma unroll
    for (int o = 1; o < 64; o <<= 1) v += __shfl_xor(v, o);
    return v;
}
__device__ __forceinline__ void store8(bf16_t* dst, f32x4 a, f32x4 b) {
    u32x4 w; w.x = cvtpk(a[0], a[1]); w.y = cvtpk(a[2], a[3]); w.z = cvtpk(b[0], b[1]); w.w = cvtpk(b[2], b[3]);
    *(u32x4*)dst = w;
}

__device__ __forceinline__ void transpose_item(const float* W, int ldw, bf16_t* WT, int row_off, const float* gk, LAS float* scr, int nblk, int item, int lane) {
    const int kb = item / nblk, nb = item % nblk, k0 = 64 * kb, n0 = 32 * nb;
    float wv_[32], gv_[32];
    const float* wp = W + (size_t)(k0 + (lane >> 5)) * ldw + n0 + (lane & 31);
#pragma unroll
    for (int i = 0; i < 32; ++i) wv_[i] = __builtin_nontemporal_load(wp + (size_t)(2 * i) * ldw);
    if (gk) {
#pragma unroll
        for (int i = 0; i < 32; ++i) gv_[i] = gk[k0 + 2 * i + (lane >> 5)];
#pragma unroll
        for (int i = 0; i < 32; ++i) wv_[i] *= gv_[i];
    }
#pragma unroll
    for (int i = 0; i < 32; ++i) scr[(2 * i + (lane >> 5)) * 33 + (lane & 31)] = wv_[i];
    asm volatile("s_waitcnt lgkmcnt(0)" ::: "memory");
    const int c = lane & 7;
#pragma unroll
    for (int j = 0; j < 4; ++j) { const int n = (lane >> 3) + 8 * j; const LAS float* s = scr + (8 * c) * 33 + n;
        u32x4 o; o.x = cvtpk(s[0 * 33], s[1 * 33]); o.y = cvtpk(s[2 * 33], s[3 * 33]); o.z = cvtpk(s[4 * 33], s[5 * 33]); o.w = cvtpk(s[6 * 33], s[7 * 33]);
        *(u32x4*)(WT + (size_t)(row_off + n0 + n) * DM + k0 + 8 * c) = o; }
    asm volatile("s_waitcnt lgkmcnt(0)" ::: "memory");
}
__device__ __forceinline__ void titem_load(const float* W, int ldw, int nblk, int item, int lane, float (&cv)[32]) {
    const int kb = item / nblk, nb = item % nblk, k0 = 64 * kb, n0 = 32 * nb;
    const float* wp = W + (size_t)(k0 + (lane >> 5)) * ldw + n0 + (lane & 31);
#pragma unroll
    for (int i = 0; i < 32; ++i) cv[i] = __builtin_nontemporal_load(wp + (size_t)(2 * i) * ldw);
}
__device__ __forceinline__ void titem_store(bf16_t* WT, int row_off, const float* gk, int nblk, int item, int lane, LAS float* scr, const float (&cv)[32]) {
    const int kb = item / nblk, nb = item % nblk, k0 = 64 * kb, n0 = 32 * nb;
#pragma unroll
    for (int i = 0; i < 32; ++i) scr[(2 * i + (lane >> 5)) * 33 + (lane & 31)] = cv[i];
    asm volatile("s_waitcnt lgkmcnt(0)" ::: "memory");
    const int c = lane & 7;
    f32x4 g0 = {1.f, 1.f, 1.f, 1.f}, g1 = {1.f, 1.f, 1.f, 1.f};
    if (gk) { g0 = *(const f32x4*)(gk + k0 + 8 * c); g1 = *(const f32x4*)(gk + k0 + 8 * c + 4); }
#pragma unroll
    for (int j = 0; j < 4; ++j) { const int n = (lane >> 3) + 8 * j; const LAS float* s = scr + (8 * c) * 33 + n;
        u32x4 o; o.x = cvtpk(s[0 * 33] * g0[0], s[1 * 33] * g0[1]); o.y = cvtpk(s[2 * 33] * g0[2], s[3 * 33] * g0[3]); o.z = cvtpk(s[4 * 33] * g1[0], s[5 * 33] * g1[1]); o.w = cvtpk(s[6 * 33] * g1[2], s[7 * 33] * g1[3]);
        *(u32x4*)(WT + (size_t)(row_off + n0 + n) * DM + k0 + 8 * c) = o; }
    asm volatile("s_waitcnt lgkmcnt(0)" ::: "memory");
}
#define P0_DECODE(S, it_) int r##S = (it_); const float* W##S; int ldw##S, roff##S, nblk##S; bf16_t* WT##S; const float* gk##S; \
    if (r##S < I_IN) { W##S = w3; ldw##S = 4096; WT##S = (bf16_t*)(ws + WS_WIN); roff##S = 0; gk##S = g1p; nblk##S = 128; } \
    else if (r##S < I_IN + I_SQ) { r##S -= I_IN; W##S = w12; ldw##S = 2048; WT##S = (bf16_t*)(ws + WS_WGLU); roff##S = 0; gk##S = nullptr; nblk##S = 64; } \
    else if (r##S < I_IN + 2 * I_SQ) { r##S -= I_IN + I_SQ; W##S = w14; ldw##S = 2048; WT##S = (bf16_t*)(ws + WS_WOUT); roff##S = 0; gk##S = nullptr; nblk##S = 64; } \
    else if (r##S < 2 * I_IN + 2 * I_SQ) { r##S -= I_IN + 2 * I_SQ; W##S = w16; ldw##S = 4112; WT##S = (bf16_t*)(ws + WS_WCAT); roff##S = 0; gk##S = g15; nblk##S = 128; } \
    else if (r##S < 3 * I_IN + 2 * I_SQ) { r##S -= 2 * I_IN + 2 * I_SQ; W##S = w18; ldw##S = 4096; WT##S = (bf16_t*)(ws + WS_WCAT); roff##S = 4096; gk##S = g1p + DM; nblk##S = 128; } \
    else { r##S -= 3 * I_IN + 2 * I_SQ; W##S = w19; ldw##S = 2048; WT##S = (bf16_t*)(ws + WS_WFO); roff##S = 0; gk##S = nullptr; nblk##S = 64; }
__device__ __forceinline__ void p0_phase(const Params& P, LAS unsigned char* lds, const int tid) {
    const int lane = tid & 63, wave = tid >> 6;
    LAS float* scrA = (LAS float*)(lds + wave * 16896); LAS float* scrB = scrA + 64 * 33;
    const int gw = blockIdx.x * 8 + wave, NGW = gridDim.x * 8;
    constexpr int I_IN = 32 * 128, I_SQ = 32 * 64, NIT = 3 * I_IN + 3 * I_SQ;
    unsigned char* ws = P.ws;
    const float* w3 = P.in[3]; const float* w12 = P.in[12]; const float* w14 = P.in[14]; const float* w16 = P.in[16]; const float* w18 = P.in[18]; const float* w19 = P.in[19];
    const float* g1p = P.in[1]; const float* g15 = P.in[15];
    asm("" : "+s"(w3)); asm("" : "+s"(w12)); asm("" : "+s"(w14)); asm("" : "+s"(w16)); asm("" : "+s"(w18)); asm("" : "+s"(w19)); asm("" : "+s"(g1p)); asm("" : "+s"(g15));
    for (int it = gw; it < NIT; it += 2 * NGW) {
        const bool hasB = it + NGW < NIT;
        P0_DECODE(A, it); P0_DECODE(B, hasB ? it + NGW : it);
        float ca[32], cb[32];
        titem_load(WA, ldwA, nblkA, rA, lane, ca);
        titem_load(WB, ldwB, nblkB, rB, lane, cb);
        titem_store(WTA, roffA, gkA, nblkA, rA, lane, scrA, ca);
        if (hasB) titem_store(WTB, roffB, gkB, nblkB, rB, lane, scrB, cb);
    }
    { bf16_t* wfT = (bf16_t*)(ws + WS_MISC + MISC_WFT); const float* kvw = P.in[16]; const float* gkv = P.in[15];
      for (int i = blockIdx.x * 512 + tid; i < 16 * DM; i += gridDim.x * 512) { const int c = i >> 11, k = i & 2047;
          const float v = gkv[k] * kvw[(size_t)k * 4112 + 4096 + c]; wfT[i] = (bf16_t)(cvtpk(v, v) & 0xffffu); } }
    { const float* x = P.in[0]; bf16_t* xb = (bf16_t*)(ws + WS_S3); float* rstd0 = (float*)(ws + WS_MISC + MISC_RSTD0);
      for (int m = gw; m < T; m += 2 * NGW) {
          const int m1 = (m + NGW < T) ? m + NGW : m;
          const f32x4* xr0 = (const f32x4*)(x + (size_t)m * DM) + lane; const f32x4* xr1 = (const f32x4*)(x + (size_t)m1 * DM) + lane; f32x4 v0[8], v1[8]; float s0 = 0.f, s1 = 0.f;
#pragma unroll
          for (int j = 0; j < 8; ++j) v0[j] = __builtin_nontemporal_load(xr0 + 64 * j);
#pragma unroll
          for (int j = 0; j < 8; ++j) v1[j] = __builtin_nontemporal_load(xr1 + 64 * j);
#pragma unroll
          for (int j = 0; j < 8; ++j) { s0 += (v0[j][0] * v0[j][0] + v0[j][1] * v0[j][1]) + (v0[j][2] * v0[j][2] + v0[j][3] * v0[j][3]); s1 += (v1[j][0] * v1[j][0] + v1[j][1] * v1[j][1]) + (v1[j][2] * v1[j][2] + v1[j][3] * v1[j][3]); }
          const float rs0 = rsqrtf(wave_sum(s0) * (1.f / DM) + EPS), rs1 = rsqrtf(wave_sum(s1) * (1.f / DM) + EPS);
          if (lane == 0) { rstd0[m] = 1.f / rs0; rstd0[m1] = 1.f / rs1; }
          u32x2* o0 = (u32x2*)(xb + (size_t)m * DM) + lane; u32x2* o1 = (u32x2*)(xb + (size_t)m1 * DM) + lane;
#pragma unroll
          for (int j = 0; j < 8; ++j) { v0[j] = v0[j] * rs0; v1[j] = v1[j] * rs1; u32x2 w; w.x = cvtpk(v0[j][0], v0[j][1]); w.y = cvtpk(v0[j][2], v0[j][3]); o0[64 * j] = w; u32x2 w1; w1.x = cvtpk(v1[j][0], v1[j][1]); w1.y = cvtpk(v1[j][2], v1[j][3]); o1[64 * j] = w1; }
      } }
}

__device__ __forceinline__ size_t sz_off(int row, int c) { return ((size_t)((row >> 4) * 64 + (c >> 5)) << 9) + ((((row & 15) * 4 + ((c >> 3) & 3))) << 3); }
struct F1 {
    const float* rstd; bf16_t* ug; bf16_t* sz;
    __device__ __forceinline__ void operator()(int row, int col, f32x4 a, f32x4 b) const {
        (void)rstd;
        if (col < DM) { const int bb = row >> 12, t = row & 4095, g = col >> 4;
            store8(ug + ((size_t)(bb * NG + g) * SEQ + t) * 16 + (col & 15), a, b); }
        else store8(sz + sz_off(row, col - DM), a, b);
    }
};
__device__ __forceinline__ float silu_(float z) { return z * sigmoidf_(z); }
struct F2 {
    const float* bias; const bf16_t* y1; const bf16_t* sz; bf16_t* y2;
    __device__ __forceinline__ void operator()(int row, int col, f32x4 a, f32x4 b) const {
        const f32x4 b0 = *(const f32x4*)(bias + col), b1 = *(const f32x4*)(bias + col + 4);
        const u32x4 yv = *(const u32x4*)(y1 + (size_t)row * DM + col), zv = *(const u32x4*)(sz + sz_off(row, col));
        a = a + b0; b = b + b1;
        f32x4 oa, ob;
        oa[0] = bflo(yv.x) * sigmoidf_(a[0]) * silu_(bflo(zv.x)); oa[1] = bfhi(yv.x) * sigmoidf_(a[1]) * silu_(bfhi(zv.x));
        oa[2] = bflo(yv.y) * sigmoidf_(a[2]) * silu_(bflo(zv.y)); oa[3] = bfhi(yv.y) * sigmoidf_(a[3]) * silu_(bfhi(zv.y));
        ob[0] = bflo(yv.z) * sigmoidf_(b[0]) * silu_(bflo(zv.z)); ob[1] = bfhi(yv.z) * sigmoidf_(b[1]) * silu_(bfhi(zv.z));
        ob[2] = bflo(yv.w) * sigmoidf_(b[2]) * silu_(bflo(zv.w)); ob[3] = bfhi(yv.w) * sigmoidf_(b[3]) * silu_(bfhi(zv.w));
        store8(y2 + (size_t)row * DM + col, oa, ob);
    }
};
struct F3 {
    bf16_t* o;
    __device__ __forceinline__ void operator()(int row, int col, f32x4 a, f32x4 b) const { store8(o + (size_t)row * DM + col, a, b); }
};
struct F4 {
    const float* rstd; bf16_t* kb; bf16_t* vb; bf16_t* qb; bf16_t* sz2;
    __device__ __forceinline__ void operator()(int row, int col, f32x4 a, f32x4 b) const {
        (void)rstd;
        const int sec = col >> 11, c = col & 2047;
        if (sec == 3) {
#pragma unroll
            for (int i = 0; i < 4; ++i) { a[i] = a[i] * sigmoidf_(a[i]); b[i] = b[i] * sigmoidf_(b[i]); } }
        const int bb = row >> 12, t = row & 4095, hh = c >> 7, d = c & 127;
        store8(kb + (size_t)sec * (16u << 20) + ((size_t)(bb * NH + hh) * SEQ) * HD + attn::hm16(t, d), a, b);
    }
};

#ifndef SSM_PF_U
#define SSM_PF_U 1
#endif
__device__ __forceinline__ void sincos_small(float x, float& s, float& c) {
    const float k = rintf(x * 0.63661977236758134f);
    float r = fmaf(-k, 1.57079625129699707031f, x); r = fmaf(-k, 7.54978941586159635335e-08f, r);
    const float r2 = r * r;
    const float sp = r + r * r2 * (-1.6666666666666666e-1f + r2 * (8.3333333333333332e-3f + r2 * (-1.9841269841269841e-4f + r2 * 2.7557319223985893e-6f)));
    const float cp = 1.f + r2 * (-0.5f + r2 * (4.1666666666666664e-2f + r2 * (-1.3888888888888889e-3f + r2 * (2.4801587301587302e-5f + r2 * -2.7557319223985888e-7f))));
    const int q = (int)k & 3;
    s = (q == 0) ? sp : (q == 1) ? cp : (q == 2) ? -sp : -cp;
    c = (q == 0) ? cp : (q == 1) ? -sp : (q == 2) ? -cp : sp;
}
__device__ __forceinline__ float gelu_tanh(float x) { const float u = 1.5957691216057308f * (x + 0.044715f * x * x * x); return x * sigmoidf_(u); }
__device__ __forceinline__ void ssm_phase(const Params& P, LAS unsigned char* lds, const int tid) {
    const int wv = __builtin_amdgcn_readfirstlane(tid >> 6);
    const float* a_re = P.in[4]; const float* a_im = P.in[5]; const float* log_dt = P.in[6]; const float* b_re = P.in[7]; const float* b_im = P.in[8];
    const float* c_re = P.in[9]; const float* c_im = P.in[10]; const float* dsk = P.in[11];
    const bf16_t* ug = (const bf16_t*)(P.ws + WS_S1); bf16_t* y1 = (bf16_t*)(P.ws + WS_S0);
    LAS float* Sst = (LAS float*)lds;
    LAS unsigned char* img = lds + 8192 + wv * 8704;
    for (int bg = blockIdx.x; bg < NB * NG; bg += gridDim.x) {
        int lane = tid & 63; asm volatile("" : "+v"(lane));
        const int n = lane & 31, hi = lane >> 5, l15 = lane & 15, kq = lane >> 4;
        const int b = bg >> 7, g = bg & 127;
        const float dt = expf(log_dt[g]);
        float abr[2], abi[2], qr_[2], qi_[2]; bf16x8 Bf[4];
#pragma unroll
        for (int ph = 0; ph < 2; ++ph) {
            const int p = ph * 32 + n; const float ar = a_re[g * 64 + p], ai = a_im[g * 64 + p];
            const float mag = expf(ar * dt); float cs, sn; sincos_small(ai * dt, sn, cs);
            abr[ph] = mag * cs; abi[ph] = mag * sn;
            const float den = ar * ar + ai * ai, nr = abr[ph] - 1.f;
            const float cr = (nr * ar + abi[ph] * ai) / den, ci = (abi[ph] * ar - nr * ai) / den;
            float pr = abr[ph], pi = abi[ph];
#pragma unroll
            for (int i = 0; i < 8; ++i) { const float t2 = pr * pr - pi * pi; pi = 2.f * pr * pi; pr = t2; }
            qr_[ph] = pr; qi_[ph] = pi;
            const float* brp = b_re + ((size_t)(g * 64 + p) * 16 + 8 * hi); const float* bip = b_im + ((size_t)(g * 64 + p) * 16 + 8 * hi);
            const f32x4 r0 = *(const f32x4*)brp, r1 = *(const f32x4*)(brp + 4), i0 = *(const f32x4*)bip, i1 = *(const f32x4*)(bip + 4);
            const f32x4 xr0 = r0 * cr - i0 * ci, xr1 = r1 * cr - i1 * ci, xi0 = i0 * cr + r0 * ci, xi1 = i1 * cr + r1 * ci;
            u32x4 wr_, wi_; wr_.x = cvtpk(xr0[0], xr0[1]); wr_.y = cvtpk(xr0[2], xr0[3]); wr_.z = cvtpk(xr1[0], xr1[1]); wr_.w = cvtpk(xr1[2], xr1[3]);
            wi_.x = cvtpk(xi0[0], xi0[1]); wi_.y = cvtpk(xi0[2], xi0[3]); wi_.z = cvtpk(xi1[0], xi1[1]); wi_.w = cvtpk(xi1[2], xi1[3]);
            Bf[ph * 2 + 0] = __builtin_bit_cast(bf16x8, wr_); Bf[ph * 2 + 1] = __builtin_bit_cast(bf16x8, wi_);
        }
        bf16x8 Cf[4], Df;
#pragma unroll
        for (int kk = 0; kk < 4; ++kk) {
            const f32x4 cr4 = *(const f32x4*)(c_re + (size_t)(g * 16 + l15) * 64 + kk * 16 + 4 * kq), ci4 = *(const f32x4*)(c_im + (size_t)(g * 16 + l15) * 64 + kk * 16 + 4 * kq);
            u32x4 w; w.x = cvtpk(cr4[0], -ci4[0]); w.y = cvtpk(cr4[1], -ci4[1]); w.z = cvtpk(cr4[2], -ci4[2]); w.w = cvtpk(cr4[3], -ci4[3]);
            Cf[kk] = __builtin_bit_cast(bf16x8, w);
        }
        { const float dv = dsk[g * 16 + l15]; float e[8];
#pragma unroll
          for (int j = 0; j < 8; ++j) e[j] = (kq < 2 && 8 * kq + j == l15) ? dv : 0.f;
          u32x4 w; w.x = cvtpk(e[0], e[1]); w.y = cvtpk(e[2], e[3]); w.z = cvtpk(e[4], e[5]); w.w = cvtpk(e[6], e[7]); Df = __builtin_bit_cast(bf16x8, w); }
        const bf16_t* ugb = ug + (size_t)bg * SEQ * 16;
        bf16_t* y1b = y1 + (size_t)b * SEQ * DM + g * 16;
        const int sm = (n >> 2) & 1, jm = (n & 3) + 4 * (n >> 3);
        float Hr[2] = {0.f, 0.f}, Hi[2] = {0.f, 0.f};
        for (int pass = 0; pass < 2; ++pass) {
            float hr[2] = {Hr[0], Hr[1]}, hi_[2] = {Hi[0], Hi[1]};
            const char* ugc = (const char*)ugb;
            const unsigned offA = (unsigned)(((wv * 2 + sm) * 256 + jm) * 16 + 8 * hi) * 2u;
            const unsigned offU = (unsigned)((wv * 2 * 256 + l15) * 16 + 8 * (kq & 1)) * 2u;
            bf16x8 Afn = *(const bf16x8*)(ugc + offA);
            for (int step = 0; step < 16; ++step) {
                const bf16x8 Af = Afn;
                if (step < 15) Afn = *(const bf16x8*)(ugc + (offA + (unsigned)(step + 1) * 512u));
#if SSM_PF_U
                bf16x8 Au0 = {0, 0, 0, 0, 0, 0, 0, 0}, Au1 = {0, 0, 0, 0, 0, 0, 0, 0};
                if (pass == 1 && kq < 2) { Au0 = *(const bf16x8*)(ugc + (offU + (unsigned)step * 512u)); Au1 = *(const bf16x8*)(ugc + (offU + 8192u + (unsigned)step * 512u)); }
#endif
                f32x16 x[4];
#pragma unroll
                for (int f = 0; f < 4; ++f) { f32x16 z16 = {}; x[f] = __builtin_amdgcn_mfma_f32_32x32x16_bf16(Af, Bf[f], z16, 0, 0, 0); }
                __builtin_amdgcn_sched_barrier(0);
#pragma unroll
                for (int r = 0; r < 16; ++r)
#pragma unroll
                    for (int ph = 0; ph < 2; ++ph) {
                        float t0 = fmaf(-abi[ph], hi_[ph], x[2 * ph][r]), t1 = fmaf(abi[ph], hr[ph], x[2 * ph + 1][r]);
                        asm("" : "+v"(t0)); asm("" : "+v"(t1));
                        float nr_ = fmaf(abr[ph], hr[ph], t0), ni_ = fmaf(abr[ph], hi_[ph], t1);
                        asm("" : "+v"(nr_)); asm("" : "+v"(ni_));
                        hr[ph] = nr_; hi_[ph] = ni_; x[2 * ph][r] = nr_; x[2 * ph + 1][r] = ni_;
                    }
                __builtin_amdgcn_sched_barrier(0);
                if (pass == 1) {
#pragma unroll
                    for (int ph = 0; ph < 2; ++ph)
#pragma unroll
                        for (int r = 0; r < 16; ++r) *(LAS unsigned*)(img + (hi * 16 + r) * 272 + (ph * 32 + n) * 4) = cvtpk(x[2 * ph][r], x[2 * ph + 1][r]);
                    asm volatile("s_waitcnt lgkmcnt(0)" ::: "memory");
#pragma unroll
                    for (int s2 = 0; s2 < 2; ++s2) {
                        __builtin_amdgcn_sched_barrier(0);
                        f32x4 acc = {0.f, 0.f, 0.f, 0.f};
#pragma unroll
                        for (int kk = 0; kk < 4; ++kk) { const bf16x8 Ah = *(const LAS bf16x8*)(img + (s2 * 16 + l15) * 272 + kk * 64 + kq * 16);
                            acc = __builtin_amdgcn_mfma_f32_16x16x32_bf16(Ah, Cf[kk], acc, 0, 0, 0); }
                        const int tokb = (wv * 2 + s2) * 256 + step * 16;
#if SSM_PF_U
                        acc = __builtin_amdgcn_mfma_f32_16x16x32_bf16(s2 ? Au1 : Au0, Df, acc, 0, 0, 0);
#else
                        { bf16x8 Au = {0, 0, 0, 0, 0, 0, 0, 0}; if (kq < 2) Au = *(const bf16x8*)(ugc + (offU + (unsigned)s2 * 8192u + (unsigned)step * 512u));
                          acc = __builtin_amdgcn_mfma_f32_16x16x32_bf16(Au, Df, acc, 0, 0, 0); }
#endif
#pragma unroll
                        for (int i = 0; i < 4; ++i) { const float yv = gelu_tanh(acc[i]); const int t = tokb + 4 * kq + i;
                            *(bf16_t*)((char*)y1b + ((unsigned)t * (unsigned)DM + (unsigned)l15) * 2u) = (bf16_t)(cvtpk(yv, yv) & 0xffffu); }
                    }
                    asm volatile("s_waitcnt lgkmcnt(0)" ::: "memory");
                }
            }
            if (pass == 0) {
                const int seg = wv * 2 + hi;
#pragma unroll
                for (int ph = 0; ph < 2; ++ph) { Sst[(seg * 64 + ph * 32 + n) * 2 + 0] = hr[ph]; Sst[(seg * 64 + ph * 32 + n) * 2 + 1] = hi_[ph]; }
                __syncthreads();
#pragma unroll
                for (int ph = 0; ph < 2; ++ph) { float cr_ = 0.f, ci_ = 0.f;
#pragma nounroll
                    for (int v = 0; v < 15; ++v) { if (v < seg) { const float sr = Sst[(v * 64 + ph * 32 + n) * 2 + 0], si = Sst[(v * 64 + ph * 32 + n) * 2 + 1];
                        const float t2 = qr_[ph] * cr_ - qi_[ph] * ci_ + sr; ci_ = qr_[ph] * ci_ + qi_[ph] * cr_ + si; cr_ = t2; } }
                    Hr[ph] = cr_; Hi[ph] = ci_; }
                __syncthreads();
            }
        }
    }
}

template <bool FIRST> __device__ __forceinline__ void row_phase(const Params& P, const int tid) {
    const int lane = tid & 63, wave = tid >> 6;
    const int gw = blockIdx.x * 8 + wave, NGW = gridDim.x * 8;
    const bf16_t* O = (const bf16_t*)(P.ws + WS_S3); const float* X = FIRST ? P.in[0] : P.out; float* OUT = P.out;
    const float* gp = P.in[2] + (FIRST ? 0 : DM);
    float* rstd1 = (float*)(P.ws + WS_MISC + MISC_RSTD1); bf16_t* h1b = (bf16_t*)(P.ws + WS_S0);
    for (int m = gw; m < T; m += NGW) {
        const u32x2* orow = (const u32x2*)(O + (size_t)m * DM) + lane; const f32x4* xrow = (const f32x4*)(X + (size_t)m * DM) + lane; f32x4* outr = (f32x4*)(OUT + (size_t)m * DM) + lane;
        f32x4 o[8]; float ss = 0.f;
#pragma unroll
        for (int j = 0; j < 8; ++j) { const u32x2 w = orow[64 * j]; o[j] = (f32x4){bflo(w.x), bfhi(w.x), bflo(w.y), bfhi(w.y)}; ss += (o[j][0] * o[j][0] + o[j][1] * o[j][1]) + (o[j][2] * o[j][2] + o[j][3] * o[j][3]); }
        const float rs = rsqrtf(wave_sum(ss) * (1.f / DM) + EPS);
        float ss1 = 0.f;
#pragma unroll
        for (int j = 0; j < 8; ++j) { const f32x4 g4 = ((const f32x4*)gp)[lane + 64 * j]; const f32x4 xv = xrow[64 * j]; o[j] = xv + o[j] * rs * g4; outr[64 * j] = o[j];
            ss1 += (o[j][0] * o[j][0] + o[j][1] * o[j][1]) + (o[j][2] * o[j][2] + o[j][3] * o[j][3]); }
        if (FIRST) {
            const float r1 = rsqrtf(wave_sum(ss1) * (1.f / DM) + EPS);
            if (lane == 0) rstd1[m] = r1;
            u32x2* o8 = (u32x2*)(h1b + (size_t)m * DM) + lane;
#pragma unroll
            for (int j = 0; j < 8; ++j) { u32x2 w; w.x = cvtpk(o[j][0], o[j][1]); w.y = cvtpk(o[j][2], o[j][3]); o8[64 * j] = w; }
        }
    }
}

__device__ __forceinline__ void logf_phase(const Params& P, LAS unsigned char* lds, const int tid) {
    const int lane = tid & 63, wv = __builtin_amdgcn_readfirstlane(tid >> 6), l15 = lane & 15, kq = lane >> 4;
    const bf16_t* h1b = (const bf16_t*)(P.ws + WS_S0); const bf16_t* wfT = (const bf16_t*)(P.ws + WS_MISC + MISC_WFT);
    const float* rstd1 = (const float*)(P.ws + WS_MISC + MISC_RSTD1); const float* bfv = P.in[17]; float* logf = (float*)(P.ws + WS_MISC + MISC_LOGF);
    LAS float* part = (LAS float*)lds;
    for (int rt = blockIdx.x; rt < T / 16; rt += 2 * gridDim.x) {
        const int rt1 = (rt + (int)gridDim.x < T / 16) ? rt + (int)gridDim.x : rt;
        f32x4 acc0 = {0.f, 0.f, 0.f, 0.f}, acc1 = {0.f, 0.f, 0.f, 0.f};
#pragma unroll
        for (int ks = 0; ks < 8; ++ks) { const int k = wv * 256 + ks * 32 + 8 * kq;
            const bf16x8 Bfr = *(const bf16x8*)(wfT + (size_t)l15 * DM + k);
            const bf16x8 A0 = *(const bf16x8*)(h1b + (size_t)(rt * 16 + l15) * DM + k), A1 = *(const bf16x8*)(h1b + (size_t)(rt1 * 16 + l15) * DM + k);
            acc0 = __builtin_amdgcn_mfma_f32_16x16x32_bf16(A0, Bfr, acc0, 0, 0, 0); acc1 = __builtin_amdgcn_mfma_f32_16x16x32_bf16(A1, Bfr, acc1, 0, 0, 0); }
#pragma unroll
        for (int i = 0; i < 4; ++i) { part[(wv * 16 + 4 * kq + i) * 16 + l15] = acc0[i]; part[2048 + (wv * 16 + 4 * kq + i) * 16 + l15] = acc1[i]; }
        __syncthreads();
        { const int tl = tid >> 8, row = (tid >> 4) & 15, c = tid & 15; float s = 0.f;
#pragma unroll
          for (int w = 0; w < 8; ++w) s += part[tl * 2048 + (w * 16 + row) * 16 + c];
          const int grow = (tl ? rt1 : rt) * 16 + row; const float f = s + bfv[c]; (void)rstd1;
          const float lf = fminf(f, 0.f) - log1pf(expf(-fabsf(f)));
          logf[((size_t)((grow >> 12) * NH + c)) * SEQ + (grow & 4095)] = lf; }
        __syncthreads();
    }
}

__device__ __forceinline__ void attn_bias_fill(const f32x4 a, const f32x4 c, char* ldsg, const int tid) {
    const int lane = tid & 63, wv = tid >> 6;
    float* bias = (float*)(ldsg + ATT_BIAS_OFF); float* wtot = (float*)(ldsg + ATT_WTOT_OFF);
    float v[8]; v[0] = a[0]; v[1] = v[0] + a[1]; v[2] = v[1] + a[2]; v[3] = v[2] + a[3]; v[4] = v[3] + c[0]; v[5] = v[4] + c[1]; v[6] = v[5] + c[2]; v[7] = v[6] + c[3];
    float sc = v[7];
#pragma unroll
    for (int off = 1; off < 64; off <<= 1) { const float t = __shfl_up(sc, off); if (lane >= off) sc += t; }
    if (lane == 63) wtot[wv] = sc;
    __syncthreads();
    float base = sc - v[7];
    for (int w = 0; w < wv; ++w) base += wtot[w];
    constexpr float INV = -1.f / attn::SCALE;
    f32x4 o0, o1;
    o0[0] = (base + v[0]) * INV; o0[1] = (base + v[1]) * INV; o0[2] = (base + v[2]) * INV; o0[3] = (base + v[3]) * INV;
    o1[0] = (base + v[4]) * INV; o1[1] = (base + v[5]) * INV; o1[2] = (base + v[6]) * INV; o1[3] = (base + v[7]) * INV;
    *(f32x4*)(bias + tid * 8) = o0; *(f32x4*)(bias + tid * 8 + 4) = o1;
    __syncthreads();
}
__device__ __forceinline__ void attn_phase(const Params& P, char* ldsg, const int wv_s) {
    typedef attn::bf16 abf; typedef attn::BlockRef<abf, abf> Ref;
    const abf* Q = (const abf*)(P.ws + WS_S3); const abf* K = (const abf*)(P.ws + WS_S1); const abf* V = (const abf*)(P.ws + WS_S2);
    const bf16_t* Z = (const bf16_t*)(P.ws + WS_S4); abf* AO = (abf*)(P.ws + WS_WIN);
    const float* logf = (const float*)(P.ws + WS_MISC + MISC_LOGF);
    constexpr int NQB = SEQ / 256, NX = NQB / 2, TOTAL = NX * NB * NH;
    const int G = gridDim.x;
    const int L = blockIdx.x;
    if (L >= TOTAL) return;
#define MKREF(r, L_, pass_) do { const int bh_ = (L_) / NX, x_ = (L_) % NX, qb_ = (pass_) ? NQB - 1 - x_ : x_, b_ = bh_ / NH, h_ = bh_ % NH; \
        (r).Q = Q + ((size_t)bh_ * SEQ + (size_t)qb_ * 256) * HD; (r).K = K + (size_t)bh_ * SEQ * HD; (r).V = V + (size_t)bh_ * SEQ * HD; \
        (r).O = AO + ((size_t)b_ * SEQ + (size_t)qb_ * 256) * DM + h_ * HD; (r).Z = Z + ((size_t)bh_ * SEQ + (size_t)qb_ * 256) * HD; (r).P0 = qb_ * 256; } while (0)
    {
        const int tid0 = mk_tid(wv_s); const float* lf = logf + (size_t)(L / NX) * SEQ;
        const f32x4 lfa = *(const f32x4*)(lf + tid0 * 8), lfc = *(const f32x4*)(lf + tid0 * 8 + 4);
        Ref lightb, heavyb; MKREF(lightb, L, 0); MKREF(heavyb, L, 1);
        attn::Seam<abf> S;
        attn::causal_swa_prime<abf, abf>(lightb, SEQ, ldsg, S, mk_tid(wv_s));
        attn_bias_fill(lfa, lfc, ldsg, mk_tid(wv_s));
        for (int pass = 0; pass < 2; ++pass) {
            Ref cur = heavyb; if (pass == 0) cur = lightb;
            attn::causal_swa_block<abf, abf>(cur, heavyb, SEQ, SEQ, ldsg, S, mk_tid(wv_s));
        }
    }
#undef MKREF
}

#define XB_TMO      128
#define XB_XCNT(j)  (256  + 64 * (j))
#define XB_XSUB(j)  (1280 + 64 * (j))
#define XB_XGEN(j)  (2304 + 64 * (j))
#define XB_TOP      3328
#define XB_TOPGEN   3392
#define XCD_BAR_WORDS 3456
#define XB_SPIN_CAP (1u << 18)

__device__ __forceinline__ unsigned xb_ld(unsigned* p)              { return __hip_atomic_load(p, __ATOMIC_RELAXED, __HIP_MEMORY_SCOPE_AGENT); }
__device__ __forceinline__ unsigned xb_add(unsigned* p, unsigned v) { return __hip_atomic_fetch_add(p, v, __ATOMIC_RELAXED, __HIP_MEMORY_SCOPE_AGENT); }
__device__ __forceinline__ unsigned xb_xcc_id() { return (unsigned)__builtin_amdgcn_s_getreg((3 << 11) | 20) & 0xFu; }
#define XB_SPIN(cond, bar) do { unsigned _sp = 0; while (cond) { __builtin_amdgcn_s_sleep(1); \
    if ((++_sp & 255u) == 0u) { if (xb_ld(&(bar)[XB_TMO])) break; if (_sp > XB_SPIN_CAP) { atomicAdd(&(bar)[XB_TMO], 1u); break; } } } } while (0)

struct XcdBarrier {
    unsigned* bar; unsigned x;
    volatile LAS unsigned* st;
};

__device__ __forceinline__ XcdBarrier xcd_barrier_post(unsigned* bar, volatile LAS unsigned* st, int tid) {
    XcdBarrier b; b.bar = bar; b.x = xb_xcc_id(); b.st = st;
    if (tid == 0) (void)xb_add(&bar[XB_XCNT(b.x)], 1u);
    return b;
}
__device__ __forceinline__ void xcd_barrier_complete(unsigned* bar, unsigned x, unsigned& nloc, unsigned& nx) {
    const unsigned G = gridDim.x * gridDim.y * gridDim.z;
    unsigned sum, cnt, mine, sp = 0u;
    for (;;) {
        sum = 0u; cnt = 0u; mine = 0u;
#pragma unroll
        for (unsigned j = 0; j < 16; ++j) { const unsigned c = xb_ld(&bar[XB_XCNT(j)]); sum += c; cnt += (c > 0u) ? 1u : 0u; mine = (j == x) ? c : mine; }
        if (sum == G) break;
        __builtin_amdgcn_s_sleep(1);
        if ((++sp & 255u) == 0u) { if (xb_ld(&bar[XB_TMO])) break; if (sp > XB_SPIN_CAP) { atomicAdd(&bar[XB_TMO], 1u); break; } }
    }
    nloc = mine > 0u ? mine : 1u; nx = cnt > 0u ? cnt : 1u;
}

__device__ __forceinline__ void xcd_barrier(const XcdBarrier& b, int tid) {
    asm volatile("s_waitcnt vmcnt(0)" ::: "memory");
    __syncthreads();
    if (tid == 0) {
        unsigned* bar = b.bar;
        __builtin_amdgcn_s_waitcnt(0);
        unsigned nloc = b.st[0], nx = b.st[1];
        if (nloc == 0u) { xcd_barrier_complete(bar, b.x, nloc, nx); b.st[0] = nloc; b.st[1] = nx; }
        const unsigned old = xb_add(&bar[XB_XSUB(b.x)], 1u);
        const unsigned gen = old / nloc;
        if (old + 1u == (gen + 1u) * nloc) {
            __builtin_amdgcn_fence(__ATOMIC_RELEASE, "agent");
            asm volatile("s_waitcnt vmcnt(0)" ::: "memory");
            const unsigned og = xb_add(&bar[XB_TOP], 1u);
            const unsigned tg = og / nx;
            if (og + 1u == (tg + 1u) * nx) xb_add(&bar[XB_TOPGEN], 1u);
            else XB_SPIN(xb_ld(&bar[XB_TOPGEN]) == tg, bar);
            __builtin_amdgcn_fence(__ATOMIC_ACQUIRE, "agent");
            asm volatile("s_waitcnt vmcnt(0)" ::: "memory");
        } else {
            XB_SPIN(xb_ld(&bar[XB_TOPGEN]) == gen, bar);
            __builtin_amdgcn_fence(__ATOMIC_ACQUIRE, "agent");
            asm volatile("s_waitcnt vmcnt(0)" ::: "memory");
        }
    }
    __syncthreads();
}

__global__ void __launch_bounds__(512, 2) yoco_fwd(Params P) {
    extern __shared__ __attribute__((aligned(16))) unsigned char lds_raw[];
    LAS unsigned char* lds = (LAS unsigned char*)lds_raw;
    cg::grid_group grid = cg::this_grid();
    const int lo = P.ph_lo, hi = P.ph_hi;
    typedef const __attribute__((address_space(4))) Params* KPtr;
    const KPtr kp0 = (KPtr)__builtin_amdgcn_kernarg_segment_ptr();
    const int wv_s = __builtin_amdgcn_readfirstlane((int)threadIdx.x >> 6);
    volatile LAS unsigned* bst = (volatile LAS unsigned*)(lds + LDS_TOTAL - 64);
    if (threadIdx.x < 2) bst[threadIdx.x] = 0u;
    __syncthreads();
    XcdBarrier bar;
    { KPtr kq_ = kp0; asm volatile("" : "+s"(kq_)); bar = xcd_barrier_post((unsigned*)(kq_->ws + WS_MISC + MISC_CTL), bst, threadIdx.x); }
    if (P.ph_hi == 0x7fffffff) grid.sync();
#define LOADP() KPtr kp_ = kp0; asm volatile("" : "+s"(kp_)); Params Q; _Pragma("unroll") for (int i_ = 0; i_ < 20; ++i_) Q.in[i_] = kp_->in[i_]; Q.out = kp_->out; Q.ws = kp_->ws; Q.ph_lo = 0; Q.ph_hi = 0; unsigned char* ws = Q.ws
#ifndef PHMASK
#define PHMASK 0x3ff
#endif
#define IN(k) (((PHMASK >> (k)) & 1) && lo <= (k) && (k) < hi)
#ifndef DUPMASK
#define DUPMASK 0
#endif
#define DUP(k) for (int rep_ = 0; rep_ < 1 + ((DUPMASK >> (k)) & 1); ++rep_)
#define SEAM(k) do { if (IN(k) && IN((k) + 1)) xcd_barrier(bar, mk_tid(wv_s)); } while (0)
    if (IN(0)) { LOADP(); (void)ws; p0_phase(Q, lds, mk_tid(wv_s)); __syncthreads(); if (DUPMASK & 1) { p0_phase(Q, lds, mk_tid(wv_s)); __syncthreads(); } } SEAM(0);
    if (IN(1)) DUP(1) { LOADP(); pg8::Gemm g{(const bf16_t*)(ws + WS_S3), (const bf16_t*)(ws + WS_WIN), T, 2 * DM, DM}; pg8::StaticOrder S; S.init(T, 2 * DM, gridDim.x, blockIdx.x);
        pg8::EpiRow8<F1> E{F1{(const float*)(ws + WS_MISC + MISC_RSTD0), (bf16_t*)(ws + WS_S1), (bf16_t*)(ws + WS_S2)}};
        pg8::gemm_phase<pg8::EpiRow8<F1>, pg8::StaticOrder, true, true>(lds, g, S, E, mk_tid(wv_s)); } SEAM(1);
    if (IN(2)) DUP(2) { LOADP(); (void)ws; ssm_phase(Q, lds, mk_tid(wv_s)); __syncthreads(); } SEAM(2);
    if (IN(3)) DUP(3) { LOADP(); pg8::Gemm g{(const bf16_t*)(ws + WS_S0), (const bf16_t*)(ws + WS_WGLU), T, DM, DM}; pg8::StaticOrder S; S.init(T, DM, gridDim.x, blockIdx.x);
        pg8::EpiRow8<F2> E{F2{Q.in[13], (const bf16_t*)(ws + WS_S0), (const bf16_t*)(ws + WS_S2), (bf16_t*)(ws + WS_S1)}};
        pg8::gemm_phase<pg8::EpiRow8<F2>, pg8::StaticOrder, true, true>(lds, g, S, E, mk_tid(wv_s)); } SEAM(3);
    if (IN(4)) DUP(4) { LOADP(); pg8::Gemm g{(const bf16_t*)(ws + WS_S1), (const bf16_t*)(ws + WS_WOUT), T, DM, DM}; pg8::StaticOrder S; S.init(T, DM, gridDim.x, blockIdx.x);
        unsigned* cnts = (unsigned*)(ws + WS_MISC + MISC_CTL + 16384); float* slots = (float*)(ws + WS_MISC + MISC_SLOTS);
        pg8::EpiNormRes<true> E{(const float*)(ws + WS_MISC + MISC_RSTD0), (const bf16_t*)(ws + WS_S3), nullptr, Q.in[2], (bf16_t*)(ws + WS_S0), pg8::RowStat{slots, cnts, nullptr}, pg8::RowStat{slots + 65536, cnts + 2048, (float*)(ws + WS_MISC + MISC_RSTD1)}};
        pg8::gemm_phase<pg8::EpiNormRes<true>, pg8::StaticOrder, false, true>(lds, g, S, E, mk_tid(wv_s)); }
    if (IN(4) && IN(6)) xcd_barrier(bar, mk_tid(wv_s));
    if (IN(6)) DUP(6) { LOADP(); logf_phase(Q, lds, mk_tid(wv_s));
        pg8::Gemm g{(const bf16_t*)(ws + WS_S0), (const bf16_t*)(ws + WS_WCAT), T, 4 * DM, DM}; pg8::StaticOrder S; S.init(T, 4 * DM, gridDim.x, blockIdx.x);
        pg8::EpiRow8<F4> E{F4{(const float*)(ws + WS_MISC + MISC_RSTD1), (bf16_t*)(ws + WS_S1), (bf16_t*)(ws + WS_S2), (bf16_t*)(ws + WS_S3), (bf16_t*)(ws + WS_S4)}};
        pg8::gemm_phase<pg8::EpiRow8<F4>, pg8::StaticOrder, true, true>(lds, g, S, E, mk_tid(wv_s)); } SEAM(6);
    if (IN(7)) { LOADP(); (void)ws; attn_phase(Q, (char*)lds_raw, wv_s); }

    if (IN(7) && IN(8)) xcd_barrier(bar, mk_tid(wv_s));
    if (IN(8)) DUP(8) { LOADP(); pg8::Gemm g{(const bf16_t*)(ws + WS_WIN), (const bf16_t*)(ws + WS_WFO), T, DM, DM}; pg8::StaticOrder S; S.init(T, DM, gridDim.x, blockIdx.x);
        unsigned* cnts = (unsigned*)(ws + WS_MISC + MISC_CTL + 16384); float* slots = (float*)(ws + WS_MISC + MISC_SLOTS);
        pg8::EpiNormRes<false> E{(const float*)(ws + WS_MISC + MISC_RSTD1), (const bf16_t*)(ws + WS_S0), Q.out, Q.in[2] + DM, nullptr, pg8::RowStat{slots + 131072, cnts + 4096, nullptr}, pg8::RowStat{nullptr, nullptr, nullptr}};
        pg8::gemm_phase<pg8::EpiNormRes<false>, pg8::StaticOrder, false, true>(lds, g, S, E, mk_tid(wv_s)); }
#undef IN
#undef SEAM
#undef LOADP
}

#ifndef N_LAUNCHES
#define N_LAUNCHES 1
#endif
extern "C" void kernel_launch(void* const* d_in, const int* in_sizes, int n_in, void* d_out, int out_size, void* d_ws, size_t ws_size, hipStream_t stream) {
    static int grid = 0;
    if (grid == 0) {
        if (n_in != 20 || out_size != T * DM || ws_size < 256 * MiB) { fprintf(stderr, "kernel_launch: unexpected shapes (n_in %d out %d ws %zu)\n", n_in, out_size, ws_size); grid = -1; return; }
        int dev = 0, cus = 0, per_cu = 0;
        (void)hipGetDevice(&dev); (void)hipDeviceGetAttribute(&cus, hipDeviceAttributeMultiprocessorCount, dev);
        if (hipFuncSetAttribute((const void*)yoco_fwd, hipFuncAttributeMaxDynamicSharedMemorySize, LDS_TOTAL) != hipSuccess) { fprintf(stderr, "kernel_launch: hipFuncSetAttribute failed\n"); grid = -1; return; }
        if (hipOccupancyMaxActiveBlocksPerMultiprocessor(&per_cu, (const void*)yoco_fwd, 512, LDS_TOTAL) != hipSuccess || per_cu < 1) { fprintf(stderr, "kernel_launch: occupancy query says %d\n", per_cu); per_cu = 1; }
        (void)hipGetLastError();
        if (cus <= 0) cus = 256;
        grid = cus * (per_cu > 1 ? 1 : per_cu);
        if (grid != 256) { fprintf(stderr, "kernel_launch: this kernel needs exactly 256 workgroups (one per CU of a 256-CU device), got %d; nothing launched\n", grid); grid = -1; return; }
    }
    if (grid < 0) return;
    if (hipMemsetAsync((char*)d_ws + WS_MISC + MISC_CTL, 0, 65536, stream) != hipSuccess) { fprintf(stderr, "kernel_launch: memset failed\n"); return; }
    Params p{};
    for (int i = 0; i < 20; ++i) p.in[i] = (const float*)d_in[i];
    p.out = (float*)d_out; p.ws = (unsigned char*)d_ws;
#if N_LAUNCHES == 1
    p.ph_lo = 0; p.ph_hi = 10;
    void* args[] = {&p};
    hipError_t e = hipLaunchCooperativeKernel((const void*)yoco_fwd, dim3(grid), dim3(512), args, LDS_TOTAL, stream);
    if (e != hipSuccess) fprintf(stderr, "cooperative launch failed: %s (grid %d)\n", hipGetErrorString(e), grid);
#else
    for (int k = 0; k < 10; ++k) { p.ph_lo = k; p.ph_hi = k + 1; hipLaunchKernelGGL(yoco_fwd, dim3(grid), dim3(512), LDS_TOTAL, stream, p); }
#endif
}
```

```cpp
#include <hip/hip_runtime.h>
#include <hip/hip_bf16.h>
#include <hip/hip_cooperative_groups.h>
#include <cstdio>
#include <cstdint>
namespace cg = cooperative_groups;
namespace pg8 {
#define PG8_LAS __attribute__((address_space(3)))
typedef unsigned short bf16_t;
typedef short bf16x8 __attribute__((ext_vector_type(8)));
typedef float f32x4 __attribute__((ext_vector_type(4)));
typedef unsigned u32x4 __attribute__((ext_vector_type(4)));
constexpr int BM = 256, BK = 64, HALF = 128, HTB = HALF * BK * 2  , STAGE_BYTES = 8 * HTB, NXCD = 8, WGM = 8;

__host__ __device__ __forceinline__ int lds_byte(int r, int c) { const int st = (r >> 4) * 2 + (c >> 5), rr = r & 15, cc = c & 31, ob = rr * 64 + cc * 2; return st * 1024 + (ob ^ (((ob >> 9) & 1) << 5)); }
__host__ __device__ __forceinline__ void stage_rc(int b, int& R, int& C) { const int st = b / 1024, sb = b % 1024, swz = sb ^ (((sb >> 9) & 1) << 5); R = (st >> 1) * 16 + swz / 64; C = (st & 1) * 32 + (swz % 64) / 2; }
__host__ __device__ __forceinline__ int perm32(int rho) { const int n = rho >> 4, i = rho & 15; return 8 * (i >> 2) + 4 * n + (i & 3); }

struct Unit { int pm, pn; };
struct Gemm { const bf16_t* A; const bf16_t* Bt; int M, N, K; };

struct StaticOrder {
    int nM, nN, nwg, G, c;
    __host__ __device__ void init(int M, int N, int G_, int c_) { nM = M / BM; nN = N / BM; nwg = nM * nN; G = G_; c = c_; }
    __host__ __device__ bool next(int i, Unit& u) const {
        const long L = (long)i * G + c; if (L >= nwg) return false;
        int wgid = (int)L; { const int q = nwg / NXCD, r = nwg % NXCD, xcd = wgid % NXCD, off = wgid / NXCD; wgid = (xcd < r ? xcd * (q + 1) : r * (q + 1) + (xcd - r) * q) + off; }
        const int nig = WGM * nN, gid = wgid / nig, fm = gid * WGM, gsz = (nM - fm) < WGM ? (nM - fm) : WGM;
        u.pm = fm + ((wgid % nig) % gsz); u.pn = (wgid % nig) / gsz; return true;
    }
    __device__ __forceinline__ void a_ready(const Unit&) const {}
    __device__ __forceinline__ void done(const Unit&) const {}
};

__device__ __forceinline__ unsigned cvt_pk_bf16(float lo, float hi) { unsigned r; asm volatile("v_cvt_pk_bf16_f32 %0, %1, %2" : "=v"(r) : "v"(lo), "v"(hi)); return r; }
typedef float f32x2 __attribute__((ext_vector_type(2)));
template <class F> struct EpiRow8 {
    static constexpr bool PERM = true, AFTER_DRAIN = false;
    F f;
    __device__ __forceinline__ void operator()(const f32x4 (&acc)[2][2][4][2], const Unit& u, int wr, int wc, int fr, int fq) const {
        const int row0 = u.pm * BM + wr * 64 + fr, col0 = u.pn * BM + wc * 32 + 8 * fq;
#pragma unroll
        for (int bj = 0; bj < 2; ++bj)
#pragma unroll
            for (int ai = 0; ai < 2; ++ai)
#pragma unroll
                for (int m = 0; m < 4; ++m) f(row0 + ai * HALF + m * 16, col0 + bj * HALF, acc[ai][bj][m][0], acc[ai][bj][m][1]);
    }
    __device__ __forceinline__ void fused(f32x4 (&)[2][2][4][2], const Unit&, int, int, int, int, PG8_LAS unsigned char*, int, int) const {}
};
struct RowStat {
    float* slots;
    unsigned* cnt;
    float* rstd_out;
    __device__ __forceinline__ void run(const f32x4 (&v)[2][2][4][2], const Unit& u, int wr, int wc, int fr, int fq, PG8_LAS unsigned char* lds, int wid, int lane) const {
        PG8_LAS float* Pp = (PG8_LAS float*)lds;
        PG8_LAS float* S = (PG8_LAS float*)(lds + 4096);
#pragma unroll
        for (int ai = 0; ai < 2; ++ai)
#pragma unroll
            for (int m = 0; m < 4; ++m) {
                float s = 0.f;
#pragma unroll
                for (int bj = 0; bj < 2; ++bj)
#pragma unroll
                    for (int n = 0; n < 2; ++n) { const f32x4 x = v[ai][bj][m][n]; s += (x[0] * x[0] + x[1] * x[1]) + (x[2] * x[2] + x[3] * x[3]); }
                s += __shfl_xor(s, 16); s += __shfl_xor(s, 32);
                if (fq == 0) Pp[(ai * HALF + wr * 64 + m * 16 + fr) * 4 + wc] = s;
            }
        asm volatile("s_waitcnt lgkmcnt(0)" ::: "memory"); __builtin_amdgcn_s_barrier(); asm volatile("" ::: "memory");
        const int row = wid * 32 + (lane & 31);
        if (lane < 32) {
            const float t = (Pp[row * 4 + 0] + Pp[row * 4 + 1]) + (Pp[row * 4 + 2] + Pp[row * 4 + 3]);
            __hip_atomic_store(slots + (size_t)(u.pm * BM + row) * 8 + u.pn, t, __ATOMIC_RELAXED, __HIP_MEMORY_SCOPE_AGENT);
        }
        asm volatile("s_waitcnt vmcnt(0)" ::: "memory");
        if (lane == 0) __hip_atomic_fetch_add(cnt + 64 * u.pm, 1u, __ATOMIC_RELAXED, __HIP_MEMORY_SCOPE_AGENT);
        if (wid == 0) {
            unsigned spins = 0;
            while ((unsigned)__builtin_amdgcn_readfirstlane(__hip_atomic_load(cnt + 64 * u.pm, __ATOMIC_RELAXED, __HIP_MEMORY_SCOPE_AGENT)) < 64u) { __builtin_amdgcn_s_sleep(2); if (++spins > (1u << 22)) break; }
            __builtin_amdgcn_fence(__ATOMIC_ACQUIRE, "agent");
        }
        asm volatile("s_waitcnt vmcnt(0) lgkmcnt(0)" ::: "memory"); __builtin_amdgcn_s_barrier(); asm volatile("" ::: "memory");
        if (lane < 32) {
            const float* sl = slots + (size_t)(u.pm * BM + row) * 8; float t = 0.f;
#pragma unroll
            for (int k = 0; k < 8; ++k) t += __hip_atomic_load(sl + k, __ATOMIC_RELAXED, __HIP_MEMORY_SCOPE_AGENT);
            const float rs = rsqrtf(t * (1.f / 2048.f) + 1e-6f);
            S[row] = rs;
            if (rstd_out && u.pn == 0) rstd_out[u.pm * BM + row] = rs;
        }
        asm volatile("s_waitcnt lgkmcnt(0)" ::: "memory"); __builtin_amdgcn_s_barrier(); asm volatile("" ::: "memory");
    }
};
template <bool SECOND> struct EpiNormRes {
    static constexpr bool PERM = true, AFTER_DRAIN = true;
    const float* base  ; const bf16_t* base16; float* out; const float* gain; bf16_t* outb; RowStat st1, st2;
    __device__ __forceinline__ void operator()(const f32x4 (&)[2][2][4][2], const Unit&, int, int, int, int) const {}
    __device__ __forceinline__ void fused(f32x4 (&acc)[2][2][4][2], const Unit& u, int wr, int wc, int fr, int fq, PG8_LAS unsigned char* lds, int wid, int lane) const {
        const PG8_LAS float* S = (const PG8_LAS float*)(lds + 4096);
        st1.run(acc, u, wr, wc, fr, fq, lds, wid, lane);
        const int col0 = u.pn * BM + wc * 32 + 8 * fq;
        f32x4 g[2][2];
#pragma unroll
        for (int bj = 0; bj < 2; ++bj) { g[bj][0] = *(const f32x4*)(gain + col0 + bj * HALF); g[bj][1] = *(const f32x4*)(gain + col0 + bj * HALF + 4); }
#pragma unroll
        for (int ai = 0; ai < 2; ++ai)
#pragma unroll
            for (int m = 0; m < 4; ++m) { const int r = ai * HALF + wr * 64 + m * 16 + fr; const float rs = S[r]; const size_t off = (size_t)(u.pm * BM + r) * 2048 + col0; const float bs = SECOND ? base[u.pm * BM + r] : __builtin_amdgcn_rcpf(base[u.pm * BM + r]);
#pragma unroll
                for (int bj = 0; bj < 2; ++bj) {
                    f32x4 b0, b1;
                    { const u32x4 w = *(const u32x4*)(base16 + off + bj * HALF);
                        b0 = (f32x4){__uint_as_float(w.x << 16), __uint_as_float(w.x & 0xffff0000u), __uint_as_float(w.y << 16), __uint_as_float(w.y & 0xffff0000u)};
                        b1 = (f32x4){__uint_as_float(w.z << 16), __uint_as_float(w.z & 0xffff0000u), __uint_as_float(w.w << 16), __uint_as_float(w.w & 0xffff0000u)}; }
                    const f32x4 h0 = b0 * bs + acc[ai][bj][m][0] * rs * g[bj][0], h1 = b1 * bs + acc[ai][bj][m][1] * rs * g[bj][1];
                    if (!SECOND) { *(f32x4*)(out + off + bj * HALF) = h0; *(f32x4*)(out + off + bj * HALF + 4) = h1; }
                    else { acc[ai][bj][m][0] = h0; acc[ai][bj][m][1] = h1; }
                }
                if (m & 1) asm volatile("" ::: "memory"); }
        if (SECOND) { st2.run(acc, u, wr, wc, fr, fq, lds, wid, lane);
#pragma unroll
            for (int ai = 0; ai < 2; ++ai)
#pragma unroll
                for (int m = 0; m < 4; ++m) { const int r = ai * HALF + wr * 64 + m * 16 + fr; const float r1 = S[r]; const size_t off = (size_t)(u.pm * BM + r) * 2048 + col0;
#pragma unroll
                    for (int bj = 0; bj < 2; ++bj) { const f32x4 h0 = acc[ai][bj][m][0] * r1, h1 = acc[ai][bj][m][1] * r1;
                        u32x4 w; w.x = cvt_pk_bf16(h0[0], h0[1]); w.y = cvt_pk_bf16(h0[2], h0[3]); w.z = cvt_pk_bf16(h1[0], h1[1]); w.w = cvt_pk_bf16(h1[2], h1[3]);
                        *(u32x4*)(outb + off + bj * HALF) = w; } } }
    }
};
template <class Epi, class Sched, bool ALIGN_EPI = false, bool SP2 = false>
__device__ __forceinline__ void gemm_phase(PG8_LAS unsigned char* lds, const Gemm g, const Sched& S, const Epi& E, const int tid_in) {
    const int tid = tid_in, wid = __builtin_amdgcn_readfirstlane(tid >> 6), lane = tid & 63, wr = wid >> 2, wc = wid & 3, fr = lane & 15, fq = lane >> 4;
    const int K = g.K, nt = K / BK;
    unsigned voffA[2], voffB[2];
#pragma unroll
    for (int i = 0; i < 2; ++i) { int R, C; stage_rc(tid * 16 + i * 8192, R, C); const int Rb = Epi::PERM ? ((R & ~31) + perm32(R & 31)) : R;
        voffA[i] = (unsigned)(R * K + C) * 2u; voffB[i] = (unsigned)(Rb * K + C) * 2u; }
    const size_t kstep = (size_t)(BK * 2);
    const size_t hstep = (size_t)HALF * K * 2;
    const size_t tstep = 2 * hstep;
    const unsigned ldsw = (unsigned)wid * 1024u;
    const int aoff = lds_byte(wr * 64 + fr, fq * 8), boff = lds_byte(wc * 32 + fr, fq * 8);
#define PG8_SA(b, h) (((b) * 2 + (h)) * HTB)
#define PG8_SB(b, h) ((4 + (b) * 2 + (h)) * HTB)
#define PG8_STAGE(bufoff, gbase, voff) do { _Pragma("unroll") for (int _i = 0; _i < 2; ++_i) \
        __builtin_amdgcn_global_load_lds((const unsigned*)((const char*)(gbase) + (voff)[_i]), (PG8_LAS unsigned*)(lds + (bufoff) + ldsw + _i * 8192), 16, 0, 0); } while (0)
#define PG8_LDA(dst, b, h) do { _Pragma("unroll") for (int m = 0; m < 4; ++m) _Pragma("unroll") for (int k = 0; k < 2; ++k) dst[m][k] = *(const PG8_LAS bf16x8*)(lds + PG8_SA(b, h) + aoff + m * 2048 + k * 1024); } while (0)
#define PG8_LDB(dst, b, h) do { _Pragma("unroll") for (int n = 0; n < 2; ++n) _Pragma("unroll") for (int k = 0; k < 2; ++k) dst[n][k] = *(const PG8_LAS bf16x8*)(lds + PG8_SB(b, h) + boff + n * 2048 + k * 1024); } while (0)
#define PG8_MMA(ai, bj, At, Bt) do { __builtin_amdgcn_s_setprio(1); _Pragma("unroll") for (int m = 0; m < 4; ++m) _Pragma("unroll") for (int n = 0; n < 2; ++n) _Pragma("unroll") for (int k = 0; k < 2; ++k) \
        acc[ai][bj][m][n] = __builtin_amdgcn_mfma_f32_16x16x32_bf16(Bt[n][k], At[m][k], acc[ai][bj][m][n], 0, 0, 0); __builtin_amdgcn_s_setprio(0); } while (0)
#define PG8_WAIT_V(n) asm volatile("s_waitcnt vmcnt(" #n ")" ::: "memory")
#define PG8_WAIT_L(n) asm volatile("s_waitcnt lgkmcnt(" #n ")" ::: "memory")
#define PG8_BAR __builtin_amdgcn_s_barrier()
#define PG8_SCHED __builtin_amdgcn_sched_barrier(0)
    Unit cur, nxt; int ui = 0;
    if (!S.next(0, cur)) return;
    f32x4 acc[2][2][4][2];
#pragma unroll
    for (int a = 0; a < 2; ++a)
#pragma unroll
        for (int b = 0; b < 2; ++b)
#pragma unroll
            for (int m = 0; m < 4; ++m)
#pragma unroll
                for (int n = 0; n < 2; ++n) acc[a][b][m][n] = (f32x4){0.f, 0.f, 0.f, 0.f};
    bf16x8 At[4][2], B0[2][2], B1[2][2];
    const char* cA = (const char*)g.A + (size_t)cur.pm * tstep; const char* cB = (const char*)g.Bt + (size_t)cur.pn * tstep;
    S.a_ready(cur);
    if constexpr (SP2) {
        PG8_STAGE(PG8_SB(0, 0), cB, voffB); PG8_STAGE(PG8_SB(0, 1), cB + hstep, voffB); PG8_STAGE(PG8_SA(0, 0), cA, voffA); PG8_STAGE(PG8_SA(0, 1), cA + hstep, voffA);
        if (wr == 1) PG8_BAR;
        PG8_WAIT_V(2); PG8_BAR;
        PG8_STAGE(PG8_SB(1, 0), cB + kstep, voffB); PG8_STAGE(PG8_SA(1, 0), cA + kstep, voffA); PG8_STAGE(PG8_SB(1, 1), cB + hstep + kstep, voffB);
        PG8_WAIT_V(6); PG8_BAR;
    } else {
        PG8_STAGE(PG8_SB(0, 0), cB, voffB); PG8_STAGE(PG8_SA(0, 0), cA, voffA); PG8_STAGE(PG8_SB(0, 1), cB + hstep, voffB); PG8_STAGE(PG8_SA(0, 1), cA + hstep, voffA);
        if (wr == 1) PG8_BAR;
        PG8_WAIT_V(4); PG8_BAR;
        PG8_STAGE(PG8_SB(1, 0), cB + kstep, voffB); PG8_STAGE(PG8_SA(1, 0), cA + kstep, voffA); PG8_STAGE(PG8_SB(1, 1), cB + hstep + kstep, voffB);
        PG8_WAIT_V(6); PG8_BAR;
    }
    for (;;) {
        const bool has_next = S.next(ui + 1, nxt);
        const char* nA = has_next ? (const char*)g.A + (size_t)nxt.pm * tstep : cA; const char* nB = has_next ? (const char*)g.Bt + (size_t)nxt.pn * tstep : cB;
        for (int t = 0; t < nt; t += 2) {
            const bool last = (t == nt - 2);
            const char* a1 = cA + (size_t)(t + 1) * kstep;
            const char* a2 = last ? nA : cA + (size_t)(t + 2) * kstep; const char* b2 = last ? nB : cB + (size_t)(t + 2) * kstep;
            const char* a3 = a2 + kstep; const char* b3 = b2 + kstep;
            if (last && has_next) S.a_ready(nxt);
            if constexpr (SP2) {
            PG8_LDB(B0, 0, 0); PG8_LDB(B1, 0, 1); PG8_SCHED; PG8_LDA(At, 0, 0); PG8_STAGE(PG8_SA(1, 1), a1 + hstep, voffA);
            PG8_WAIT_V(8); PG8_WAIT_L(0); PG8_BAR; PG8_MMA(0, 0, At, B0); PG8_MMA(0, 1, At, B1); PG8_BAR; PG8_SCHED;
            PG8_LDA(At, 0, 1); PG8_STAGE(PG8_SB(0, 0), b2, voffB); PG8_STAGE(PG8_SB(0, 1), b2 + hstep, voffB); PG8_STAGE(PG8_SA(0, 0), a2, voffA);
            PG8_WAIT_V(8); PG8_WAIT_L(0); PG8_BAR; PG8_MMA(1, 0, At, B0); PG8_MMA(1, 1, At, B1); PG8_BAR; PG8_SCHED;
            PG8_LDB(B0, 1, 0); PG8_LDB(B1, 1, 1); PG8_SCHED; PG8_LDA(At, 1, 0); PG8_STAGE(PG8_SA(0, 1), a2 + hstep, voffA);
            PG8_WAIT_V(8); PG8_WAIT_L(0); PG8_BAR; PG8_MMA(0, 0, At, B0); PG8_MMA(0, 1, At, B1); PG8_BAR; PG8_SCHED;
            PG8_LDA(At, 1, 1); PG8_STAGE(PG8_SB(1, 0), b3, voffB); PG8_STAGE(PG8_SB(1, 1), b3 + hstep, voffB); PG8_STAGE(PG8_SA(1, 0), a3, voffA);
            PG8_WAIT_V(8); PG8_WAIT_L(0); PG8_BAR; PG8_MMA(1, 0, At, B0); PG8_MMA(1, 1, At, B1); PG8_BAR; PG8_SCHED;
            } else {
            PG8_LDB(B0, 0, 0); PG8_SCHED; PG8_LDA(At, 0, 0); PG8_STAGE(PG8_SA(1, 1), a1 + hstep, voffA);
            PG8_WAIT_L(8); PG8_BAR; PG8_WAIT_L(0); PG8_MMA(0, 0, At, B0); PG8_BAR; PG8_SCHED;
            PG8_LDB(B1, 0, 1); PG8_STAGE(PG8_SB(0, 0), b2, voffB);
            PG8_BAR; PG8_WAIT_L(0); PG8_MMA(0, 1, At, B1); PG8_BAR;
            PG8_LDA(At, 0, 1); PG8_STAGE(PG8_SA(0, 0), a2, voffA);
            PG8_BAR; PG8_WAIT_L(0); PG8_MMA(1, 0, At, B0); PG8_BAR; PG8_SCHED;
            PG8_STAGE(PG8_SB(0, 1), b2 + hstep, voffB);
            PG8_WAIT_V(6); PG8_BAR; PG8_MMA(1, 1, At, B1); PG8_BAR;
            PG8_LDB(B0, 1, 0); PG8_SCHED; PG8_LDA(At, 1, 0); PG8_STAGE(PG8_SA(0, 1), a2 + hstep, voffA);
            PG8_WAIT_L(8); PG8_BAR; PG8_WAIT_L(0); PG8_MMA(0, 0, At, B0); PG8_BAR; PG8_SCHED;
            PG8_LDB(B1, 1, 1); PG8_STAGE(PG8_SB(1, 0), b3, voffB);
            PG8_BAR; PG8_WAIT_L(0); PG8_MMA(0, 1, At, B1); PG8_BAR;
            PG8_LDA(At, 1, 1); PG8_STAGE(PG8_SA(1, 0), a3, voffA);
            PG8_BAR; PG8_WAIT_L(0); PG8_MMA(1, 0, At, B0); PG8_BAR; PG8_SCHED;
            PG8_STAGE(PG8_SB(1, 1), b3 + hstep, voffB);
            PG8_WAIT_V(6); PG8_BAR; PG8_MMA(1, 1, At, B1); PG8_BAR;
            }
        }
        if constexpr (ALIGN_EPI) { if (wr == 0) PG8_BAR; }
        if constexpr (!Epi::AFTER_DRAIN) { E(acc, cur, wr, wc, fr, fq); S.done(cur); }
        if (!has_next) break;
#pragma unroll
        for (int a = 0; a < 2; ++a)
#pragma unroll
            for (int b = 0; b < 2; ++b)
#pragma unroll
                for (int m = 0; m < 4; ++m)
#pragma unroll
                    for (int n = 0; n < 2; ++n) acc[a][b][m][n] = (f32x4){0.f, 0.f, 0.f, 0.f};
        cur = nxt; cA = nA; cB = nB; ++ui;
        if constexpr (ALIGN_EPI) { if (wr == 1) PG8_BAR; }
    }
    PG8_WAIT_V(0);
    if constexpr (!ALIGN_EPI) { if (wr == 0) PG8_BAR; }
    PG8_BAR;
    if constexpr (Epi::AFTER_DRAIN) { E.fused(acc, cur, wr, wc, fr, fq, lds, wid, lane); S.done(cur); }
#undef PG8_SA
#undef PG8_SB
#undef PG8_STAGE
#undef PG8_LDA
#undef PG8_LDB
#undef PG8_MMA
#undef PG8_WAIT_V
#undef PG8_WAIT_L
#undef PG8_BAR
#undef PG8_SCHED
}
}
namespace attn {
constexpr int D = 128; constexpr float THR = 8.f; constexpr bool WSKIP = false; constexpr int OSTR = 2048, BIAS_OFF = 69632, OST_OFF = 90112;
constexpr float SCALE = 0.08838834764831845f;
constexpr int NW = 8, QBLK = 32, KVBLK = 64, QB = NW * QBLK;
constexpr int SHM_V = KVBLK * D * 2, SHM_K = KVBLK * D * 2;
constexpr int LDS_BYTES = 2 * SHM_V + 2 * SHM_K + NW * 64 * 4;
using bf16 = __hip_bfloat16;
typedef short bf16x8 __attribute__((ext_vector_type(8)));
typedef short s16x4 __attribute__((ext_vector_type(4)));
typedef float f32x16 __attribute__((ext_vector_type(16)));
typedef float f32x4 __attribute__((ext_vector_type(4)));
typedef unsigned u32x4 __attribute__((ext_vector_type(4)));
template <class A, class Bt> struct same_t { static constexpr bool v = false; };
template <class A> struct same_t<A, A> { static constexpr bool v = true; };

#define KSWZ(row, colB) ((row) * 256 + ((colB) ^ (((row) & 7) << 4)))
#define SBAR() __builtin_amdgcn_sched_barrier(0)
__device__ __forceinline__ int v_st(int k, int c) { const int kk = (k & ~0xC) | ((k & 4) << 1) | ((k & 8) >> 1); return ((kk >> 3) * 4 + (c >> 5)) * 512 + ((kk & 7) * 32 + (c & 31)) * 2; }
__device__ __forceinline__ int v_rd_base(int lane) { return ((lane & 3) << 3) | (((lane >> 2) & 3) << 6) | (((lane >> 4) & 1) << 5) | (((lane >> 5) & 1) << 8); }
constexpr int v_rd_off(int d0, int ks, int half) { return d0 * 512 + ks * 4096 + half * 2048; }
__device__ __forceinline__ int crow(int r, int hi) { return (r & 3) + 8 * (r >> 2) + 4 * hi; }
__device__ __forceinline__ unsigned cvtpk(float lo, float hi) {
    unsigned r; asm volatile("v_cvt_pk_bf16_f32 %0, %1, %2" : "=v"(r) : "v"(lo), "v"(hi)); return r;
}
__device__ __forceinline__ bf16x8 pack8(f32x4 a, f32x4 b) {
    u32x4 w = {cvtpk(a[0], a[1]), cvtpk(a[2], a[3]), cvtpk(b[0], b[1]), cvtpk(b[2], b[3])};
    return *reinterpret_cast<bf16x8*>(&w);
}
template <class T> __device__ __forceinline__ bf16x8 load8(const T* p) {
    if constexpr (same_t<T, float>::v) { return pack8(*(const f32x4*)p, *(const f32x4*)(p + 4)); }
    else { return *reinterpret_cast<const bf16x8*>(p); }
}
__device__ __forceinline__ void mask_tile(f32x16& p0, f32x16& p1, int dq, unsigned W) {
    const float NEG = -__builtin_inff();
#pragma unroll
    for (int r = 0; r < 16; ++r) {
        const int c = (r & 3) + 8 * (r >> 2);
        if ((unsigned)(dq - c) >= W) p0[r] = NEG;
        if ((unsigned)(dq - c - 32) >= W) p1[r] = NEG;
    }
}
__device__ __forceinline__ void partialSM(f32x16& p0, f32x16& p1, float& m_reg, float& mn, float& alpha) {
    float pmax = p0[0]; for (int r = 1; r < 16; ++r) pmax = fmaxf(pmax, p0[r]); for (int r = 0; r < 16; ++r) pmax = fmaxf(pmax, p1[r]);
    { auto rr = __builtin_amdgcn_permlane32_swap(__float_as_uint(pmax), __float_as_uint(pmax), false, false);
      pmax = fmaxf(__uint_as_float(rr[0]), __uint_as_float(rr[1])); }
    constexpr float C2 = 1.4426950408889634f * SCALE;
    if (__builtin_expect(__all((pmax - m_reg) * SCALE <= THR), 1)) { mn = m_reg; alpha = 1.f; }
    else { mn = fmaxf(m_reg, pmax); alpha = __builtin_amdgcn_exp2f((m_reg - mn) * C2); m_reg = mn; }
    const float mnL = -mn * C2;
    for (int r = 0; r < 16; ++r) p0[r] = fmaf(p0[r], C2, mnL); for (int r = 0; r < 16; ++r) p1[r] = fmaf(p1[r], C2, mnL);
    for (int r = 0; r < 16; ++r) p0[r] = __builtin_amdgcn_exp2f(p0[r]);
}
__device__ __forceinline__ void finishSM(f32x16& p0, f32x16& p1, float alpha, float& l_reg, bf16x8& pa0, bf16x8& pa1, bf16x8& pa2, bf16x8& pa3) {
    for (int r = 0; r < 16; ++r) p1[r] = __builtin_amdgcn_exp2f(p1[r]);
    float ps = 0; for (int r = 0; r < 16; ++r) ps += p0[r]; for (int r = 0; r < 16; ++r) ps += p1[r];
    { auto rr = __builtin_amdgcn_permlane32_swap(__float_as_uint(ps), __float_as_uint(ps), false, false);
      ps = __uint_as_float(rr[0]) + __uint_as_float(rr[1]); }
    l_reg = l_reg * alpha + ps;
#define PK4(P, B_, OUT) do { unsigned a0 = cvtpk(P[B_+0], P[B_+1]), a1 = cvtpk(P[B_+2], P[B_+3]);                          \
        unsigned b0 = cvtpk(P[B_+4], P[B_+5]), b1 = cvtpk(P[B_+6], P[B_+7]);                                             \
        auto r0 = __builtin_amdgcn_permlane32_swap(a0, b0, false, false); auto r1 = __builtin_amdgcn_permlane32_swap(a1, b1, false, false); \
        u32x4 w = {r0[0], r1[0], r0[1], r1[1]}; OUT = *reinterpret_cast<bf16x8*>(&w); } while (0)
    PK4(p0, 0, pa0); PK4(p0, 8, pa1); PK4(p1, 0, pa2); PK4(p1, 8, pa3);
#undef PK4
}
__device__ __forceinline__ const float* bl_addr(const char* lds, int hi, int kbase) { int h = hi; asm volatile("" : "+v"(h)); return (const float*)(lds + BIAS_OFF) + 4 * h + kbase; }
template <int KB, bool SK>
__device__ __forceinline__ void qkt(f32x16& p0, f32x16& p1, const char* K_lds, int r32, int hi, const bf16x8* qr, bool act, const float* bl) {
    if (SK && !act) { const float NEG = -__builtin_inff();
#pragma unroll
        for (int r = 0; r < 16; ++r) { p0[r] = NEG; p1[r] = NEG; } return; }
    { const f32x4 c0 = *(const f32x4*)(bl), c1 = *(const f32x4*)(bl + 8), c2 = *(const f32x4*)(bl + 16), c3 = *(const f32x4*)(bl + 24);
      const f32x4 e0 = *(const f32x4*)(bl + 32), e1 = *(const f32x4*)(bl + 40), e2 = *(const f32x4*)(bl + 48), e3 = *(const f32x4*)(bl + 56);
      p0 = (f32x16){c0[0], c0[1], c0[2], c0[3], c1[0], c1[1], c1[2], c1[3], c2[0], c2[1], c2[2], c2[3], c3[0], c3[1], c3[2], c3[3]};
      p1 = (f32x16){e0[0], e0[1], e0[2], e0[3], e1[0], e1[1], e1[2], e1[3], e2[0], e2[1], e2[2], e2[3], e3[0], e3[1], e3[2], e3[3]}; }
    const char* kb[4];
#pragma unroll
    for (int dd = 0; dd < 4; ++dd) kb[dd] = K_lds + KB * SHM_K + KSWZ(r32, (dd * 16 + hi * 8) * 2);
#pragma unroll
    for (int d0 = 0; d0 < 8; ++d0) { const char* a = kb[d0 & 3] + (d0 >> 2) * 128;
        bf16x8 b0 = *reinterpret_cast<const bf16x8*>(a);
        bf16x8 b1 = *reinterpret_cast<const bf16x8*>(a + 32 * 256);
        p0 = __builtin_amdgcn_mfma_f32_32x32x16_bf16(b0, qr[d0], p0, 0, 0, 0);
        p1 = __builtin_amdgcn_mfma_f32_32x32x16_bf16(b1, qr[d0], p1, 0, 0, 0); }
}
template <int VB, bool SK>
__device__ __forceinline__ void pv_tile(f32x16* o, int vb0, bf16x8 pa0, bf16x8 pa1, bf16x8 pa2, bf16x8 pa3, bool act) {
    if (SK && !act) return;
#define TRRD(dst, off) asm volatile("ds_read_b64_tr_b16 %0, %1 offset:%2" : "=&v"(dst) : "v"(vb0), "i"(off) : "memory")
#define PV_D0(d0) do { s16x4 l0, l1, l2, l3, h0, h1, h2, h3; constexpr int b_ = VB * SHM_V + v_rd_off(d0, 0, 0);     \
        TRRD(l0, b_); TRRD(h0, b_ + 2048); TRRD(l1, b_ + 4096); TRRD(h1, b_ + 6144); TRRD(l2, b_ + 8192); TRRD(h2, b_ + 10240); TRRD(l3, b_ + 12288); TRRD(h3, b_ + 14336); \
        asm volatile("s_waitcnt lgkmcnt(0)" ::: "memory"); SBAR();                 \
        o[d0] = __builtin_amdgcn_mfma_f32_32x32x16_bf16(pa0, (bf16x8){l0[0], l0[1], l0[2], l0[3], h0[0], h0[1], h0[2], h0[3]}, o[d0], 0, 0, 0);   \
        o[d0] = __builtin_amdgcn_mfma_f32_32x32x16_bf16(pa1, (bf16x8){l1[0], l1[1], l1[2], l1[3], h1[0], h1[1], h1[2], h1[3]}, o[d0], 0, 0, 0);   \
        o[d0] = __builtin_amdgcn_mfma_f32_32x32x16_bf16(pa2, (bf16x8){l2[0], l2[1], l2[2], l2[3], h2[0], h2[1], h2[2], h2[3]}, o[d0], 0, 0, 0);   \
        o[d0] = __builtin_amdgcn_mfma_f32_32x32x16_bf16(pa3, (bf16x8){l3[0], l3[1], l3[2], l3[3], h3[0], h3[1], h3[2], h3[3]}, o[d0], 0, 0, 0); } while (0)
    PV_D0(0); PV_D0(1); PV_D0(2); PV_D0(3);
#undef PV_D0
#undef TRRD
}

template <class TIn, class TOut> struct BlockRef { const TIn* Q; const TIn* K; const TIn* V; TOut* O; const unsigned short* Z; int P0; };
template <class TIn> struct Seam {
    bf16x8 qr[8];
    bf16x8 st_v0, st_v1, st_k0, st_k1; f32x4 sf0, sf1, sf2, sf3;
    f32x4 tq[16];
};
__device__ __forceinline__ int swa_jlo(int P0, int W) { const int lowk = P0 - W + 1; return lowk > 0 ? lowk / KVBLK : 0; }
__device__ __forceinline__ int hm16(int r, int d) { return (r & ~15) * 128 + ((((d >> 5) * 16 + (r & 15)) * 4 + ((d >> 3) & 3)) << 3); }
#define ROW(p, k0, rr) ((p) + (size_t)(k0) * D + hm16((rr), sc))
#define VMW() asm volatile("s_waitcnt vmcnt(0)" ::: "memory")
#define VMWN(n) asm volatile("s_waitcnt vmcnt(%0)" :: "i"(n) : "memory")
#define SLOAD_H(Kp, Vp, k0) do { S.st_v0 = load8<TIn>(ROW(Vp, k0, sr)); S.st_v1 = load8<TIn>(ROW(Vp, k0, 32 + sr));              \
                         S.st_k0 = load8<TIn>(ROW(Kp, k0, sr)); S.st_k1 = load8<TIn>(ROW(Kp, k0, 32 + sr)); } while (0)
#define SWRITE_HK(bf) do { *(bf16x8*)(K_lds + (bf) * SHM_K + kws) = S.st_k0; *(bf16x8*)(K_lds + (bf) * SHM_K + kws + 32 * 256) = S.st_k1; } while (0)
#define SWRITE_HV(bf) do { *(bf16x8*)(V_lds + (bf) * SHM_V + vst0) = S.st_v0; *(bf16x8*)(V_lds + (bf) * SHM_V + vst1) = S.st_v1; } while (0)
#define SWRITE_H(bf) do { SWRITE_HV(bf); SWRITE_HK(bf); } while (0)
#define SLOAD_F(p, k0) do { S.sf0 = *(const f32x4*)ROW(p, k0, sr); S.sf1 = *(const f32x4*)(ROW(p, k0, sr) + 4);                \
                            S.sf2 = *(const f32x4*)ROW(p, k0, 32 + sr); S.sf3 = *(const f32x4*)(ROW(p, k0, 32 + sr) + 4); } while (0)
#define SWRITE_KF(bf) do { *(bf16x8*)(K_lds + (bf) * SHM_K + kws) = pack8(S.sf0, S.sf1); *(bf16x8*)(K_lds + (bf) * SHM_K + kws + 32 * 256) = pack8(S.sf2, S.sf3); } while (0)
#define SWRITE_VF(bf) do { *(bf16x8*)(V_lds + (bf) * SHM_V + vst0) = pack8(S.sf0, S.sf1); *(bf16x8*)(V_lds + (bf) * SHM_V + vst1) = pack8(S.sf2, S.sf3); } while (0)
template <class TIn, class TOut>
__device__ __forceinline__ void causal_swa_prime(const BlockRef<TIn, TOut>& cur, int W, char* lds, Seam<TIn>& S, const int tid_in) {
    constexpr bool F32 = same_t<TIn, float>::v;
    const int tid = tid_in, wid = __builtin_amdgcn_readfirstlane(tid >> 6), lane = tid & 63, r32 = lane & 31, hi = lane >> 5;
    const int sr = tid >> 4, sc = (tid & 15) * 8, kws = KSWZ(sr, sc * 2); char* K_lds = lds + 2 * SHM_V;
    const int kb0 = swa_jlo(cur.P0, W) * KVBLK;
    for (int d0 = 0; d0 < 8; ++d0) S.qr[d0] = load8<TIn>(cur.Q + hm16(wid * QBLK + r32, d0 * 16 + hi * 8));
    if constexpr (F32) { SLOAD_F((const float*)cur.K, kb0); VMW(); SWRITE_KF(0); SBAR(); SLOAD_F((const float*)cur.V, kb0); }
    else { SLOAD_H(cur.K, cur.V, kb0); VMW(); SWRITE_HK(0); }
    __syncthreads();
}
template <class TIn, class TOut>
__device__ __forceinline__ void causal_swa_block(const BlockRef<TIn, TOut>& cur, const BlockRef<TIn, TOut>& nxt, int skv, int W, char* lds, Seam<TIn>& S, const int tid_in) {
    constexpr bool F32 = same_t<TIn, float>::v;
    const int tid = tid_in, wid = __builtin_amdgcn_readfirstlane(tid >> 6), lane = tid & 63, r32 = lane & 31, hi = lane >> 5;
    const int j_lo = swa_jlo(cur.P0, W);
    int j_hi = (cur.P0 + QB - 1) / KVBLK + 1; if (j_hi > skv / KVBLK) j_hi = skv / KVBLK;
    const int NT = j_hi - j_lo;
    const int kbn = swa_jlo(nxt.P0, W) * KVBLK;
    const int qlo = cur.P0 + wid * QBLK, qm = qlo + r32 - 4 * hi;
    char* V_lds = lds; char* K_lds = lds + 2 * SHM_V;
    float* ws = (float*)(lds + 2 * SHM_V + 2 * SHM_K) + wid * 64; float* li_l = ws, * al_l = ws + 32;
    float m_reg = ((const float*)(lds + BIAS_OFF))[cur.P0 + wid * QBLK + r32], l_reg = 0; f32x16 o[4] = {};
    const int sr = tid >> 4, sc = (tid & 15) * 8, vst0 = v_st(sr, sc), vst1 = v_st(32 + sr, sc), kws = KSWZ(sr, sc * 2);
    const int vb0 = (int)(uintptr_t)V_lds + v_rd_base(lane);
    const TIn* Kh = cur.K; const TIn* Vh = cur.V;
#define RESC(a) do { if (__any((a) < 1.f)) { if (hi == 0) al_l[r32] = (a); asm volatile("s_waitcnt lgkmcnt(0)" ::: "memory");              \
                     for (int d_ = 0; d_ < 4; ++d_) for (int r = 0; r < 16; ++r) o[d_][r] *= al_l[crow(r, hi)]; } } while (0)
#define KBASE(t) ((j_lo + (t)) * KVBLK)
#define BL(t) bl_addr(lds, hi, KBASE(t))
#define ACT(t) (KBASE(t) <= qlo + QBLK - 1 && KBASE(t) + KVBLK - 1 >= qlo - W + 1)
#define MASKT(P0_, P1_, t) do { const int kb_ = KBASE(t); if ((!SK || ACT(t)) && (kb_ + KVBLK - 1 > qlo || kb_ <= qlo + QBLK - 1 - W)) mask_tile(P0_, P1_, qm - kb_, (unsigned)W); } while (0)
    constexpr int NQL = F32 ? 16 : 8;
    constexpr bool SK = WSKIP && !F32;
#define SEAM_K0() do { VMWN(NQL); if constexpr (F32) { SWRITE_KF(0); SBAR(); SLOAD_F((const float*)nxt.V, kbn); } else { SWRITE_HK(0); } SBAR(); } while (0)
    f32x16 pA0, pA1, pB0, pB1; float mnA, mnB, alA, alB; bf16x8 pa0, pa1, pa2, pa3;
    if constexpr (F32) { VMW(); SWRITE_VF(0); SBAR(); } else { SWRITE_HV(0); SBAR(); }
    if (NT > 1) { if constexpr (F32) SLOAD_F((const float*)Kh, KBASE(1)); else SLOAD_H(Kh, Vh, KBASE(1)); }
    SBAR(); qkt<0, SK>(pA0, pA1, K_lds, r32, hi, S.qr, ACT(0), BL(0));
    if constexpr (F32) { if (NT > 1) { VMW(); SWRITE_KF(1); SBAR(); SLOAD_F((const float*)Vh, KBASE(1)); } }
    MASKT(pA0, pA1, 0); partialSM(pA0, pA1, m_reg, mnA, alA);
    if (NT > 1) { VMW(); if constexpr (F32) { SWRITE_VF(1); SBAR(); if (NT > 2) SLOAD_F((const float*)Kh, KBASE(2)); } else SWRITE_H(1); }
    __syncthreads();
#define HALF_STEP(PX0, PX1, mnX, alX, PY0, PY1, alY, t, KB, VB, SB) do {                                                      \
        SBAR(); qkt<KB, SK>(PX0, PX1, K_lds, r32, hi, S.qr, ACT(t), BL(t));                                             \
        finishSM(PY0, PY1, alY, l_reg, pa0, pa1, pa2, pa3); SBAR();                                                           \
        if ((t) + 1 < NT) { if constexpr (F32) { VMW(); SWRITE_KF(SB); SBAR(); SLOAD_F((const float*)Vh, KBASE((t) + 1)); }  \
                            else { SLOAD_H(Kh, Vh, KBASE((t) + 1)); } SBAR(); }                                               \
        pv_tile<VB, SK>(o, vb0, pa0, pa1, pa2, pa3, ACT((t) - 1)); MASKT(PX0, PX1, (t)); partialSM(PX0, PX1, m_reg, mnX, alX);                                        \
        __syncthreads();                                                                                                      \
        if ((t) + 1 < NT) { VMW(); if constexpr (F32) { SWRITE_VF(SB); SBAR(); if ((t) + 2 < NT) SLOAD_F((const float*)Kh, KBASE((t) + 2)); } \
                            else { SWRITE_H(SB); } }                                                                          \
        RESC(alX); __syncthreads(); } while (0)
    for (int t = 1; t + 1 < NT; t += 2) {
        HALF_STEP(pB0, pB1, mnB, alB, pA0, pA1, alA, t, 1, 0, 0);
        HALF_STEP(pA0, pA1, mnA, alA, pB0, pB1, alB, t + 1, 0, 1, 1);
    }
    const bool even = (NT & 1) == 0;
    if (even) { SBAR(); qkt<1, SK>(pB0, pB1, K_lds, r32, hi, S.qr, ACT(NT - 1), BL(NT - 1)); SBAR(); }
#define QROW(e) (nxt.Q + (size_t)(wid * QBLK + r32) * D + ((e) >> 1) * 16 + hi * 8 + ((e) & 1) * 4)
    if constexpr (F32) { SLOAD_F((const float*)nxt.K, kbn); SBAR();
#pragma unroll
        for (int e = 0; e < 8; ++e) S.tq[e] = *(const f32x4*)QROW(e); }
    else { SLOAD_H(nxt.K, nxt.V, kbn); SBAR();
#pragma unroll
        for (int d0 = 0; d0 < 8; ++d0) S.qr[d0] = load8<TIn>(nxt.Q + hm16(wid * QBLK + r32, d0 * 16 + hi * 8)); }
    SBAR();
    finishSM(pA0, pA1, alA, l_reg, pa0, pa1, pa2, pa3); SBAR();
    if constexpr (F32) {
#pragma unroll
        for (int e = 8; e < 16; ++e) S.tq[e] = *(const f32x4*)QROW(e); SBAR(); }
#undef QROW
    pv_tile<0, SK>(o, vb0, pa0, pa1, pa2, pa3, ACT(even ? NT - 2 : NT - 1));
    if (even) { MASKT(pB0, pB1, NT - 1); partialSM(pB0, pB1, m_reg, mnB, alB); __syncthreads(); RESC(alB);
        finishSM(pB0, pB1, alB, l_reg, pa0, pa1, pa2, pa3); SBAR(); pv_tile<1, SK>(o, vb0, pa0, pa1, pa2, pa3, ACT(NT - 1)); }
    SBAR(); SEAM_K0();
    if (hi == 0) li_l[r32] = l_reg; asm volatile("s_waitcnt lgkmcnt(0)" ::: "memory");
    float rli[16];
#pragma unroll
    for (int r = 0; r < 16; ++r) rli[r] = __builtin_amdgcn_rcpf(li_l[crow(r, hi)]);
    { unsigned short* stg = (unsigned short*)(lds + OST_OFF) + wid * 2048;
      size_t obase = (size_t)cur.O, zbase = (size_t)cur.Z; int ln = lane; asm volatile("" : "+s"(obase), "+s"(zbase), "+v"(ln));
#pragma unroll
      for (int half = 0; half < 2; ++half) {
#pragma unroll
        for (int r = 0; r < 16; ++r) { const int orow = crow(r, hi);
#pragma unroll
          for (int dl = 0; dl < 2; ++dl) { const float v = o[half * 2 + dl][r] * rli[r]; stg[orow * 64 + dl * 32 + r32] = (unsigned short)(cvtpk(v, v) & 0xffffu); } }
        asm volatile("s_waitcnt lgkmcnt(0)" ::: "memory");
#pragma unroll
        for (int i = 0; i < 4; ++i) { const int row = i * 8 + (ln >> 3), ch = ln & 7;
          const u32x4 v = *(const u32x4*)(stg + row * 64 + ch * 8);
          const size_t off = ((size_t)(wid * QBLK + row) * OSTR + half * 64 + ch * 8) * 2;
          const u32x4 z = *(const u32x4*)(zbase + (size_t)hm16(wid * QBLK + row, half * 64 + ch * 8) * 2); u32x4 w;
#define MUL2(a_, b_) cvtpk(__uint_as_float((a_) << 16) * __uint_as_float((b_) << 16), __uint_as_float((a_) & 0xffff0000u) * __uint_as_float((b_) & 0xffff0000u))
          w.x = MUL2(v.x, z.x); w.y = MUL2(v.y, z.y); w.z = MUL2(v.z, z.z); w.w = MUL2(v.w, z.w);
#undef MUL2
          *(u32x4*)(obase + off) = w; }
        asm volatile("s_waitcnt lgkmcnt(0)" ::: "memory");
      } }
    if constexpr (F32) {
#pragma unroll
        for (int d0 = 0; d0 < 8; ++d0) S.qr[d0] = pack8(S.tq[2 * d0], S.tq[2 * d0 + 1]); }
    __syncthreads();
#undef RESC
#undef KBASE
#undef BL
#undef ACT
#undef MASKT
#undef SEAM_K0
#undef HALF_STEP
}
#undef ROW
#undef VMW
#undef VMWN
#undef SLOAD_H
#undef SWRITE_HK
#undef SWRITE_HV
#undef SWRITE_H
#undef SLOAD_F
#undef SWRITE_KF
#undef SWRITE_VF

}
#define LAS __attribute__((address_space(3)))
typedef unsigned short bf16_t;
typedef short bf16x8 __attribute__((ext_vector_type(8)));
typedef float f32x4 __attribute__((ext_vector_type(4)));
typedef float f32x16 __attribute__((ext_vector_type(16)));
typedef unsigned u32x4 __attribute__((ext_vector_type(4)));
typedef unsigned u32x2 __attribute__((ext_vector_type(2)));

constexpr int DM = 2048, NB = 2, SEQ = 4096, T = NB * SEQ, NH = 16, HD = 128, NG = 128;
constexpr float EPS = 1e-6f;
constexpr size_t MiB = 1u << 20;
constexpr size_t WS_WIN = 0, WS_WGLU = 16 * MiB, WS_WOUT = 24 * MiB, WS_WCAT = 32 * MiB, WS_WFO = 64 * MiB;
constexpr size_t WS_S0 = 72 * MiB;
constexpr size_t WS_S1 = 104 * MiB;
constexpr size_t WS_S2 = 136 * MiB;
constexpr size_t WS_S3 = 168 * MiB;
constexpr size_t WS_S4 = 200 * MiB;
constexpr size_t WS_MISC = 232 * MiB;
constexpr size_t MISC_RSTD0 = 0, MISC_RSTD1 = 32768, MISC_LOGF = 65536, MISC_WFT = 65536 + 524288, MISC_CTL = 65536 + 524288 + 65536  , MISC_SLOTS = MISC_CTL + 65536  ;
constexpr int LDS_TOTAL = 147456;
constexpr int ATT_BIAS_OFF = 69632;
constexpr int ATT_WTOT_OFF = ATT_BIAS_OFF + 16384;

struct Params { const float* in[20]; float* out; unsigned char* ws; int ph_lo, ph_hi; };

__device__ __forceinline__ int mk_tid(int wv_s) { int t = wv_s * 64 + (int)__lane_id(); asm volatile("" : "+v"(t)); return t; }
__device__ __forceinline__ unsigned cvtpk(float lo, float hi) { unsigned r; asm volatile("v_cvt_pk_bf16_f32 %0, %1, %2" : "=v"(r) : "v"(lo), "v"(hi)); return r; }
__device__ __forceinline__ float bflo(unsigned w) { return __uint_as_float(w << 16); }
__device__ __forceinline__ float bfhi(unsigned w) { return __uint_as_float(w & 0xffff0000u); }
__device__ __forceinline__ float sigmoidf_(float v) { return __builtin_amdgcn_rcpf(1.f + __expf(-v)); }
__device__ __forceinline__ float wave_sum(float v) {
#pragma unroll
    for (int o = 1; o < 64; o <<= 1) v += __shfl_xor(v, o);
    return v;
}
__device__ __forceinline__ void store8(bf16_t* dst, f32x4 a, f32x4 b) {
    u32x4 w; w.x = cvtpk(a[0], a[1]); w.y = cvtpk(a[2], a[3]); w.z = cvtpk(b[0], b[1]); w.w = cvtpk(b[2], b[3]);
    *(u32x4*)dst = w;
}

__device__ __forceinline__ void transpose_item(const float* W, int ldw, bf16_t* WT, int row_off, const float* gk, LAS float* scr, int nblk, int item, int lane) {
    const int kb = item / nblk, nb = item % nblk, k0 = 64 * kb, n0 = 32 * nb;
    float wv_[32], gv_[32];
    const float* wp = W + (size_t)(k0 + (lane >> 5)) * ldw + n0 + (lane & 31);
#pragma unroll
    for (int i = 0; i < 32; ++i) wv_[i] = __builtin_nontemporal_load(wp + (size_t)(2 * i) * ldw);
    if (gk) {
#pragma unroll
        for (int i = 0; i < 32; ++i) gv_[i] = gk[k0 + 2 * i + (lane >> 5)];
#pragma unroll
        for (int i = 0; i < 32; ++i) wv_[i] *= gv_[i];
    }
#pragma unroll
    for (int i = 0; i < 32; ++i) scr[(2 * i + (lane >> 5)) * 33 + (lane & 31)] = wv_[i];
    asm volatile("s_waitcnt lgkmcnt(0)" ::: "memory");
    const int c = lane & 7;
#pragma unroll
    for (int j = 0; j < 4; ++j) { const int n = (lane >> 3) + 8 * j; const LAS float* s = scr + (8 * c) * 33 + n;
        u32x4 o; o.x = cvtpk(s[0 * 33], s[1 * 33]); o.y = cvtpk(s[2 * 33], s[3 * 33]); o.z = cvtpk(s[4 * 33], s[5 * 33]); o.w = cvtpk(s[6 * 33], s[7 * 33]);
        *(u32x4*)(WT + (size_t)(row_off + n0 + n) * DM + k0 + 8 * c) = o; }
    asm volatile("s_waitcnt lgkmcnt(0)" ::: "memory");
}
__device__ __forceinline__ void titem_load(const float* W, int ldw, int nblk, int item, int lane, float (&cv)[32]) {
    const int kb = item / nblk, nb = item % nblk, k0 = 64 * kb, n0 = 32 * nb;
    const float* wp = W + (size_t)(k0 + (lane >> 5)) * ldw + n0 + (lane & 31);
#pragma unroll
    for (int i = 0; i < 32; ++i) cv[i] = __builtin_nontemporal_load(wp + (size_t)(2 * i) * ldw);
}
__device__ __forceinline__ void titem_store(bf16_t* WT, int row_off, const float* gk, int nblk, int item, int lane, LAS float* scr, const float (&cv)[32]) {
    const int kb = item / nblk, nb = item % nblk, k0 = 64 * kb, n0 = 32 * nb;
#pragma unroll
    for (int i = 0; i < 32; ++i) scr[(2 * i + (lane >> 5)) * 33 + (lane & 31)] = cv[i];
    asm volatile("s_waitcnt lgkmcnt(0)" ::: "memory");
    const int c = lane & 7;
    f32x4 g0 = {1.f, 1.f, 1.f, 1.f}, g1 = {1.f, 1.f, 1.f, 1.f};
    if (gk) { g0 = *(const f32x4*)(gk + k0 + 8 * c); g1 = *(const f32x4*)(gk + k0 + 8 * c + 4); }
#pragma unroll
    for (int j = 0; j < 4; ++j) { const int n = (lane >> 3) + 8 * j; const LAS float* s = scr + (8 * c) * 33 + n;
        u32x4 o; o.x = cvtpk(s[0 * 33] * g0[0], s[1 * 33] * g0[1]); o.y = cvtpk(s[2 * 33] * g0[2], s[3 * 33] * g0[3]); o.z = cvtpk(s[4 * 33] * g1[0], s[5 * 33] * g1[1]); o.w = cvtpk(s[6 * 33] * g1[2], s[7 * 33] * g1[3]);
        *(u32x4*)(WT + (size_t)(row_off + n0 + n) * DM + k0 + 8 * c) = o; }
    asm volatile("s_waitcnt lgkmcnt(0)" ::: "memory");
}
#define P0_DECODE(S, it_) int r##S = (it_); const float* W##S; int ldw##S, roff##S, nblk##S; bf16_t* WT##S; const float* gk##S; \
    if (r##S < I_IN) { W##S = w3; ldw##S = 4096; WT##S = (bf16_t*)(ws + WS_WIN); roff##S = 0; gk##S = g1p; nblk##S = 128; } \
    else if (r##S < I_IN + I_SQ) { r##S -= I_IN; W##S = w12; ldw##S = 2048; WT##S = (bf16_t*)(ws + WS_WGLU); roff##S = 0; gk##S = nullptr; nblk##S = 64; } \
    else if (r##S < I_IN + 2 * I_SQ) { r##S -= I_IN + I_SQ; W##S = w14; ldw##S = 2048; WT##S = (bf16_t*)(ws + WS_WOUT); roff##S = 0; gk##S = nullptr; nblk##S = 64; } \
    else if (r##S < 2 * I_IN + 2 * I_SQ) { r##S -= I_IN + 2 * I_SQ; W##S = w16; ldw##S = 4112; WT##S = (bf16_t*)(ws + WS_WCAT); roff##S = 0; gk##S = g15; nblk##S = 128; } \
    else if (r##S < 3 * I_IN + 2 * I_SQ) { r##S -= 2 * I_IN + 2 * I_SQ; W##S = w18; ldw##S = 4096; WT##S = (bf16_t*)(ws + WS_WCAT); roff##S = 4096; gk##S = g1p + DM; nblk##S = 128; } \
    else { r##S -= 3 * I_IN + 2 * I_SQ; W##S = w19; ldw##S = 2048; WT##S = (bf16_t*)(ws + WS_WFO); roff##S = 0; gk##S = nullptr; nblk##S = 64; }
__device__ __forceinline__ void p0_phase(const Params& P, LAS unsigned char* lds, const int tid) {
    const int lane = tid & 63, wave = tid >> 6;
    LAS float* scrA = (LAS float*)(lds + wave * 16896); LAS float* scrB = scrA + 64 * 33;
    const int gw = blockIdx.x * 8 + wave, NGW = gridDim.x * 8;
    constexpr int I_IN = 32 * 128, I_SQ = 32 * 64, NIT = 3 * I_IN + 3 * I_SQ;
    unsigned char* ws = P.ws;
    const float* w3 = P.in[3]; const float* w12 = P.in[12]; const float* w14 = P.in[14]; const float* w16 = P.in[16]; const float* w18 = P.in[18]; const float* w19 = P.in[19];
    const float* g1p = P.in[1]; const float* g15 = P.in[15];
    asm("" : "+s"(w3)); asm("" : "+s"(w12)); asm("" : "+s"(w14)); asm("" : "+s"(w16)); asm("" : "+s"(w18)); asm("" : "+s"(w19)); asm("" : "+s"(g1p)); asm("" : "+s"(g15));
    for (int it = gw; it < NIT; it += 2 * NGW) {
        const bool hasB = it + NGW < NIT;
        P0_DECODE(A, it); P0_DECODE(B, hasB ? it + NGW : it);
        float ca[32], cb[32];
        titem_load(WA, ldwA, nblkA, rA, lane, ca);
        titem_load(WB, ldwB, nblkB, rB, lane, cb);
        titem_store(WTA, roffA, gkA, nblkA, rA, lane, scrA, ca);
        if (hasB) titem_store(WTB, roffB, gkB, nblkB, rB, lane, scrB, cb);
    }
    { bf16_t* wfT = (bf16_t*)(ws + WS_MISC + MISC_WFT); const float* kvw = P.in[16]; const float* gkv = P.in[15];
      for (int i = blockIdx.x * 512 + tid; i < 16 * DM; i += gridDim.x * 512) { const int c = i >> 11, k = i & 2047;
          const float v = gkv[k] * kvw[(size_t)k * 4112 + 4096 + c]; wfT[i] = (bf16_t)(cvtpk(v, v) & 0xffffu); } }
    { const float* x = P.in[0]; bf16_t* xb = (bf16_t*)(ws + WS_S3); float* rstd0 = (float*)(ws + WS_MISC + MISC_RSTD0);
      for (int m = gw; m < T; m += 2 * NGW) {
          const int m1 = (m + NGW < T) ? m + NGW : m;
          const f32x4* xr0 = (const f32x4*)(x + (size_t)m * DM) + lane; const f32x4* xr1 = (const f32x4*)(x + (size_t)m1 * DM) + lane; f32x4 v0[8], v1[8]; float s0 = 0.f, s1 = 0.f;
#pragma unroll
          for (int j = 0; j < 8; ++j) v0[j] = __builtin_nontemporal_load(xr0 + 64 * j);
#pragma unroll
          for (int j = 0; j < 8; ++j) v1[j] = __builtin_nontemporal_load(xr1 + 64 * j);
#pragma unroll
          for (int j = 0; j < 8; ++j) { s0 += (v0[j][0] * v0[j][0] + v0[j][1] * v0[j][1]) + (v0[j][2] * v0[j][2] + v0[j][3] * v0[j][3]); s1 += (v1[j][0] * v1[j][0] + v1[j][1] * v1[j][1]) + (v1[j][2] * v1[j][2] + v1[j][3] * v1[j][3]); }
          const float rs0 = rsqrtf(wave_sum(s0) * (1.f / DM) + EPS), rs1 = rsqrtf(wave_sum(s1) * (1.f / DM) + EPS);
          if (lane == 0) { rstd0[m] = 1.f / rs0; rstd0[m1] = 1.f / rs1; }
          u32x2* o0 = (u32x2*)(xb + (size_t)m * DM) + lane; u32x2* o1 = (u32x2*)(xb + (size_t)m1 * DM) + lane;
#pragma unroll
          for (int j = 0; j < 8; ++j) { v0[j] = v0[j] * rs0; v1[j] = v1[j] * rs1; u32x2 w; w.x = cvtpk(v0[j][0], v0[j][1]); w.y = cvtpk(v0[j][2], v0[j][3]); o0[64 * j] = w; u32x2 w1; w1.x = cvtpk(v1[j][0], v1[j][1]); w1.y = cvtpk(v1[j][2], v1[j][3]); o1[64 * j] = w1; }
      } }
}

__device__ __forceinline__ size_t sz_off(int row, int c) { return ((size_t)((row >> 4) * 64 + (c >> 5)) << 9) + ((((row & 15) * 4 + ((c >> 3) & 3))) << 3); }
struct F1 {
    const float* rstd; bf16_t* ug; bf16_t* sz;
    __device__ __forceinline__ void operator()(int row, int col, f32x4 a, f32x4 b) const {
        (void)rstd;
        if (col < DM) { const int bb = row >> 12, t = row & 4095, g = col >> 4;
            store8(ug + ((size_t)(bb * NG + g) * SEQ + t) * 16 + (col & 15), a, b); }
        else {
#pragma unroll
            for (int i = 0; i < 4; ++i) { a[i] = a[i] * sigmoidf_(a[i]); b[i] = b[i] * sigmoidf_(b[i]); }
            store8(sz + sz_off(row, col - DM), a, b); }
    }
};
struct F2 {
    const float* bias; const bf16_t* y1; const bf16_t* sz; bf16_t* y2;
    __device__ __forceinline__ void operator()(int row, int col, f32x4 a, f32x4 b) const {
        const f32x4 b0 = *(const f32x4*)(bias + col), b1 = *(const f32x4*)(bias + col + 4);
        const u32x4 yv = *(const u32x4*)(y1 + (size_t)row * DM + col), zv = *(const u32x4*)(sz + sz_off(row, col));
        a = a + b0; b = b + b1;
        f32x4 oa, ob;
        oa[0] = bflo(yv.x) * sigmoidf_(a[0]) * bflo(zv.x); oa[1] = bfhi(yv.x) * sigmoidf_(a[1]) * bfhi(zv.x);
        oa[2] = bflo(yv.y) * sigmoidf_(a[2]) * bflo(zv.y); oa[3] = bfhi(yv.y) * sigmoidf_(a[3]) * bfhi(zv.y);
        ob[0] = bflo(yv.z) * sigmoidf_(b[0]) * bflo(zv.z); ob[1] = bfhi(yv.z) * sigmoidf_(b[1]) * bfhi(zv.z);
        ob[2] = bflo(yv.w) * sigmoidf_(b[2]) * bflo(zv.w); ob[3] = bfhi(yv.w) * sigmoidf_(b[3]) * bfhi(zv.w);
        store8(y2 + (size_t)row * DM + col, oa, ob);
    }
};
struct F3 {
    bf16_t* o;
    __device__ __forceinline__ void operator()(int row, int col, f32x4 a, f32x4 b) const { store8(o + (size_t)row * DM + col, a, b); }
};
struct F4 {
    const float* rstd; bf16_t* kb; bf16_t* vb; bf16_t* qb; bf16_t* sz2;
    __device__ __forceinline__ void operator()(int row, int col, f32x4 a, f32x4 b) const {
        (void)rstd;
        const int sec = col >> 11, c = col & 2047;
        if (sec == 3) {
#pragma unroll
            for (int i = 0; i < 4; ++i) { a[i] = a[i] * sigmoidf_(a[i]); b[i] = b[i] * sigmoidf_(b[i]); } }
        const int bb = row >> 12, t = row & 4095, hh = c >> 7, d = c & 127;
        store8(kb + (size_t)sec * (16u << 20) + ((size_t)(bb * NH + hh) * SEQ) * HD + attn::hm16(t, d), a, b);
    }
};

#ifndef SSM_PF_U
#define SSM_PF_U 1
#endif
__device__ __forceinline__ void sincos_small(float x, float& s, float& c) {
    const float k = rintf(x * 0.63661977236758134f);
    float r = fmaf(-k, 1.57079625129699707031f, x); r = fmaf(-k, 7.54978941586159635335e-08f, r);
    const float r2 = r * r;
    const float sp = r + r * r2 * (-1.6666666666666666e-1f + r2 * (8.3333333333333332e-3f + r2 * (-1.9841269841269841e-4f + r2 * 2.7557319223985893e-6f)));
    const float cp = 1.f + r2 * (-0.5f + r2 * (4.1666666666666664e-2f + r2 * (-1.3888888888888889e-3f + r2 * (2.4801587301587302e-5f + r2 * -2.7557319223985888e-7f))));
    const int q = (int)k & 3;
    s = (q == 0) ? sp : (q == 1) ? cp : (q == 2) ? -sp : -cp;
    c = (q == 0) ? cp : (q == 1) ? -sp : (q == 2) ? -cp : sp;
}
__device__ __forceinline__ float gelu_tanh(float x) { const float u = 1.5957691216057308f * (x + 0.044715f * x * x * x); return x * sigmoidf_(u); }
__device__ __forceinline__ void ssm_phase(const Params& P, LAS unsigned char* lds, const int tid) {
    const int wv = __builtin_amdgcn_readfirstlane(tid >> 6);
    const float* a_re = P.in[4]; const float* a_im = P.in[5]; const float* log_dt = P.in[6]; const float* b_re = P.in[7]; const float* b_im = P.in[8];
    const float* c_re = P.in[9]; const float* c_im = P.in[10]; const float* dsk = P.in[11];
    const bf16_t* ug = (const bf16_t*)(P.ws + WS_S1); bf16_t* y1 = (bf16_t*)(P.ws + WS_S0);
    LAS float* Sst = (LAS float*)lds;
    LAS unsigned char* img = lds + 8192 + wv * 8704;
    for (int bg = blockIdx.x; bg < NB * NG; bg += gridDim.x) {
        int lane = tid & 63; asm volatile("" : "+v"(lane));
        const int n = lane & 31, hi = lane >> 5, l15 = lane & 15, kq = lane >> 4;
        const int b = bg >> 7, g = bg & 127;
        const float dt = expf(log_dt[g]);
        float abr[2], abi[2], qr_[2], qi_[2]; bf16x8 Bf[4];
#pragma unroll
        for (int ph = 0; ph < 2; ++ph) {
            const int p = ph * 32 + n; const float ar = a_re[g * 64 + p], ai = a_im[g * 64 + p];
            const float mag = expf(ar * dt); float cs, sn; sincos_small(ai * dt, sn, cs);
            abr[ph] = mag * cs; abi[ph] = mag * sn;
            const float den = ar * ar + ai * ai, nr = abr[ph] - 1.f;
            const float cr = (nr * ar + abi[ph] * ai) / den, ci = (abi[ph] * ar - nr * ai) / den;
            float pr = abr[ph], pi = abi[ph];
#pragma unroll
            for (int i = 0; i < 8; ++i) { const float t2 = pr * pr - pi * pi; pi = 2.f * pr * pi; pr = t2; }
            qr_[ph] = pr; qi_[ph] = pi;
            const float* brp = b_re + ((size_t)(g * 64 + p) * 16 + 8 * hi); const float* bip = b_im + ((size_t)(g * 64 + p) * 16 + 8 * hi);
            const f32x4 r0 = *(const f32x4*)brp, r1 = *(const f32x4*)(brp + 4), i0 = *(const f32x4*)bip, i1 = *(const f32x4*)(bip + 4);
            const f32x4 xr0 = r0 * cr - i0 * ci, xr1 = r1 * cr - i1 * ci, xi0 = i0 * cr + r0 * ci, xi1 = i1 * cr + r1 * ci;
            u32x4 wr_, wi_; wr_.x = cvtpk(xr0[0], xr0[1]); wr_.y = cvtpk(xr0[2], xr0[3]); wr_.z = cvtpk(xr1[0], xr1[1]); wr_.w = cvtpk(xr1[2], xr1[3]);
            wi_.x = cvtpk(xi0[0], xi0[1]); wi_.y = cvtpk(xi0[2], xi0[3]); wi_.z = cvtpk(xi1[0], xi1[1]); wi_.w = cvtpk(xi1[2], xi1[3]);
            Bf[ph * 2 + 0] = __builtin_bit_cast(bf16x8, wr_); Bf[ph * 2 + 1] = __builtin_bit_cast(bf16x8, wi_);
        }
        bf16x8 Cf[4], Df;
#pragma unroll
        for (int kk = 0; kk < 4; ++kk) {
            const f32x4 cr4 = *(const f32x4*)(c_re + (size_t)(g * 16 + l15) * 64 + kk * 16 + 4 * kq), ci4 = *(const f32x4*)(c_im + (size_t)(g * 16 + l15) * 64 + kk * 16 + 4 * kq);
            u32x4 w; w.x = cvtpk(cr4[0], -ci4[0]); w.y = cvtpk(cr4[1], -ci4[1]); w.z = cvtpk(cr4[2], -ci4[2]); w.w = cvtpk(cr4[3], -ci4[3]);
            Cf[kk] = __builtin_bit_cast(bf16x8, w);
        }
        { const float dv = dsk[g * 16 + l15]; float e[8];
#pragma unroll
          for (int j = 0; j < 8; ++j) e[j] = (kq < 2 && 8 * kq + j == l15) ? dv : 0.f;
          u32x4 w; w.x = cvtpk(e[0], e[1]); w.y = cvtpk(e[2], e[3]); w.z = cvtpk(e[4], e[5]); w.w = cvtpk(e[6], e[7]); Df = __builtin_bit_cast(bf16x8, w); }
        const bf16_t* ugb = ug + (size_t)bg * SEQ * 16;
        bf16_t* y1b = y1 + (size_t)b * SEQ * DM + g * 16;
        const int sm = (n >> 2) & 1, jm = (n & 3) + 4 * (n >> 3);
        float Hr[2] = {0.f, 0.f}, Hi[2] = {0.f, 0.f};
        for (int pass = 0; pass < 2; ++pass) {
            float hr[2] = {Hr[0], Hr[1]}, hi_[2] = {Hi[0], Hi[1]};
            const char* ugc = (const char*)ugb;
            const unsigned offA = (unsigned)(((wv * 2 + sm) * 256 + jm) * 16 + 8 * hi) * 2u;
            const unsigned offU = (unsigned)((wv * 2 * 256 + l15) * 16 + 8 * (kq & 1)) * 2u;
            bf16x8 Afn = *(const bf16x8*)(ugc + offA);
            for (int step = 0; step < 16; ++step) {
                const bf16x8 Af = Afn;
                if (step < 15) Afn = *(const bf16x8*)(ugc + (offA + (unsigned)(step + 1) * 512u));
#if SSM_PF_U
                bf16x8 Au0 = {0, 0, 0, 0, 0, 0, 0, 0}, Au1 = {0, 0, 0, 0, 0, 0, 0, 0};
                if (pass == 1 && kq < 2) { Au0 = *(const bf16x8*)(ugc + (offU + (unsigned)step * 512u)); Au1 = *(const bf16x8*)(ugc + (offU + 8192u + (unsigned)step * 512u)); }
#endif
                f32x16 x[4];
#pragma unroll
                for (int f = 0; f < 4; ++f) { f32x16 z16 = {}; x[f] = __builtin_amdgcn_mfma_f32_32x32x16_bf16(Af, Bf[f], z16, 0, 0, 0); }
                __builtin_amdgcn_sched_barrier(0);
#pragma unroll
                for (int r = 0; r < 16; ++r)
#pragma unroll
                    for (int ph = 0; ph < 2; ++ph) {
                        float t0 = fmaf(-abi[ph], hi_[ph], x[2 * ph][r]), t1 = fmaf(abi[ph], hr[ph], x[2 * ph + 1][r]);
                        asm("" : "+v"(t0)); asm("" : "+v"(t1));
                        float nr_ = fmaf(abr[ph], hr[ph], t0), ni_ = fmaf(abr[ph], hi_[ph], t1);
                        asm("" : "+v"(nr_)); asm("" : "+v"(ni_));
                        hr[ph] = nr_; hi_[ph] = ni_; x[2 * ph][r] = nr_; x[2 * ph + 1][r] = ni_;
                    }
                __builtin_amdgcn_sched_barrier(0);
                if (pass == 1) {
#pragma unroll
                    for (int ph = 0; ph < 2; ++ph)
#pragma unroll
                        for (int r = 0; r < 16; ++r) *(LAS unsigned*)(img + (hi * 16 + r) * 272 + (ph * 32 + n) * 4) = cvtpk(x[2 * ph][r], x[2 * ph + 1][r]);
                    asm volatile("s_waitcnt lgkmcnt(0)" ::: "memory");
#pragma unroll
                    for (int s2 = 0; s2 < 2; ++s2) {
                        __builtin_amdgcn_sched_barrier(0);
                        f32x4 acc = {0.f, 0.f, 0.f, 0.f};
#pragma unroll
                        for (int kk = 0; kk < 4; ++kk) { const bf16x8 Ah = *(const LAS bf16x8*)(img + (s2 * 16 + l15) * 272 + kk * 64 + kq * 16);
                            acc = __builtin_amdgcn_mfma_f32_16x16x32_bf16(Ah, Cf[kk], acc, 0, 0, 0); }
                        const int tokb = (wv * 2 + s2) * 256 + step * 16;
#if SSM_PF_U
                        acc = __builtin_amdgcn_mfma_f32_16x16x32_bf16(s2 ? Au1 : Au0, Df, acc, 0, 0, 0);
#else
                        { bf16x8 Au = {0, 0, 0, 0, 0, 0, 0, 0}; if (kq < 2) Au = *(const bf16x8*)(ugc + (offU + (unsigned)s2 * 8192u + (unsigned)step * 512u));
                          acc = __builtin_amdgcn_mfma_f32_16x16x32_bf16(Au, Df, acc, 0, 0, 0); }
#endif
#pragma unroll
                        for (int i = 0; i < 4; ++i) { const float yv = gelu_tanh(acc[i]); const int t = tokb + 4 * kq + i;
                            *(bf16_t*)((char*)y1b + ((unsigned)t * (unsigned)DM + (unsigned)l15) * 2u) = (bf16_t)(cvtpk(yv, yv) & 0xffffu); }
                    }
                    asm volatile("s_waitcnt lgkmcnt(0)" ::: "memory");
                }
            }
            if (pass == 0) {
                const int seg = wv * 2 + hi;
#pragma unroll
                for (int ph = 0; ph < 2; ++ph) { Sst[(seg * 64 + ph * 32 + n) * 2 + 0] = hr[ph]; Sst[(seg * 64 + ph * 32 + n) * 2 + 1] = hi_[ph]; }
                __syncthreads();
#pragma unroll
                for (int ph = 0; ph < 2; ++ph) { float cr_ = 0.f, ci_ = 0.f;
#pragma nounroll
                    for (int v = 0; v < 15; ++v) { if (v < seg) { const float sr = Sst[(v * 64 + ph * 32 + n) * 2 + 0], si = Sst[(v * 64 + ph * 32 + n) * 2 + 1];
                        const float t2 = qr_[ph] * cr_ - qi_[ph] * ci_ + sr; ci_ = qr_[ph] * ci_ + qi_[ph] * cr_ + si; cr_ = t2; } }
                    Hr[ph] = cr_; Hi[ph] = ci_; }
                __syncthreads();
            }
        }
    }
}

template <bool FIRST> __device__ __forceinline__ void row_phase(const Params& P, const int tid) {
    const int lane = tid & 63, wave = tid >> 6;
    const int gw = blockIdx.x * 8 + wave, NGW = gridDim.x * 8;
    const bf16_t* O = (const bf16_t*)(P.ws + WS_S3); const float* X = FIRST ? P.in[0] : P.out; float* OUT = P.out;
    const float* gp = P.in[2] + (FIRST ? 0 : DM);
    float* rstd1 = (float*)(P.ws + WS_MISC + MISC_RSTD1); bf16_t* h1b = (bf16_t*)(P.ws + WS_S0);
    for (int m = gw; m < T; m += NGW) {
        const u32x2* orow = (const u32x2*)(O + (size_t)m * DM) + lane; const f32x4* xrow = (const f32x4*)(X + (size_t)m * DM) + lane; f32x4* outr = (f32x4*)(OUT + (size_t)m * DM) + lane;
        f32x4 o[8]; float ss = 0.f;
#pragma unroll
        for (int j = 0; j < 8; ++j) { const u32x2 w = orow[64 * j]; o[j] = (f32x4){bflo(w.x), bfhi(w.x), bflo(w.y), bfhi(w.y)}; ss += (o[j][0] * o[j][0] + o[j][1] * o[j][1]) + (o[j][2] * o[j][2] + o[j][3] * o[j][3]); }
        const float rs = rsqrtf(wave_sum(ss) * (1.f / DM) + EPS);
        float ss1 = 0.f;
#pragma unroll
        for (int j = 0; j < 8; ++j) { const f32x4 g4 = ((const f32x4*)gp)[lane + 64 * j]; const f32x4 xv = xrow[64 * j]; o[j] = xv + o[j] * rs * g4; outr[64 * j] = o[j];
            ss1 += (o[j][0] * o[j][0] + o[j][1] * o[j][1]) + (o[j][2] * o[j][2] + o[j][3] * o[j][3]); }
        if (FIRST) {
            const float r1 = rsqrtf(wave_sum(ss1) * (1.f / DM) + EPS);
            if (lane == 0) rstd1[m] = r1;
            u32x2* o8 = (u32x2*)(h1b + (size_t)m * DM) + lane;
#pragma unroll
            for (int j = 0; j < 8; ++j) { u32x2 w; w.x = cvtpk(o[j][0], o[j][1]); w.y = cvtpk(o[j][2], o[j][3]); o8[64 * j] = w; }
        }
    }
}

__device__ __forceinline__ void logf_phase(const Params& P, LAS unsigned char* lds, const int tid) {
    const int lane = tid & 63, wv = __builtin_amdgcn_readfirstlane(tid >> 6), l15 = lane & 15, kq = lane >> 4;
    const bf16_t* h1b = (const bf16_t*)(P.ws + WS_S0); const bf16_t* wfT = (const bf16_t*)(P.ws + WS_MISC + MISC_WFT);
    const float* rstd1 = (const float*)(P.ws + WS_MISC + MISC_RSTD1); const float* bfv = P.in[17]; float* logf = (float*)(P.ws + WS_MISC + MISC_LOGF);
    LAS float* part = (LAS float*)lds;
    for (int rt = blockIdx.x; rt < T / 16; rt += 2 * gridDim.x) {
        const int rt1 = (rt + (int)gridDim.x < T / 16) ? rt + (int)gridDim.x : rt;
        f32x4 acc0 = {0.f, 0.f, 0.f, 0.f}, acc1 = {0.f, 0.f, 0.f, 0.f};
#pragma unroll
        for (int ks = 0; ks < 8; ++ks) { const int k = wv * 256 + ks * 32 + 8 * kq;
            const bf16x8 Bfr = *(const bf16x8*)(wfT + (size_t)l15 * DM + k);
            const bf16x8 A0 = *(const bf16x8*)(h1b + (size_t)(rt * 16 + l15) * DM + k), A1 = *(const bf16x8*)(h1b + (size_t)(rt1 * 16 + l15) * DM + k);
            acc0 = __builtin_amdgcn_mfma_f32_16x16x32_bf16(A0, Bfr, acc0, 0, 0, 0); acc1 = __builtin_amdgcn_mfma_f32_16x16x32_bf16(A1, Bfr, acc1, 0, 0, 0); }
#pragma unroll
        for (int i = 0; i < 4; ++i) { part[(wv * 16 + 4 * kq + i) * 16 + l15] = acc0[i]; part[2048 + (wv * 16 + 4 * kq + i) * 16 + l15] = acc1[i]; }
        __syncthreads();
        { const int tl = tid >> 8, row = (tid >> 4) & 15, c = tid & 15; float s = 0.f;
#pragma unroll
          for (int w = 0; w < 8; ++w) s += part[tl * 2048 + (w * 16 + row) * 16 + c];
          const int grow = (tl ? rt1 : rt) * 16 + row; const float f = s + bfv[c]; (void)rstd1;
          const float lf = fminf(f, 0.f) - log1pf(expf(-fabsf(f)));
          logf[((size_t)((grow >> 12) * NH + c)) * SEQ + (grow & 4095)] = lf; }
        __syncthreads();
    }
}

__device__ __forceinline__ void attn_bias_fill(const f32x4 a, const f32x4 c, char* ldsg, const int tid) {
    const int lane = tid & 63, wv = tid >> 6;
    float* bias = (float*)(ldsg + ATT_BIAS_OFF); float* wtot = (float*)(ldsg + ATT_WTOT_OFF);
    float v[8]; v[0] = a[0]; v[1] = v[0] + a[1]; v[2] = v[1] + a[2]; v[3] = v[2] + a[3]; v[4] = v[3] + c[0]; v[5] = v[4] + c[1]; v[6] = v[5] + c[2]; v[7] = v[6] + c[3];
    float sc = v[7];
#pragma unroll
    for (int off = 1; off < 64; off <<= 1) { const float t = __shfl_up(sc, off); if (lane >= off) sc += t; }
    if (lane == 63) wtot[wv] = sc;
    __syncthreads();
    float base = sc - v[7];
    for (int w = 0; w < wv; ++w) base += wtot[w];
    constexpr float INV = -1.f / attn::SCALE;
    f32x4 o0, o1;
    o0[0] = (base + v[0]) * INV; o0[1] = (base + v[1]) * INV; o0[2] = (base + v[2]) * INV; o0[3] = (base + v[3]) * INV;
    o1[0] = (base + v[4]) * INV; o1[1] = (base + v[5]) * INV; o1[2] = (base + v[6]) * INV; o1[3] = (base + v[7]) * INV;
    *(f32x4*)(bias + tid * 8) = o0; *(f32x4*)(bias + tid * 8 + 4) = o1;
    __syncthreads();
}
__device__ __forceinline__ void attn_phase(const Params& P, char* ldsg, const int wv_s) {
    typedef attn::bf16 abf; typedef attn::BlockRef<abf, abf> Ref;
    const abf* Q = (const abf*)(P.ws + WS_S3); const abf* K = (const abf*)(P.ws + WS_S1); const abf* V = (const abf*)(P.ws + WS_S2);
    const bf16_t* Z = (const bf16_t*)(P.ws + WS_S4); abf* AO = (abf*)(P.ws + WS_WIN);
    const float* logf = (const float*)(P.ws + WS_MISC + MISC_LOGF);
    constexpr int NQB = SEQ / 256, NX = NQB / 2, TOTAL = NX * NB * NH;
    const int G = gridDim.x;
    const int L = blockIdx.x;
    if (L >= TOTAL) return;
#define MKREF(r, L_, pass_) do { const int bh_ = (L_) / NX, x_ = (L_) % NX, qb_ = (pass_) ? NQB - 1 - x_ : x_, b_ = bh_ / NH, h_ = bh_ % NH; \
        (r).Q = Q + ((size_t)bh_ * SEQ + (size_t)qb_ * 256) * HD; (r).K = K + (size_t)bh_ * SEQ * HD; (r).V = V + (size_t)bh_ * SEQ * HD; \
        (r).O = AO + ((size_t)b_ * SEQ + (size_t)qb_ * 256) * DM + h_ * HD; (r).Z = Z + ((size_t)bh_ * SEQ + (size_t)qb_ * 256) * HD; (r).P0 = qb_ * 256; } while (0)
    {
        const int tid0 = mk_tid(wv_s); const float* lf = logf + (size_t)(L / NX) * SEQ;
        const f32x4 lfa = *(const f32x4*)(lf + tid0 * 8), lfc = *(const f32x4*)(lf + tid0 * 8 + 4);
        Ref lightb, heavyb; MKREF(lightb, L, 0); MKREF(heavyb, L, 1);
        attn::Seam<abf> S;
        attn::causal_swa_prime<abf, abf>(lightb, SEQ, ldsg, S, mk_tid(wv_s));
        attn_bias_fill(lfa, lfc, ldsg, mk_tid(wv_s));
        for (int pass = 0; pass < 2; ++pass) {
            Ref cur = heavyb; if (pass == 0) cur = lightb;
            attn::causal_swa_block<abf, abf>(cur, heavyb, SEQ, SEQ, ldsg, S, mk_tid(wv_s));
        }
    }
#undef MKREF
}

#define XB_TMO      128
#define XB_XCNT(j)  (256  + 64 * (j))
#define XB_XSUB(j)  (1280 + 64 * (j))
#define XB_XGEN(j)  (2304 + 64 * (j))
#define XB_TOP      3328
#define XB_TOPGEN   3392
#define XCD_BAR_WORDS 3456
#define XB_SPIN_CAP (1u << 18)

__device__ __forceinline__ unsigned xb_ld(unsigned* p)              { return __hip_atomic_load(p, __ATOMIC_RELAXED, __HIP_MEMORY_SCOPE_AGENT); }
__device__ __forceinline__ unsigned xb_add(unsigned* p, unsigned v) { return __hip_atomic_fetch_add(p, v, __ATOMIC_RELAXED, __HIP_MEMORY_SCOPE_AGENT); }
__device__ __forceinline__ unsigned xb_xcc_id() { return (unsigned)__builtin_amdgcn_s_getreg((3 << 11) | 20) & 0xFu; }
#define XB_SPIN(cond, bar) do { unsigned _sp = 0; while (cond) { __builtin_amdgcn_s_sleep(1); \
    if ((++_sp & 255u) == 0u) { if (xb_ld(&(bar)[XB_TMO])) break; if (_sp > XB_SPIN_CAP) { atomicAdd(&(bar)[XB_TMO], 1u); break; } } } } while (0)

struct XcdBarrier {
    unsigned* bar; unsigned x;
    volatile LAS unsigned* st;
};

__device__ __forceinline__ XcdBarrier xcd_barrier_post(unsigned* bar, volatile LAS unsigned* st, int tid) {
    XcdBarrier b; b.bar = bar; b.x = xb_xcc_id(); b.st = st;
    if (tid == 0) (void)xb_add(&bar[XB_XCNT(b.x)], 1u);
    return b;
}
__device__ __forceinline__ void xcd_barrier_complete(unsigned* bar, unsigned x, unsigned& nloc, unsigned& nx) {
    const unsigned G = gridDim.x * gridDim.y * gridDim.z;
    unsigned sum, cnt, mine, sp = 0u;
    for (;;) {
        sum = 0u; cnt = 0u; mine = 0u;
#pragma unroll
        for (unsigned j = 0; j < 16; ++j) { const unsigned c = xb_ld(&bar[XB_XCNT(j)]); sum += c; cnt += (c > 0u) ? 1u : 0u; mine = (j == x) ? c : mine; }
        if (sum == G) break;
        __builtin_amdgcn_s_sleep(1);
        if ((++sp & 255u) == 0u) { if (xb_ld(&bar[XB_TMO])) break; if (sp > XB_SPIN_CAP) { atomicAdd(&bar[XB_TMO], 1u); break; } }
    }
    nloc = mine > 0u ? mine : 1u; nx = cnt > 0u ? cnt : 1u;
}

__device__ __forceinline__ void xcd_barrier(const XcdBarrier& b, int tid) {
    asm volatile("s_waitcnt vmcnt(0)" ::: "memory");
    __syncthreads();
    if (tid == 0) {
        unsigned* bar = b.bar;
        __builtin_amdgcn_s_waitcnt(0);
        unsigned nloc = b.st[0], nx = b.st[1];
        if (nloc == 0u) { xcd_barrier_complete(bar, b.x, nloc, nx); b.st[0] = nloc; b.st[1] = nx; }
        const unsigned old = xb_add(&bar[XB_XSUB(b.x)], 1u);
        const unsigned gen = old / nloc;
        if (old + 1u == (gen + 1u) * nloc) {
            __builtin_amdgcn_fence(__ATOMIC_RELEASE, "agent");
            asm volatile("s_waitcnt vmcnt(0)" ::: "memory");
            const unsigned og = xb_add(&bar[XB_TOP], 1u);
            const unsigned tg = og / nx;
            if (og + 1u == (tg + 1u) * nx) xb_add(&bar[XB_TOPGEN], 1u);
            else XB_SPIN(xb_ld(&bar[XB_TOPGEN]) == tg, bar);
            __builtin_amdgcn_fence(__ATOMIC_ACQUIRE, "agent");
            asm volatile("s_waitcnt vmcnt(0)" ::: "memory");
        } else {
            XB_SPIN(xb_ld(&bar[XB_TOPGEN]) == gen, bar);
            __builtin_amdgcn_fence(__ATOMIC_ACQUIRE, "agent");
            asm volatile("s_waitcnt vmcnt(0)" ::: "memory");
        }
    }
    __syncthreads();
}

__global__ void __launch_bounds__(512, 2) yoco_fwd(Params P) {
    extern __shared__ __attribute__((aligned(16))) unsigned char lds_raw[];
    LAS unsigned char* lds = (LAS unsigned char*)lds_raw;
    cg::grid_group grid = cg::this_grid();
    const int lo = P.ph_lo, hi = P.ph_hi;
    typedef const __attribute__((address_space(4))) Params* KPtr;
    const KPtr kp0 = (KPtr)__builtin_amdgcn_kernarg_segment_ptr();
    const int wv_s = __builtin_amdgcn_readfirstlane((int)threadIdx.x >> 6);
    volatile LAS unsigned* bst = (volatile LAS unsigned*)(lds + LDS_TOTAL - 64);
    if (threadIdx.x < 2) bst[threadIdx.x] = 0u;
    __syncthreads();
    XcdBarrier bar;
    { KPtr kq_ = kp0; asm volatile("" : "+s"(kq_)); bar = xcd_barrier_post((unsigned*)(kq_->ws + WS_MISC + MISC_CTL), bst, threadIdx.x); }
    if (P.ph_hi == 0x7fffffff) grid.sync();
#define LOADP() KPtr kp_ = kp0; asm volatile("" : "+s"(kp_)); Params Q; _Pragma("unroll") for (int i_ = 0; i_ < 20; ++i_) Q.in[i_] = kp_->in[i_]; Q.out = kp_->out; Q.ws = kp_->ws; Q.ph_lo = 0; Q.ph_hi = 0; unsigned char* ws = Q.ws
#ifndef PHMASK
#define PHMASK 0x3ff
#endif
#define IN(k) (((PHMASK >> (k)) & 1) && lo <= (k) && (k) < hi)
#ifndef DUPMASK
#define DUPMASK 0
#endif
#define DUP(k) for (int rep_ = 0; rep_ < 1 + ((DUPMASK >> (k)) & 1); ++rep_)
#define SEAM(k) do { if (IN(k) && IN((k) + 1)) xcd_barrier(bar, mk_tid(wv_s)); } while (0)
    if (IN(0)) { LOADP(); (void)ws; p0_phase(Q, lds, mk_tid(wv_s)); __syncthreads(); if (DUPMASK & 1) { p0_phase(Q, lds, mk_tid(wv_s)); __syncthreads(); } } SEAM(0);
    if (IN(1)) DUP(1) { LOADP(); pg8::Gemm g{(const bf16_t*)(ws + WS_S3), (const bf16_t*)(ws + WS_WIN), T, 2 * DM, DM}; pg8::StaticOrder S; S.init(T, 2 * DM, gridDim.x, blockIdx.x);
        pg8::EpiRow8<F1> E{F1{(const float*)(ws + WS_MISC + MISC_RSTD0), (bf16_t*)(ws + WS_S1), (bf16_t*)(ws + WS_S2)}};
        pg8::gemm_phase<pg8::EpiRow8<F1>, pg8::StaticOrder, true, true>(lds, g, S, E, mk_tid(wv_s)); } SEAM(1);
    if (IN(2)) DUP(2) { LOADP(); (void)ws; ssm_phase(Q, lds, mk_tid(wv_s)); __syncthreads(); } SEAM(2);
    if (IN(3)) DUP(3) { LOADP(); pg8::Gemm g{(const bf16_t*)(ws + WS_S0), (const bf16_t*)(ws + WS_WGLU), T, DM, DM}; pg8::StaticOrder S; S.init(T, DM, gridDim.x, blockIdx.x);
        pg8::EpiRow8<F2> E{F2{Q.in[13], (const bf16_t*)(ws + WS_S0), (const bf16_t*)(ws + WS_S2), (bf16_t*)(ws + WS_S1)}};
        pg8::gemm_phase<pg8::EpiRow8<F2>, pg8::StaticOrder, true, true>(lds, g, S, E, mk_tid(wv_s)); } SEAM(3);
    if (IN(4)) DUP(4) { LOADP(); pg8::Gemm g{(const bf16_t*)(ws + WS_S1), (const bf16_t*)(ws + WS_WOUT), T, DM, DM}; pg8::StaticOrder S; S.init(T, DM, gridDim.x, blockIdx.x);
        unsigned* cnts = (unsigned*)(ws + WS_MISC + MISC_CTL + 16384); float* slots = (float*)(ws + WS_MISC + MISC_SLOTS);
        pg8::EpiNormRes<true> E{(const float*)(ws + WS_MISC + MISC_RSTD0), (const bf16_t*)(ws + WS_S3), nullptr, Q.in[2], (bf16_t*)(ws + WS_S0), pg8::RowStat{slots, cnts, nullptr}, pg8::RowStat{slots + 65536, cnts + 2048, (float*)(ws + WS_MISC + MISC_RSTD1)}};
        pg8::gemm_phase<pg8::EpiNormRes<true>, pg8::StaticOrder, false, true>(lds, g, S, E, mk_tid(wv_s)); }
    if (IN(4) && IN(6)) xcd_barrier(bar, mk_tid(wv_s));
    if (IN(6)) DUP(6) { LOADP(); logf_phase(Q, lds, mk_tid(wv_s));
        pg8::Gemm g{(const bf16_t*)(ws + WS_S0), (const bf16_t*)(ws + WS_WCAT), T, 4 * DM, DM}; pg8::StaticOrder S; S.init(T, 4 * DM, gridDim.x, blockIdx.x);
        pg8::EpiRow8<F4> E{F4{(const float*)(ws + WS_MISC + MISC_RSTD1), (bf16_t*)(ws + WS_S1), (bf16_t*)(ws + WS_S2), (bf16_t*)(ws + WS_S3), (bf16_t*)(ws + WS_S4)}};
        pg8::gemm_phase<pg8::EpiRow8<F4>, pg8::StaticOrder, true, true>(lds, g, S, E, mk_tid(wv_s)); } SEAM(6);
    if (IN(7)) { LOADP(); (void)ws; attn_phase(Q, (char*)lds_raw, wv_s); }

    if (IN(7) && IN(8)) xcd_barrier(bar, mk_tid(wv_s));
    if (IN(8)) DUP(8) { LOADP(); pg8::Gemm g{(const bf16_t*)(ws + WS_WIN), (const bf16_t*)(ws + WS_WFO), T, DM, DM}; pg8::StaticOrder S; S.init(T, DM, gridDim.x, blockIdx.x);
        unsigned* cnts = (unsigned*)(ws + WS_MISC + MISC_CTL + 16384); float* slots = (float*)(ws + WS_MISC + MISC_SLOTS);
        pg8::EpiNormRes<false> E{(const float*)(ws + WS_MISC + MISC_RSTD1), (const bf16_t*)(ws + WS_S0), Q.out, Q.in[2] + DM, nullptr, pg8::RowStat{slots + 131072, cnts + 4096, nullptr}, pg8::RowStat{nullptr, nullptr, nullptr}};
        pg8::gemm_phase<pg8::EpiNormRes<false>, pg8::StaticOrder, false, true>(lds, g, S, E, mk_tid(wv_s)); }
#undef IN
#undef SEAM
#undef LOADP
}

#ifndef N_LAUNCHES
#define N_LAUNCHES 1
#endif
extern "C" void kernel_launch(void* const* d_in, const int* in_sizes, int n_in, void* d_out, int out_size, void* d_ws, size_t ws_size, hipStream_t stream) {
    static int grid = 0;
    if (grid == 0) {
        if (n_in != 20 || out_size != T * DM || ws_size < 256 * MiB) { fprintf(stderr, "kernel_launch: unexpected shapes (n_in %d out %d ws %zu)\n", n_in, out_size, ws_size); grid = -1; return; }
        int dev = 0, cus = 0, per_cu = 0;
        (void)hipGetDevice(&dev); (void)hipDeviceGetAttribute(&cus, hipDeviceAttributeMultiprocessorCount, dev);
        if (hipFuncSetAttribute((const void*)yoco_fwd, hipFuncAttributeMaxDynamicSharedMemorySize, LDS_TOTAL) != hipSuccess) { fprintf(stderr, "kernel_launch: hipFuncSetAttribute failed\n"); grid = -1; return; }
        if (hipOccupancyMaxActiveBlocksPerMultiprocessor(&per_cu, (const void*)yoco_fwd, 512, LDS_TOTAL) != hipSuccess || per_cu < 1) { fprintf(stderr, "kernel_launch: occupancy query says %d\n", per_cu); per_cu = 1; }
        (void)hipGetLastError();
        if (cus <= 0) cus = 256;
        grid = cus * (per_cu > 1 ? 1 : per_cu);
        if (grid != 256) { fprintf(stderr, "kernel_launch: this kernel needs exactly 256 workgroups (one per CU of a 256-CU device), got %d; nothing launched\n", grid); grid = -1; return; }
    }
    if (grid < 0) return;
    if (hipMemsetAsync((char*)d_ws + WS_MISC + MISC_CTL, 0, 65536, stream) != hipSuccess) { fprintf(stderr, "kernel_launch: memset failed\n"); return; }
    Params p{};
    for (int i = 0; i < 20; ++i) p.in[i] = (const float*)d_in[i];
    p.out = (float*)d_out; p.ws = (unsigned char*)d_ws;
#if N_LAUNCHES == 1
    p.ph_lo = 0; p.ph_hi = 10;
    void* args[] = {&p};
    hipError_t e = hipLaunchCooperativeKernel((const void*)yoco_fwd, dim3(grid), dim3(512), args, LDS_TOTAL, stream);
    if (e != hipSuccess) fprintf(stderr, "cooperative launch failed: %s (grid %d)\n", hipGetErrorString(e), grid);
#else
    for (int k = 0; k < 10; ++k) { p.ph_lo = k; p.ph_hi = k + 1; hipLaunchKernelGGL(yoco_fwd, dim3(grid), dim3(512), LDS_TOTAL, stream, p); }
#endif
}
```
